# Optimizing an MI355X kernel written in HIP

```python
import math
import jax, jax.numpy as jnp
from jax import lax
import numpy as np

D_MODEL = 1024
BATCH = 32
SEQ = 256
DEPTH = 2
DEC_BATCH = 4
DEC_SEQ = 1024
PAST_LEN = 512

GRID_W = 64
HEAD_DIM = 64
MIX_WIDTH = D_MODEL
DIFF_WIDTH = MIX_WIDTH // 2
GQA_WIDTH = MIX_WIDTH - DIFF_WIDTH
DIFF_HEADS = DIFF_WIDTH // (2 * HEAD_DIM)
GQA_Q_HEADS = GQA_WIDTH // HEAD_DIM
GQA_KV_HEADS = 2
GQA_REP = GQA_Q_HEADS // GQA_KV_HEADS
DIFF_QK_COLS = 2 * DIFF_HEADS * HEAD_DIM
DIFF_V_COLS = DIFF_HEADS * 2 * HEAD_DIM
GQA_Q_COLS = GQA_Q_HEADS * HEAD_DIM
GQA_KV_COLS = GQA_KV_HEADS * HEAD_DIM
IN_COLS = 2 * DIFF_QK_COLS + DIFF_V_COLS + GQA_Q_COLS + 2 * GQA_KV_COLS
IN_SPLITS = (DIFF_QK_COLS,
             2 * DIFF_QK_COLS,
             2 * DIFF_QK_COLS + DIFF_V_COLS,
             2 * DIFF_QK_COLS + DIFF_V_COLS + GQA_Q_COLS,
             2 * DIFF_QK_COLS + DIFF_V_COLS + GQA_Q_COLS + GQA_KV_COLS)
FFN_HIDDEN = ((8 * D_MODEL + 3 * 256 - 1) // (3 * 256)) * 256
Q_BLOCK = 128
ROPE_THETA = 10000.0
EPS = 1e-6

kernel_name = "hybrid_diffattn_gqa_dit_step"


def rms_norm(x, gain):
    xf = x.astype(jnp.float32)
    y = xf * lax.rsqrt(jnp.mean(xf * xf, axis=-1, keepdims=True) + EPS)
    return (y * gain.astype(jnp.float32)).astype(x.dtype)


def axial_rope_angles(n_tokens):
    t = jnp.arange(n_tokens, dtype=jnp.int32)
    row = (t // GRID_W).astype(jnp.float32)
    col = (t % GRID_W).astype(jnp.float32)
    axis_dim = HEAD_DIM // 2
    freqs = ROPE_THETA ** (-jnp.arange(0, axis_dim, 2, dtype=jnp.float32) / axis_dim)
    ang = jnp.concatenate([row[:, None] * freqs, col[:, None] * freqs], axis=-1)
    return jnp.cos(ang), jnp.sin(ang)


def apply_rope(x, cos, sin):
    half = HEAD_DIM // 2
    xf = x.astype(jnp.float32)
    x1, x2 = xf[..., :half], xf[..., half:]
    shape = (1, cos.shape[0]) + (1,) * (x.ndim - 3) + (half,)
    c = cos.reshape(shape)
    s = sin.reshape(shape)
    return jnp.concatenate([x1 * c - x2 * s, x2 * c + x1 * s], axis=-1).astype(x.dtype)


def sweep_query_blocks(attend, q):
    b, t = q.shape[0], q.shape[1]
    nb = t // Q_BLOCK
    qb = jnp.moveaxis(q.reshape((b, nb, Q_BLOCK) + q.shape[2:]), 1, 0)
    out = lax.map(attend, qb)
    out = jnp.moveaxis(out, 0, 1)
    return out.reshape((b, t) + out.shape[3:])


def diff_attention(q, k, v, lam, lam_init, subln_w):
    scale = HEAD_DIM ** -0.5

    def attend(qb):
        s = jnp.einsum('bqhcd,bshcd->bhcqs', qb, k).astype(jnp.float32) * scale
        p = jax.nn.softmax(s, axis=-1)
        w = p[:, :, 0] - lam * p[:, :, 1]
        return jnp.einsum('bhqs,bshe->bqhe', w.astype(v.dtype), v)

    o = sweep_query_blocks(attend, q)
    return rms_norm(o, subln_w) * (1.0 - lam_init)


def gqa_attention(q, k, v):
    scale = HEAD_DIM ** -0.5

    def attend(qb):
        s = jnp.einsum('bqgrd,bsgd->bgrqs', qb, k).astype(jnp.float32) * scale
        p = jax.nn.softmax(s, axis=-1)
        return jnp.einsum('bgrqs,bsge->bqgre', p.astype(v.dtype), v)

    return sweep_query_blocks(attend, q)


def modulation(cond, w_mod, b_mod):
    m = jax.nn.silu(cond) @ w_mod + b_mod
    return jnp.split(m[:, None, :], 6, axis=-1)


def trunk_layer(x, cond, rope, ctx, layer_idx,
                w_mod, b_mod, norm_attn, w_in, q_norm_a, k_norm_a,
                lambda_q1, lambda_k1, lambda_q2, lambda_k2, subln,
                q_norm_b, k_norm_b, w_out, norm_ffn, w_gate_up, w_down):
    b, t, _ = x.shape
    sh_a, sc_a, g_a, sh_f, sc_f, g_f = modulation(cond, w_mod, b_mod)

    h = rms_norm(x, norm_attn) * (1.0 + sc_a) + sh_a
    proj = h @ w_in
    qa, ka, va, qb, kb, vb = jnp.split(proj, IN_SPLITS, axis=-1)
    qa = rms_norm(qa.reshape(b, t, DIFF_HEADS, 2, HEAD_DIM), q_norm_a)
    ka = rms_norm(ka.reshape(b, t, DIFF_HEADS, 2, HEAD_DIM), k_norm_a)
    va = va.reshape(b, t, DIFF_HEADS, 2 * HEAD_DIM)
    qb = rms_norm(qb.reshape(b, t, GQA_KV_HEADS, GQA_REP, HEAD_DIM), q_norm_b)
    kb = rms_norm(kb.reshape(b, t, GQA_KV_HEADS, HEAD_DIM), k_norm_b)
    vb = vb.reshape(b, t, GQA_KV_HEADS, HEAD_DIM)
    own_ctx = (ka, va, kb, vb)

    if ctx is None:
        keys_a, vals_a, keys_b, vals_b = ka, va, kb, vb
    else:
        cos, sin = rope
        qa, ka = apply_rope(qa, cos, sin), apply_rope(ka, cos, sin)
        qb, kb = apply_rope(qb, cos, sin), apply_rope(kb, cos, sin)
        c_ka, c_va, c_kb, c_vb = ctx
        keys_a = jnp.concatenate([ka, c_ka.astype(ka.dtype)], axis=1)
        vals_a = jnp.concatenate([va, c_va.astype(va.dtype)], axis=1)
        keys_b = jnp.concatenate([kb, c_kb.astype(kb.dtype)], axis=1)
        vals_b = jnp.concatenate([vb, c_vb.astype(vb.dtype)], axis=1)

    lam_init = 0.8 - 0.6 * math.exp(-0.3 * layer_idx)
    lam = (jnp.exp(jnp.sum(lambda_q1.astype(jnp.float32) * lambda_k1.astype(jnp.float32)))
           - jnp.exp(jnp.sum(lambda_q2.astype(jnp.float32) * lambda_k2.astype(jnp.float32)))
           + lam_init)
    out_a = diff_attention(qa, keys_a, vals_a, lam, lam_init, subln).reshape(b, t, DIFF_WIDTH)
    out_b = gqa_attention(qb, keys_b, vals_b).reshape(b, t, GQA_WIDTH)
    mix = jnp.concatenate([out_a, out_b], axis=-1) @ w_out
    x = x + g_a * mix

    h = rms_norm(x, norm_ffn) * (1.0 + sc_f) + sh_f
    gate, up = jnp.split(h @ w_gate_up, 2, axis=-1)
    x = x + g_f * ((jax.nn.silu(gate) * up) @ w_down)
    return x, own_ctx


def setup_inputs(seed: int = 0) -> dict:
    key = jax.random.key(seed)
    ks = jax.random.split(key, 32)

    def nrm(k, shape, s):
        return jax.random.normal(k, shape, jnp.float32) * s

    d = D_MODEL
    return {
        "x_prompt": nrm(ks[0], (BATCH, SEQ, d), 1.0),
        "x_sample": nrm(ks[1], (DEC_BATCH, DEC_SEQ, d), 1.0),
        "cache_diff_k": nrm(ks[2], (DEC_BATCH, DEPTH, PAST_LEN, DIFF_HEADS, 2, HEAD_DIM), 1.0),
        "cache_diff_v": nrm(ks[3], (DEC_BATCH, DEPTH, PAST_LEN, DIFF_HEADS, 2 * HEAD_DIM), 1.0),
        "cache_gqa_k": nrm(ks[4], (DEC_BATCH, DEPTH, PAST_LEN, GQA_KV_HEADS, HEAD_DIM), 1.0),
        "cache_gqa_v": nrm(ks[5], (DEC_BATCH, DEPTH, PAST_LEN, GQA_KV_HEADS, HEAD_DIM), 1.0),
        "c": nrm(ks[6], (DEC_BATCH, d), 1.0),
        "c_ctx": nrm(ks[7], (d,), 1.0),
        "w_mod": nrm(ks[8], (DEPTH, d, 6 * d), 0.5 * d ** -0.5),
        "b_mod": nrm(ks[9], (DEPTH, 6 * d), 0.02),
        "norm_attn": 1.0 + nrm(ks[10], (DEPTH, d), 0.02),
        "w_in": nrm(ks[11], (DEPTH, d, IN_COLS), d ** -0.5),
        "q_norm_a": 1.0 + nrm(ks[12], (DEPTH, HEAD_DIM), 0.02),
        "k_norm_a": 1.0 + nrm(ks[13], (DEPTH, HEAD_DIM), 0.02),
        "lambda_q1": nrm(ks[14], (DEPTH, HEAD_DIM), 0.1),
        "lambda_k1": nrm(ks[15], (DEPTH, HEAD_DIM), 0.1),
        "lambda_q2": nrm(ks[16], (DEPTH, HEAD_DIM), 0.1),
        "lambda_k2": nrm(ks[17], (DEPTH, HEAD_DIM), 0.1),
        "subln": 1.0 + nrm(ks[18], (DEPTH, 2 * HEAD_DIM), 0.02),
        "q_norm_b": 1.0 + nrm(ks[19], (DEPTH, HEAD_DIM), 0.02),
        "k_norm_b": 1.0 + nrm(ks[20], (DEPTH, HEAD_DIM), 0.02),
        "w_out": nrm(ks[21], (DEPTH, MIX_WIDTH, d), MIX_WIDTH ** -0.5),
        "norm_ffn": 1.0 + nrm(ks[22], (DEPTH, d), 0.02),
        "w_gate_up": nrm(ks[23], (DEPTH, d, 2 * FFN_HIDDEN), d ** -0.5),
        "w_down": nrm(ks[24], (DEPTH, FFN_HIDDEN, d), FFN_HIDDEN ** -0.5),
    }


def reference(x_prompt, x_sample, cache_diff_k, cache_diff_v, cache_gqa_k, cache_gqa_v,
              c, c_ctx, w_mod, b_mod, norm_attn, w_in, q_norm_a, k_norm_a,
              lambda_q1, lambda_k1, lambda_q2, lambda_k2, subln, q_norm_b, k_norm_b,
              w_out, norm_ffn, w_gate_up, w_down):
    rope = axial_rope_angles(x_sample.shape[1])
    cond_ctx = c_ctx[None, :]

    yp = x_prompt
    ys = x_sample
    dk, dv, gk, gv = [], [], [], []
    for l in range(DEPTH):
        lw = (w_mod[l], b_mod[l], norm_attn[l], w_in[l], q_norm_a[l], k_norm_a[l],
              lambda_q1[l], lambda_k1[l], lambda_q2[l], lambda_k2[l], subln[l],
              q_norm_b[l], k_norm_b[l], w_out[l], norm_ffn[l], w_gate_up[l], w_down[l])
        yp, (ka, va, kb, vb) = trunk_layer(yp, cond_ctx, None, None, l, *lw)
        dk.append(ka)
        dv.append(va)
        gk.append(kb)
        gv.append(vb)
        ctx = (cache_diff_k[:, l], cache_diff_v[:, l], cache_gqa_k[:, l], cache_gqa_v[:, l])
        ys, _ = trunk_layer(ys, c, rope, ctx, l, *lw)

    new_diff_k = jnp.stack(dk, axis=1)
    new_diff_v = jnp.stack(dv, axis=1)
    new_gqa_k = jnp.stack(gk, axis=1)
    new_gqa_v = jnp.stack(gv, axis=1)
    return (yp, ys, new_diff_k, new_diff_v, new_gqa_k, new_gqa_v)
```

```cpp
#include <hip/hip_runtime.h>
#include <hip/hip_cooperative_groups.h>
#include <cstdio>
#include <cstdint>
#include <cmath>
namespace nv {
constexpr int D = 1024, INC = 2304, FH = 2816, NMOD = 6144;
constexpr float EPS = 1e-6f;
struct Chunk { int cb0, ncb, lb0, nlb; };
__host__ __device__ inline int chunk_NC(const Chunk& c) { return 256 * c.ncb; }
__host__ __device__ inline int chunk_R(const Chunk& c) { return 256 * c.ncb + 1024 * c.nlb; }
__device__ inline int row_m(const Chunk& c, int r) { const int NC = 256 * c.ncb; return r < NC ? 256 * c.cb0 + r : 8192 + 1024 * c.lb0 + (r - NC); }
__device__ inline int cond_of_m(int m) { return m < 8192 ? 4 : (m - 8192) >> 10; }
__device__ inline float wave_sum(float v) {
#pragma unroll
    for (int o = 1; o < 64; o <<= 1) v += __shfl_xor(v, o);
    return v;
}
__device__ inline float wave_max(float v) {
#pragma unroll
    for (int o = 1; o < 64; o <<= 1) v = fmaxf(v, __shfl_xor(v, o));
    return v;
}

__global__ void __launch_bounds__(256) k_mod(const float* c_in, const float* c_ctx, const float* w_mod, const float* b_mod, float* mod,
                                             const float* lq1, const float* lk1, const float* lq2, const float* lk2, float* lamout) {
    __shared__ float s[5][1024];
    for (int i = threadIdx.x; i < 5 * 1024; i += 256) { const int c = i >> 10, k = i & 1023; const float x = c < 4 ? c_in[c * 1024 + k] : c_ctx[k]; s[c][k] = x / (1.f + expf(-x)); }
    __syncthreads();
    const int gid = blockIdx.x * 256 + threadIdx.x;
    const int l = gid / NMOD, n = gid % NMOD;
    const float* w = w_mod + (size_t)l * 1024 * NMOD + n;
    float a0 = 0.f, a1 = 0.f, a2 = 0.f, a3 = 0.f, a4 = 0.f;
    for (int k = 0; k < 1024; ++k) { const float wv = w[(size_t)k * NMOD]; a0 += s[0][k] * wv; a1 += s[1][k] * wv; a2 += s[2][k] * wv; a3 += s[3][k] * wv; a4 += s[4][k] * wv; }
    const float b = b_mod[l * NMOD + n];
    float* o = mod + (size_t)l * 5 * NMOD + n;
    o[0 * NMOD] = a0 + b; o[1 * NMOD] = a1 + b; o[2 * NMOD] = a2 + b; o[3 * NMOD] = a3 + b; o[4 * NMOD] = a4 + b;
    if (blockIdx.x == 0 && threadIdx.x < 128) {
        const int ll = threadIdx.x >> 6, d = threadIdx.x & 63;
        const float s1 = wave_sum(lq1[ll * 64 + d] * lk1[ll * 64 + d]), s2 = wave_sum(lq2[ll * 64 + d] * lk2[ll * 64 + d]);
        const float li = 0.8f - 0.6f * expf(-0.3f * (float)ll);
        if (d == 0) { lamout[ll] = expf(s1) - expf(s2) + li; lamout[2 + ll] = li; }
    }
}
__global__ void __launch_bounds__(256) k_load_x(Chunk ch, const float* xp, const float* xs, float* X) {
    const int r = blockIdx.x, m = row_m(ch, r);
    const float* src = m < 8192 ? xp + (size_t)m * D : xs + (size_t)(m - 8192) * D;
    ((float4*)(X + (size_t)r * D))[threadIdx.x] = ((const float4*)src)[threadIdx.x];
}
__global__ void __launch_bounds__(256) k_norm_mod(Chunk ch, const float* X, const float* gain, const float* mod_l, int sh_off, int sc_off, float* H) {
    __shared__ float red[4];
    const int r = blockIdx.x, m = row_m(ch, r), c = cond_of_m(m);
    const float4 v = ((const float4*)(X + (size_t)r * D))[threadIdx.x];
    float ss = wave_sum(v.x * v.x + v.y * v.y + v.z * v.z + v.w * v.w);
    if ((threadIdx.x & 63) == 0) red[threadIdx.x >> 6] = ss;
    __syncthreads();
    ss = red[0] + red[1] + red[2] + red[3];
    const float rstd = 1.0f / sqrtf(ss * (1.f / D) + EPS);
    const int k = threadIdx.x * 4;
    const float* mc = mod_l + (size_t)c * NMOD;
    float4 o;
    o.x = v.x * rstd * gain[k + 0] * (1.f + mc[sc_off + k + 0]) + mc[sh_off + k + 0];
    o.y = v.y * rstd * gain[k + 1] * (1.f + mc[sc_off + k + 1]) + mc[sh_off + k + 1];
    o.z = v.z * rstd * gain[k + 2] * (1.f + mc[sc_off + k + 2]) + mc[sh_off + k + 2];
    o.w = v.w * rstd * gain[k + 3] * (1.f + mc[sc_off + k + 3]) + mc[sh_off + k + 3];
    ((float4*)(H + (size_t)r * D))[threadIdx.x] = o;
}
template <bool DUAL>
__global__ void __launch_bounds__(256) k_gemm(const float* __restrict__ A, int lda, const float* __restrict__ B, int ldb, float* __restrict__ C, int ldc, int K, int dual_off) {
    __shared__ float As[16][68], Bs[16][68], Bs2[DUAL ? 16 : 1][68];
    const int t = threadIdx.x, tx = t & 15, ty = t >> 4;
    const int row0 = blockIdx.y * 64, col0 = blockIdx.x * 64;
    float acc[4][4], acc2[4][4];
#pragma unroll
    for (int i = 0; i < 4; ++i)
#pragma unroll
        for (int j = 0; j < 4; ++j) { acc[i][j] = 0.f; acc2[i][j] = 0.f; }
    for (int k0 = 0; k0 < K; k0 += 16) {
        { const int r = t >> 2, kk = (t & 3) * 4; const float4 v = *(const float4*)&A[(size_t)(row0 + r) * lda + k0 + kk]; As[kk + 0][r] = v.x; As[kk + 1][r] = v.y; As[kk + 2][r] = v.z; As[kk + 3][r] = v.w; }
        { const int kk = t >> 4, cc = (t & 15) * 4; *(float4*)&Bs[kk][cc] = *(const float4*)&B[(size_t)(k0 + kk) * ldb + col0 + cc];
          if (DUAL) *(float4*)&Bs2[kk][cc] = *(const float4*)&B[(size_t)(k0 + kk) * ldb + dual_off + col0 + cc]; }
        __syncthreads();
#pragma unroll
        for (int kk = 0; kk < 16; ++kk) {
            const float4 a = *(const float4*)&As[kk][ty * 4], b = *(const float4*)&Bs[kk][tx * 4];
            const float av[4] = {a.x, a.y, a.z, a.w}, bv[4] = {b.x, b.y, b.z, b.w};
#pragma unroll
            for (int i = 0; i < 4; ++i)
#pragma unroll
                for (int j = 0; j < 4; ++j) acc[i][j] += av[i] * bv[j];
            if (DUAL) { const float4 b2 = *(const float4*)&Bs2[kk][tx * 4]; const float b2v[4] = {b2.x, b2.y, b2.z, b2.w};
#pragma unroll
                for (int i = 0; i < 4; ++i)
#pragma unroll
                    for (int j = 0; j < 4; ++j) acc2[i][j] += av[i] * b2v[j]; }
        }
        __syncthreads();
    }
#pragma unroll
    for (int i = 0; i < 4; ++i) { float4 o;
        if (DUAL) { o.x = acc[i][0] / (1.f + expf(-acc[i][0])) * acc2[i][0]; o.y = acc[i][1] / (1.f + expf(-acc[i][1])) * acc2[i][1]; o.z = acc[i][2] / (1.f + expf(-acc[i][2])) * acc2[i][2]; o.w = acc[i][3] / (1.f + expf(-acc[i][3])) * acc2[i][3]; }
        else { o.x = acc[i][0]; o.y = acc[i][1]; o.z = acc[i][2]; o.w = acc[i][3]; }
        *(float4*)&C[(size_t)(row0 + ty * 4 + i) * ldc + col0 + tx * 4] = o; }
}
__global__ void __launch_bounds__(256) k_qkpost(Chunk ch, float* P, int l, const float* qna, const float* kna, const float* qnb, const float* knb, float* out, int write_out) {
    const int wave = (blockIdx.x * 256 + threadIdx.x) >> 6, lane = threadIdx.x & 63;
    const int r = wave / 36, g = wave % 36;
    if (r >= chunk_R(ch)) return;
    const int m = row_m(ch, r);
    float* p = P + (size_t)r * INC + g * 64 + lane;
    float v = *p;
    const float* gain = nullptr; bool isk = false;
    if (g < 8) gain = qna; else if (g < 16) { gain = kna; isk = true; } else if (g < 24) gain = nullptr; else if (g < 32) gain = qnb; else if (g < 34) { gain = knb; isk = true; }
    (void)isk;
    if (gain) {
        const float ss = wave_sum(v * v);
        v = v * (1.0f / sqrtf(ss * (1.f / 64.f) + EPS)) * gain[l * 64 + lane];
        if (m >= 8192) {
            const int tpos = (m - 8192) & 1023, i = lane & 31;
            const float pos = (i < 16) ? (float)(tpos >> 6) : (float)(tpos & 63);
            const float freq = powf(10000.0f, -(float)(2 * (i & 15)) / 32.0f);
            const float ang = pos * freq, cs = cosf(ang), sn = sinf(ang);
            const float other = __shfl_xor(v, 32);
            v = (lane < 32) ? (v * cs - other * sn) : (v * cs + other * sn);
        }
        *p = v;
    }
    if (write_out && m < 8192) {
        const int b = m >> 8, t = m & 255;
        const size_t O_DK = (size_t)12288 * 1024, O_DV = O_DK + (size_t)8192 * 2 * 512, O_GK = O_DV + (size_t)8192 * 2 * 512, O_GV = O_GK + (size_t)8192 * 2 * 128;
        if (g >= 8 && g < 16)       out[O_DK + ((size_t)(b * 2 + l) * 256 + t) * 512 + (g - 8) * 64 + lane] = v;
        else if (g >= 16 && g < 24) out[O_DV + ((size_t)(b * 2 + l) * 256 + t) * 512 + (g - 16) * 64 + lane] = v;
        else if (g >= 32 && g < 34) out[O_GK + ((size_t)(b * 2 + l) * 256 + t) * 128 + (g - 32) * 64 + lane] = v;
        else if (g >= 34)           out[O_GV + ((size_t)(b * 2 + l) * 256 + t) * 128 + (g - 34) * 64 + lane] = v;
    }
}
__global__ void __launch_bounds__(256) k_attn(Chunk ch, const float* P, int l, const float* cdk, const float* cdv, const float* cgk, const float* cgv,
                                              const float* lam2, const float* subln, float* AO) {
    __shared__ float sc[4][2][1536];
    const int wid = threadIdx.x >> 6, lane = threadIdx.x & 63;
    const int wave = blockIdx.x * 4 + wid;
    const int r = wave / 12, h = wave % 12;
    if (r >= chunk_R(ch)) return;
    const int NC = chunk_NC(ch), m = row_m(ch, r);
    const bool lat = m >= 8192;
    const int rb0 = lat ? NC + ((r - NC) >> 10) * 1024 : (r >> 8) * 256;
    const int nown = lat ? 1024 : 256, S = lat ? 1536 : 256;
    const int bl = lat ? (m - 8192) >> 10 : 0;
    const float scale = 0.125f;
    if (h < 4) {
        for (int cpt = 0; cpt < 2; ++cpt) {
            const float* q = P + (size_t)r * INC + h * 128 + cpt * 64;
            float qv[64];
#pragma unroll
            for (int d = 0; d < 64; ++d) qv[d] = q[d];
            float mx = -INFINITY;
            for (int s = lane; s < S; s += 64) {
                const float* k = (s < nown) ? P + (size_t)(rb0 + s) * INC + 512 + h * 128 + cpt * 64
                                            : cdk + ((((size_t)bl * 2 + l) * 512 + (s - nown)) * 4 + h) * 128 + cpt * 64;
                float dot = 0.f;
#pragma unroll
                for (int d = 0; d < 64; d += 4) { const float4 kv = *(const float4*)(k + d); dot += qv[d] * kv.x + qv[d + 1] * kv.y + qv[d + 2] * kv.z + qv[d + 3] * kv.w; }
                dot *= scale; sc[wid][cpt][s] = dot; mx = fmaxf(mx, dot);
            }
            mx = wave_max(mx);
            float sum = 0.f;
            for (int s = lane; s < S; s += 64) { const float e = expf(sc[wid][cpt][s] - mx); sc[wid][cpt][s] = e; sum += e; }
            sum = wave_sum(sum);
            const float inv = 1.f / sum;
            for (int s = lane; s < S; s += 64) sc[wid][cpt][s] *= inv;
        }
        __builtin_amdgcn_s_waitcnt(0);
        const float lam = lam2[l], li = lam2[2 + l];
        float o0 = 0.f, o1 = 0.f;
        for (int s = 0; s < S; ++s) {
            const float w = sc[wid][0][s] - lam * sc[wid][1][s];
            const float* v = (s < nown) ? P + (size_t)(rb0 + s) * INC + 1024 + h * 128 : cdv + ((((size_t)bl * 2 + l) * 512 + (s - nown)) * 4 + h) * 128;
            o0 += w * v[lane]; o1 += w * v[lane + 64];
        }
        const float ss = wave_sum(o0 * o0 + o1 * o1);
        const float rstd = 1.0f / sqrtf(ss * (1.f / 128.f) + EPS);
        AO[(size_t)r * D + h * 128 + lane] = o0 * rstd * subln[l * 128 + lane] * (1.f - li);
        AO[(size_t)r * D + h * 128 + 64 + lane] = o1 * rstd * subln[l * 128 + 64 + lane] * (1.f - li);
    } else {
        const int hq = h - 4, g = hq >> 2;
        const float* q = P + (size_t)r * INC + 1536 + hq * 64;
        float qv[64];
#pragma unroll
        for (int d = 0; d < 64; ++d) qv[d] = q[d];
        float mx = -INFINITY;
        for (int s = lane; s < S; s += 64) {
            const float* k = (s < nown) ? P + (size_t)(rb0 + s) * INC + 2048 + g * 64 : cgk + ((((size_t)bl * 2 + l) * 512 + (s - nown)) * 2 + g) * 64;
            float dot = 0.f;
#pragma unroll
            for (int d = 0; d < 64; d += 4) { const float4 kv = *(const float4*)(k + d); dot += qv[d] * kv.x + qv[d + 1] * kv.y + qv[d + 2] * kv.z + qv[d + 3] * kv.w; }
            dot *= scale; sc[wid][0][s] = dot; mx = fmaxf(mx, dot);
        }
        mx = wave_max(mx);
        float sum = 0.f;
        for (int s = lane; s < S; s += 64) { const float e = expf(sc[wid][0][s] - mx); sc[wid][0][s] = e; sum += e; }
        sum = wave_sum(sum);
        __builtin_amdgcn_s_waitcnt(0);
        float o0 = 0.f;
        for (int s = 0; s < S; ++s) {
            const float* v = (s < nown) ? P + (size_t)(rb0 + s) * INC + 2176 + g * 64 : cgv + ((((size_t)bl * 2 + l) * 512 + (s - nown)) * 2 + g) * 64;
            o0 += sc[wid][0][s] * v[lane];
        }
        AO[(size_t)r * D + 512 + hq * 64 + lane] = o0 / sum;
    }
}
__global__ void __launch_bounds__(256) k_resid(Chunk ch, float* X, const float* Y, const float* mod_l, int g_off) {
    const int r = blockIdx.x, m = row_m(ch, r), c = cond_of_m(m);
    const float* g = mod_l + (size_t)c * NMOD + g_off;
    const int k = threadIdx.x * 4;
    float4 x = ((float4*)(X + (size_t)r * D))[threadIdx.x]; const float4 y = ((const float4*)(Y + (size_t)r * D))[threadIdx.x];
    x.x += g[k] * y.x; x.y += g[k + 1] * y.y; x.z += g[k + 2] * y.z; x.w += g[k + 3] * y.w;
    ((float4*)(X + (size_t)r * D))[threadIdx.x] = x;
}
__global__ void __launch_bounds__(256) k_store_y(Chunk ch, const float* X, float* out) {
    const int r = blockIdx.x, m = row_m(ch, r);
    ((float4*)(out + (size_t)m * D))[threadIdx.x] = ((const float4*)(X + (size_t)r * D))[threadIdx.x];
}

struct Bufs { float* mod; float* lam; float* X; float* H; float* P; };
struct Hooks { void (*after)(int stage, int l, void* user); void* user; };
enum Stage { ST_H1 = 0, ST_PROJ, ST_AO, ST_XMID, ST_H2, ST_ACT, ST_XOUT, ST_N };

static void run_chunk(const Chunk ch, void* const* d_in, float* d_out, const Bufs& B, hipStream_t st, int write_out, const Hooks* hk) {
    const float* const* in = (const float* const*)d_in;
    const int R = chunk_R(ch);
    k_load_x<<<R, 256, 0, st>>>(ch, in[0], in[1], B.X);
    for (int l = 0; l < 2; ++l) {
        const float* mod_l = B.mod + (size_t)l * 5 * NMOD;
        k_norm_mod<<<R, 256, 0, st>>>(ch, B.X, in[10] + l * D, mod_l, 0, 1024, B.H);
        if (hk) hk->after(ST_H1, l, hk->user);
        k_gemm<false><<<dim3(INC / 64, R / 64), 256, 0, st>>>(B.H, D, in[11] + (size_t)l * D * INC, INC, B.P, INC, D, 0);
        k_qkpost<<<(R * 36 + 3) / 4, 256, 0, st>>>(ch, B.P, l, in[12], in[13], in[19], in[20], d_out, write_out);
        if (hk) hk->after(ST_PROJ, l, hk->user);
        k_attn<<<(R * 12 + 3) / 4, 256, 0, st>>>(ch, B.P, l, in[2], in[3], in[4], in[5], B.lam, in[18], B.H);
        if (hk) hk->after(ST_AO, l, hk->user);
        k_gemm<false><<<dim3(D / 64, R / 64), 256, 0, st>>>(B.H, D, in[21] + (size_t)l * D * D, D, B.P, D, D, 0);
        k_resid<<<R, 256, 0, st>>>(ch, B.X, B.P, mod_l, 2048);
        if (hk) hk->after(ST_XMID, l, hk->user);
        k_norm_mod<<<R, 256, 0, st>>>(ch, B.X, in[22] + l * D, mod_l, 3072, 4096, B.H);
        if (hk) hk->after(ST_H2, l, hk->user);
        k_gemm<true><<<dim3(FH / 64, R / 64), 256, 0, st>>>(B.H, D, in[23] + (size_t)l * D * 2 * FH, 2 * FH, B.P, FH, D, FH);
        if (hk) hk->after(ST_ACT, l, hk->user);
        k_gemm<false><<<dim3(D / 64, R / 64), 256, 0, st>>>(B.P, FH, in[24] + (size_t)l * FH * D, D, B.H, D, FH, 0);
        k_resid<<<R, 256, 0, st>>>(ch, B.X, B.H, mod_l, 5120);
        if (hk) hk->after(ST_XOUT, l, hk->user);
    }
    if (write_out) k_store_y<<<R, 256, 0, st>>>(ch, B.X, d_out);
}
static void run_mod(void* const* d_in, const Bufs& B, hipStream_t st) {
    const float* const* in = (const float* const*)d_in;
    k_mod<<<2 * NMOD / 256, 256, 0, st>>>(in[6], in[7], in[8], in[9], B.mod, in[14], in[15], in[16], in[17], B.lam);
}
}
extern "C" void kernel_launch(void* const* d_in, const int* in_sizes, int n_in, void* d_out, int out_size, void* d_ws, size_t ws_size, hipStream_t stream) {
    (void)in_sizes; (void)n_in; (void)out_size; (void)ws_size;
    float* ws = (float*)d_ws;
    nv::Bufs B;
    B.mod = ws; B.lam = ws + 65536; B.X = ws + 131072; B.H = B.X + (size_t)3072 * 1024; B.P = B.H + (size_t)3072 * 1024;
    nv::run_mod(d_in, B, stream);
    for (int i = 0; i < 4; ++i) { nv::Chunk ch{8 * i, 8, i, 1}; nv::run_chunk(ch, d_in, (float*)d_out, B, stream, 1, nullptr); }
}
```

```cpp
#include <hip/hip_runtime.h>
#include <hip/hip_cooperative_groups.h>
#include <hip/hip_bf16.h>
#include <cstdio>
#include <cstdint>
#include <cmath>
namespace cg = cooperative_groups;
namespace pg8 {
#define PG8_LAS __attribute__((address_space(3)))
typedef unsigned short bf16_t;
typedef short bf16x8 __attribute__((ext_vector_type(8)));
typedef float f32x4 __attribute__((ext_vector_type(4)));
typedef unsigned u32x4 __attribute__((ext_vector_type(4)));
constexpr int BM = 256, BK = 64, HALF = 128, HTB = HALF * BK * 2  , STAGE_BYTES = 8 * HTB, NXCD = 8, WGM = 8;

__host__ __device__ __forceinline__ int lds_byte(int r, int c) { const int st = (r >> 4) * 2 + (c >> 5), rr = r & 15, cc = c & 31, ob = rr * 64 + cc * 2; return st * 1024 + (ob ^ (((ob >> 9) & 1) << 5)); }
__host__ __device__ __forceinline__ void stage_rc(int b, int& R, int& C) { const int st = b / 1024, sb = b % 1024, swz = sb ^ (((sb >> 9) & 1) << 5); R = (st >> 1) * 16 + swz / 64; C = (st & 1) * 32 + (swz % 64) / 2; }
__host__ __device__ __forceinline__ int perm32(int rho) { const int n = rho >> 4, i = rho & 15; return 8 * (i >> 2) + 4 * n + (i & 3); }

struct Unit { int pm, pn; };
struct Gemm { const bf16_t* A; const bf16_t* Bt; int M, N, K; };

struct StaticOrder {
    int nM, nN, nwg, G, c;
    __host__ __device__ void init(int M, int N, int G_, int c_) { nM = M / BM; nN = N / BM; nwg = nM * nN; G = G_; c = c_; }
    __host__ __device__ bool next(int i, Unit& u) const {
        const long L = (long)i * G + c; if (L >= nwg) return false;
        int wgid = (int)L; { const int q = nwg / NXCD, r = nwg % NXCD, xcd = wgid % NXCD, off = wgid / NXCD; wgid = (xcd < r ? xcd * (q + 1) : r * (q + 1) + (xcd - r) * q) + off; }
        const int nig = WGM * nN, gid = wgid / nig, fm = gid * WGM, gsz = (nM - fm) < WGM ? (nM - fm) : WGM;
        u.pm = fm + ((wgid % nig) % gsz); u.pn = (wgid % nig) / gsz; return true;
    }
    __device__ __forceinline__ void a_ready(const Unit&) const {}
    __device__ __forceinline__ void done(const Unit&) const {}
};

__device__ __forceinline__ unsigned cvt_pk_bf16(float lo, float hi) { unsigned r; asm volatile("v_cvt_pk_bf16_f32 %0, %1, %2" : "=v"(r) : "v"(lo), "v"(hi)); return r; }
template <class Epi, class Sched, bool ALIGN_EPI = false, bool SP2 = false>
__device__ __forceinline__ void gemm_phase(PG8_LAS unsigned char* lds, const Gemm g, const Sched& S, const Epi& E) {
    int tid_ = threadIdx.x; asm volatile("" : "+v"(tid_));
    const int tid = tid_, wid = __builtin_amdgcn_readfirstlane(tid >> 6), lane = tid & 63, wr = wid >> 2, wc = wid & 3, fr = lane & 15, fq = lane >> 4;
    const int K = g.K, nt = K / BK;
    unsigned voffA[2], voffB[2];
#pragma unroll
    for (int i = 0; i < 2; ++i) { int R, C; stage_rc(tid * 16 + i * 8192, R, C); const int Rb = Epi::PERM ? ((R & ~31) + perm32(R & 31)) : R;
        voffA[i] = (unsigned)(R * K + C) * 2u; voffB[i] = (unsigned)(Rb * K + C) * 2u; }
    const size_t kstep = (size_t)(BK * 2);
    const size_t hstep = (size_t)HALF * K * 2;
    const size_t tstep = 2 * hstep;
    const unsigned ldsw = (unsigned)wid * 1024u;
    const int aoff = lds_byte(wr * 64 + fr, fq * 8), boff = lds_byte(wc * 32 + fr, fq * 8);
#define PG8_SA(b, h) (((b) * 2 + (h)) * HTB)
#define PG8_SB(b, h) ((4 + (b) * 2 + (h)) * HTB)
#define PG8_STAGE(bufoff, gbase, voff) do { _Pragma("unroll") for (int _i = 0; _i < 2; ++_i) \
        __builtin_amdgcn_global_load_lds((const unsigned*)((const char*)(gbase) + (voff)[_i]), (PG8_LAS unsigned*)(lds + (bufoff) + ldsw + _i * 8192), 16, 0, 0); } while (0)
#define PG8_LDA(dst, b, h) do { _Pragma("unroll") for (int m = 0; m < 4; ++m) _Pragma("unroll") for (int k = 0; k < 2; ++k) dst[m][k] = *(const PG8_LAS bf16x8*)(lds + PG8_SA(b, h) + aoff + m * 2048 + k * 1024); } while (0)
#define PG8_LDB(dst, b, h) do { _Pragma("unroll") for (int n = 0; n < 2; ++n) _Pragma("unroll") for (int k = 0; k < 2; ++k) dst[n][k] = *(const PG8_LAS bf16x8*)(lds + PG8_SB(b, h) + boff + n * 2048 + k * 1024); } while (0)
#define PG8_MMA(ai, bj, At, Bt) do { __builtin_amdgcn_s_setprio(1); _Pragma("unroll") for (int m = 0; m < 4; ++m) _Pragma("unroll") for (int n = 0; n < 2; ++n) _Pragma("unroll") for (int k = 0; k < 2; ++k) \
        acc[ai][bj][m][n] = __builtin_amdgcn_mfma_f32_16x16x32_bf16(Bt[n][k], At[m][k], acc[ai][bj][m][n], 0, 0, 0); __builtin_amdgcn_s_setprio(0); } while (0)
#define PG8_WAIT_V(n) asm volatile("s_waitcnt vmcnt(" #n ")" ::: "memory")
#define PG8_WAIT_L(n) asm volatile("s_waitcnt lgkmcnt(" #n ")" ::: "memory")
#define PG8_BAR __builtin_amdgcn_s_barrier()
#define PG8_SCHED __builtin_amdgcn_sched_barrier(0)
    Unit cur, nxt; int ui = 0;
    if (!S.next(0, cur)) return;
    f32x4 acc[2][2][4][2];
#pragma unroll
    for (int a = 0; a < 2; ++a)
#pragma unroll
        for (int b = 0; b < 2; ++b)
#pragma unroll
            for (int m = 0; m < 4; ++m)
#pragma unroll
                for (int n = 0; n < 2; ++n) acc[a][b][m][n] = (f32x4){0.f, 0.f, 0.f, 0.f};
    bf16x8 At[4][2], B0[2][2], B1[2][2];
    const char* cA = (const char*)g.A + (size_t)cur.pm * tstep; const char* cB = (const char*)g.Bt + (size_t)cur.pn * tstep;
    S.a_ready(cur);
    if constexpr (SP2) {
        PG8_STAGE(PG8_SB(0, 0), cB, voffB); PG8_STAGE(PG8_SB(0, 1), cB + hstep, voffB); PG8_STAGE(PG8_SA(0, 0), cA, voffA); PG8_STAGE(PG8_SA(0, 1), cA + hstep, voffA);
        if (wr == 1) PG8_BAR;
        PG8_WAIT_V(2); PG8_BAR;
        PG8_STAGE(PG8_SB(1, 0), cB + kstep, voffB); PG8_STAGE(PG8_SA(1, 0), cA + kstep, voffA); PG8_STAGE(PG8_SB(1, 1), cB + hstep + kstep, voffB);
        PG8_WAIT_V(6); PG8_BAR;
    } else {
        PG8_STAGE(PG8_SB(0, 0), cB, voffB); PG8_STAGE(PG8_SA(0, 0), cA, voffA); PG8_STAGE(PG8_SB(0, 1), cB + hstep, voffB); PG8_STAGE(PG8_SA(0, 1), cA + hstep, voffA);
        if (wr == 1) PG8_BAR;
        PG8_WAIT_V(4); PG8_BAR;
        PG8_STAGE(PG8_SB(1, 0), cB + kstep, voffB); PG8_STAGE(PG8_SA(1, 0), cA + kstep, voffA); PG8_STAGE(PG8_SB(1, 1), cB + hstep + kstep, voffB);
        PG8_WAIT_V(6); PG8_BAR;
    }
    for (;;) {
        const bool has_next = S.next(ui + 1, nxt);
        const char* nA = has_next ? (const char*)g.A + (size_t)nxt.pm * tstep : cA; const char* nB = has_next ? (const char*)g.Bt + (size_t)nxt.pn * tstep : cB;
        for (int t = 0; t < nt; t += 2) {
            const bool last = (t == nt - 2);
            const char* a1 = cA + (size_t)(t + 1) * kstep;
            const char* a2 = last ? nA : cA + (size_t)(t + 2) * kstep; const char* b2 = last ? nB : cB + (size_t)(t + 2) * kstep;
            const char* a3 = a2 + kstep; const char* b3 = b2 + kstep;
            if (last && has_next) S.a_ready(nxt);
            if constexpr (SP2) {
            PG8_LDB(B0, 0, 0); PG8_LDB(B1, 0, 1); PG8_SCHED; PG8_LDA(At, 0, 0); PG8_STAGE(PG8_SA(1, 1), a1 + hstep, voffA);
            PG8_WAIT_V(8); PG8_WAIT_L(0); PG8_BAR; PG8_MMA(0, 0, At, B0); PG8_MMA(0, 1, At, B1); PG8_BAR; PG8_SCHED;
            PG8_LDA(At, 0, 1); PG8_STAGE(PG8_SB(0, 0), b2, voffB); PG8_STAGE(PG8_SB(0, 1), b2 + hstep, voffB); PG8_STAGE(PG8_SA(0, 0), a2, voffA);
            PG8_WAIT_V(8); PG8_WAIT_L(0); PG8_BAR; PG8_MMA(1, 0, At, B0); PG8_MMA(1, 1, At, B1); PG8_BAR; PG8_SCHED;
            PG8_LDB(B0, 1, 0); PG8_LDB(B1, 1, 1); PG8_SCHED; PG8_LDA(At, 1, 0); PG8_STAGE(PG8_SA(0, 1), a2 + hstep, voffA);
            PG8_WAIT_V(8); PG8_WAIT_L(0); PG8_BAR; PG8_MMA(0, 0, At, B0); PG8_MMA(0, 1, At, B1); PG8_BAR; PG8_SCHED;
            PG8_LDA(At, 1, 1); PG8_STAGE(PG8_SB(1, 0), b3, voffB); PG8_STAGE(PG8_SB(1, 1), b3 + hstep, voffB); PG8_STAGE(PG8_SA(1, 0), a3, voffA);
            PG8_WAIT_V(8); PG8_WAIT_L(0); PG8_BAR; PG8_MMA(1, 0, At, B0); PG8_MMA(1, 1, At, B1); PG8_BAR; PG8_SCHED;
            } else {
            PG8_LDB(B0, 0, 0); PG8_SCHED; PG8_LDA(At, 0, 0); PG8_STAGE(PG8_SA(1, 1), a1 + hstep, voffA);
            PG8_WAIT_L(8); PG8_BAR; PG8_WAIT_L(0); PG8_MMA(0, 0, At, B0); PG8_BAR; PG8_SCHED;
            PG8_LDB(B1, 0, 1); PG8_STAGE(PG8_SB(0, 0), b2, voffB);
            PG8_BAR; PG8_WAIT_L(0); PG8_MMA(0, 1, At, B1); PG8_BAR;
            PG8_LDA(At, 0, 1); PG8_STAGE(PG8_SA(0, 0), a2, voffA);
            PG8_BAR; PG8_WAIT_L(0); PG8_MMA(1, 0, At, B0); PG8_BAR; PG8_SCHED;
            PG8_STAGE(PG8_SB(0, 1), b2 + hstep, voffB);
            PG8_WAIT_V(6); PG8_BAR; PG8_MMA(1, 1, At, B1); PG8_BAR;
            PG8_LDB(B0, 1, 0); PG8_SCHED; PG8_LDA(At, 1, 0); PG8_STAGE(PG8_SA(0, 1), a2 + hstep, voffA);
            PG8_WAIT_L(8); PG8_BAR; PG8_WAIT_L(0); PG8_MMA(0, 0, At, B0); PG8_BAR; PG8_SCHED;
            PG8_LDB(B1, 1, 1); PG8_STAGE(PG8_SB(1, 0), b3, voffB);
            PG8_BAR; PG8_WAIT_L(0); PG8_MMA(0, 1, At, B1); PG8_BAR;
            PG8_LDA(At, 1, 1); PG8_STAGE(PG8_SA(1, 0), a3, voffA);
            PG8_BAR; PG8_WAIT_L(0); PG8_MMA(1, 0, At, B0); PG8_BAR; PG8_SCHED;
            PG8_STAGE(PG8_SB(1, 1), b3 + hstep, voffB);
            PG8_WAIT_V(6); PG8_BAR; PG8_MMA(1, 1, At, B1); PG8_BAR;
            }
        }
        if constexpr (ALIGN_EPI) { if (wr == 0) PG8_BAR; }
        if constexpr (!Epi::AFTER_DRAIN) { E(acc, cur, wr, wc, fr, fq); S.done(cur); }
        if (!has_next) break;
#pragma unroll
        for (int a = 0; a < 2; ++a)
#pragma unroll
            for (int b = 0; b < 2; ++b)
#pragma unroll
                for (int m = 0; m < 4; ++m)
#pragma unroll
                    for (int n = 0; n < 2; ++n) acc[a][b][m][n] = (f32x4){0.f, 0.f, 0.f, 0.f};
        cur = nxt; cA = nA; cB = nB; ++ui;
        if constexpr (ALIGN_EPI) { if (wr == 1) PG8_BAR; }
    }
    PG8_WAIT_V(0);
    if constexpr (!ALIGN_EPI) { if (wr == 0) PG8_BAR; }
    PG8_BAR;
    if constexpr (Epi::AFTER_DRAIN) { E.fused(acc, cur, wr, wc, fr, fq, lds, wid, lane); S.done(cur); }
#undef PG8_SA
#undef PG8_SB
#undef PG8_STAGE
#undef PG8_LDA
#undef PG8_LDB
#undef PG8_MMA
#undef PG8_WAIT_V
#undef PG8_WAIT_L
#undef PG8_BAR
#undef PG8_SCHED
}
}
namespace fx {
using pg8::bf16_t; using pg8::bf16x8; using pg8::f32x4; using pg8::u32x4;
#define LAS __attribute__((address_space(3)))
typedef float f32x16 __attribute__((ext_vector_type(16)));
typedef unsigned u32x2 __attribute__((ext_vector_type(2)));
typedef short v4i16_t __attribute__((ext_vector_type(4)));
constexpr int D = 1024, INC = 2304, FH = 2816, NMOD = 6144, MTOT = 12288, MCTX = 8192;
constexpr float EPS = 1e-6f;
constexpr float LOG2E = 1.4426950408889634f;
constexpr float C2 = 0.125f * LOG2E;
constexpr size_t MiB = 1u << 20;
constexpr size_t WS_MOD = 0;
constexpr size_t WS_LAM = 256 * 1024;
constexpr size_t WS_GTAB = 320 * 1024;
constexpr size_t WS_BIN = 512 * 1024;
constexpr size_t WS_BGU = 768 * 1024;
constexpr size_t WS_ROPE = 1 * MiB;
constexpr size_t WS_SSQ1 = 2 * MiB;
constexpr size_t WS_SSQ2 = 3 * MiB;
constexpr size_t WS_WT = 4 * MiB;
constexpr size_t WT_IN = 0, WT_OUT = 4718592, WT_GU = WT_OUT + 2097152, WT_DN = WT_GU + 11534336, WT_LAYER = WT_DN + 5767168;
static_assert(WT_LAYER == 23 * MiB, "weight copies per layer");
constexpr size_t WS_CACHE = WS_WT + 2 * WT_LAYER;
constexpr size_t WS_CDK = WS_CACHE, WS_CDV = WS_CACHE + 4 * MiB, WS_CGK = WS_CACHE + 8 * MiB, WS_CGV = WS_CACHE + 9 * MiB;
constexpr size_t WS_AP = WS_CACHE + 10 * MiB;
constexpr size_t WS_PQ = WS_AP + 24 * MiB;
constexpr size_t WS_O = WS_PQ + 54 * MiB;
constexpr size_t WS_HD = WS_PQ;
constexpr size_t WS_FAST_END = WS_O + 24 * MiB;
constexpr size_t O_Y = 0, O_DK = (size_t)12288 * 1024, O_DV = O_DK + (size_t)8192 * 2 * 512, O_GK = O_DV + (size_t)8192 * 2 * 512, O_GV = O_GK + (size_t)8192 * 2 * 128;
constexpr int LDS_BYTES = 147456;

__device__ __forceinline__ unsigned f2bf(float f) { unsigned u = __builtin_bit_cast(unsigned, f); return (u + 0x7fffu + ((u >> 16) & 1u)) >> 16; }
__device__ __forceinline__ unsigned pk2(float lo, float hi) { return f2bf(lo) | (f2bf(hi) << 16); }
__device__ __forceinline__ float wave_sum(float v) {
#pragma unroll
    for (int o = 1; o < 64; o <<= 1) v += __shfl_xor(v, o);
    return v;
}
__host__ __device__ __forceinline__ int col_slot(int kind, int col) {
    int pn, bj, wc, j;
    if (kind == 0) { pn = col >> 8; const int c = col & 255; wc = c >> 6; bj = (c >> 5) & 1; j = c & 31; }
    else if (kind == 1) { pn = col >> 8; const int c = col & 255; bj = c >> 7; wc = (c >> 5) & 3; j = c & 31; }
    else { bj = col >= FH ? 1 : 0; const int cc = col - FH * bj; pn = cc >> 7; wc = (cc >> 5) & 3; j = cc & 31; }
    const int fq = j >> 3, n = (j >> 2) & 1, i = j & 3;
    return 256 * pn + 128 * bj + 32 * wc + 16 * n + 4 * fq + i;
}
__host__ __device__ __forceinline__ int slot_col(int kind, int s) {
    const int pn = s >> 8, t = s & 255, bj = t >> 7, wc = (t >> 5) & 3, n = (t >> 4) & 1, fq = (t >> 2) & 3, i = t & 3;
    if (kind == 0) return 256 * pn + 64 * wc + 32 * bj + 8 * fq + 4 * n + i;
    if (kind == 1) return 256 * pn + 128 * bj + 32 * wc + 8 * fq + 4 * n + i;
    return FH * bj + 128 * pn + 32 * wc + 8 * fq + 4 * n + i;
}

struct Args { const float* in[25]; float* out; unsigned char* ws; int ph_lo, ph_hi; };

__device__ __forceinline__ void p0_transpose_item(const float* W, int K, int N, bf16_t* WT, int kind, LAS float* scr, int item, int lane) {
    const int nblk = N / 32, kb = item / nblk, nb = item % nblk, k0 = 64 * kb, n0 = 32 * nb;
#pragma unroll 8
    for (int i = 0; i < 32; ++i) { const int kk = 2 * i + (lane >> 5); scr[kk * 33 + (lane & 31)] = W[(size_t)(k0 + kk) * N + n0 + (lane & 31)]; }
    asm volatile("s_waitcnt lgkmcnt(0)" ::: "memory");
    const int c = lane & 7;
#pragma unroll
    for (int j = 0; j < 4; ++j) { const int n = (lane >> 3) + 8 * j; const LAS float* s = scr + (8 * c) * 33 + n;
        u32x4 o; o.x = pk2(s[0 * 33], s[1 * 33]); o.y = pk2(s[2 * 33], s[3 * 33]); o.z = pk2(s[4 * 33], s[5 * 33]); o.w = pk2(s[6 * 33], s[7 * 33]);
        *(u32x4*)(WT + (size_t)col_slot(kind, n0 + n) * K + k0 + 8 * c) = o; }
    asm volatile("s_waitcnt lgkmcnt(0)" ::: "memory");
}
__device__ __forceinline__ void phase0(const Args& a, LAS unsigned char* lds) {
    int tid_ = threadIdx.x; asm volatile("" : "+v"(tid_));
    const int tid = tid_, lane = tid & 63, wid = __builtin_amdgcn_readfirstlane(tid >> 6);
    const int G = gridDim.x, bx = blockIdx.x;
    unsigned char* ws = a.ws;
    for (int u = bx; u < 192; u += G) {
        LAS float* s = (LAS float*)lds;
        LAS float* red = (LAS float*)(lds + 20480);
        for (int i = tid; i < 5 * 1024; i += 512) { const int c = i >> 10, k = i & 1023; const float x = c < 4 ? a.in[6][c * 1024 + k] : a.in[7][k]; s[i] = x / (1.f + __expf(-x)); }
        __syncthreads();
        const int l = u / 96, n0 = (u % 96) * 64;
        const float* w = a.in[8] + (size_t)l * 1024 * NMOD + (size_t)(wid * 128) * NMOD + n0 + lane;
        float a0 = 0.f, a1 = 0.f, a2 = 0.f, a3 = 0.f, a4 = 0.f;
#pragma unroll 16
        for (int k = 0; k < 128; ++k) { const float wv = w[(size_t)k * NMOD]; const int kk = wid * 128 + k;
            a0 += s[kk] * wv; a1 += s[1024 + kk] * wv; a2 += s[2048 + kk] * wv; a3 += s[3072 + kk] * wv; a4 += s[4096 + kk] * wv; }
        red[(wid * 5 + 0) * 64 + lane] = a0; red[(wid * 5 + 1) * 64 + lane] = a1; red[(wid * 5 + 2) * 64 + lane] = a2; red[(wid * 5 + 3) * 64 + lane] = a3; red[(wid * 5 + 4) * 64 + lane] = a4;
        __syncthreads();
        if (tid < 320) { const int c = tid >> 6; float sum = 0.f;
#pragma unroll
            for (int ww = 0; ww < 8; ++ww) sum += red[(ww * 5 + c) * 64 + lane];
            ((float*)(ws + WS_MOD))[(size_t)(l * 5 + c) * NMOD + n0 + lane] = sum + a.in[9][l * NMOD + n0 + lane]; }
        __syncthreads();
    }
    if (bx == G - 1 && wid < 2) {
        const int ll = wid;
        const float s1 = wave_sum(a.in[14][ll * 64 + lane] * a.in[15][ll * 64 + lane]), s2 = wave_sum(a.in[16][ll * 64 + lane] * a.in[17][ll * 64 + lane]);
        const float li = 0.8f - 0.6f * expf(-0.3f * (float)ll);
        if (lane == 0) { float* lm = (float*)(ws + WS_LAM); lm[ll] = expf(s1) - expf(s2) + li; lm[2 + ll] = li; }
    }
    {
        LAS float* scr = (LAS float*)(lds + 32768 + wid * 8704);
        const int gw = bx * 8 + wid, NGW = G * 8;
        constexpr int I_IN = 16 * 72, I_OUT = 16 * 32, I_GU = 16 * 176, I_DN = 44 * 32, I_L = I_IN + I_OUT + I_GU + I_DN;
        for (int it = gw; it < 2 * I_L; it += NGW) {
            const int l = it / I_L; int r = it % I_L;
            bf16_t* wt = (bf16_t*)(ws + WS_WT + (size_t)l * WT_LAYER);
            if (r < I_IN) { p0_transpose_item(a.in[11] + (size_t)l * D * INC, D, INC, (bf16_t*)((unsigned char*)wt + WT_IN), 0, scr, r, lane); continue; } r -= I_IN;
            if (r < I_OUT) { p0_transpose_item(a.in[21] + (size_t)l * D * D, D, D, (bf16_t*)((unsigned char*)wt + WT_OUT), 1, scr, r, lane); continue; } r -= I_OUT;
            if (r < I_GU) { p0_transpose_item(a.in[23] + (size_t)l * D * 2 * FH, D, 2 * FH, (bf16_t*)((unsigned char*)wt + WT_GU), 2, scr, r, lane); continue; } r -= I_GU;
            p0_transpose_item(a.in[24] + (size_t)l * FH * D, FH, D, (bf16_t*)((unsigned char*)wt + WT_DN), 1, scr, r, lane);
        }
    }
    {
        const size_t gt = (size_t)bx * 512 + tid, GT = (size_t)G * 512;
        constexpr size_t N_DK = 2097152 / 8, N_GK = 524288 / 8;
        for (size_t i = gt; i < 2 * N_DK + 2 * N_GK; i += GT) {
            const float* src; bf16_t* dst; size_t j = i;
            if (j < N_DK) { src = a.in[2]; dst = (bf16_t*)(ws + WS_CDK); }
            else if (j < 2 * N_DK) { j -= N_DK; src = a.in[3]; dst = (bf16_t*)(ws + WS_CDV); }
            else if (j < 2 * N_DK + N_GK) { j -= 2 * N_DK; src = a.in[4]; dst = (bf16_t*)(ws + WS_CGK); }
            else { j -= 2 * N_DK + N_GK; src = a.in[5]; dst = (bf16_t*)(ws + WS_CGV); }
            const f32x4 v0 = *(const f32x4*)(src + j * 8), v1 = *(const f32x4*)(src + j * 8 + 4);
            u32x4 o; o.x = pk2(v0[0], v0[1]); o.y = pk2(v0[2], v0[3]); o.z = pk2(v1[0], v1[1]); o.w = pk2(v1[2], v1[3]);
            *(u32x4*)(dst + j * 8) = o;
        }
        float* rope = (float*)(ws + WS_ROPE);
        for (size_t i = gt; i < 32768; i += GT) { const int t = (int)(i >> 5), ii = (int)(i & 31);
            const float pos = (ii < 16) ? (float)(t >> 6) : (float)(t & 63);
            const float freq = powf(10000.0f, -(float)(2 * (ii & 15)) / 32.0f);
            const float ang = pos * freq; rope[i] = cosf(ang); rope[32768 + i] = sinf(ang); }
    }
}
__device__ __forceinline__ void phase1(const Args& a) {
    int tid_ = threadIdx.x; asm volatile("" : "+v"(tid_));
    const int tid = tid_, lane = tid & 63, wid = __builtin_amdgcn_readfirstlane(tid >> 6);
    const int G = gridDim.x, bx = blockIdx.x;
    unsigned char* ws = a.ws;
    const float* mod = (const float*)(ws + WS_MOD);
    const size_t gt = (size_t)bx * 512 + tid, GT = (size_t)G * 512;
    { float* gt_ = (float*)(ws + WS_GTAB);
      for (size_t i = gt; i < 2 * 2 * 5 * 1024; i += GT) { const int k = (int)(i & 1023), c = (int)((i >> 10) % 5), w = (int)((i / 5120) & 1), l = (int)(i / 10240);
          const float nw = w == 0 ? a.in[10][l * D + k] : a.in[22][l * D + k];
          gt_[i] = nw * (1.f + mod[(size_t)(l * 5 + c) * NMOD + (w == 0 ? 1024 : 4096) + k]); } }
    const int gw = bx * 8 + wid, NGW = G * 8;
    for (int grp = 0; grp < 4; ++grp) {
        const int l = grp >> 1, isgu = grp & 1, nrows = isgu ? 2 * FH : INC, kind = isgu ? 2 : 0;
        const bf16_t* wt = (const bf16_t*)(ws + WS_WT + (size_t)l * WT_LAYER + (isgu ? WT_GU : WT_IN));
        float* bias = (float*)(ws + (isgu ? WS_BGU : WS_BIN)) + (size_t)l * 5 * nrows;
        float sh[5][16];
#pragma unroll
        for (int c = 0; c < 5; ++c) { const float* sp = mod + (size_t)(l * 5 + c) * NMOD + (isgu ? 3072 : 0);
#pragma unroll
            for (int h = 0; h < 2; ++h) { const f32x4 v0 = *(const f32x4*)(sp + h * 512 + lane * 8), v1 = *(const f32x4*)(sp + h * 512 + lane * 8 + 4);
                sh[c][h * 8 + 0] = v0[0]; sh[c][h * 8 + 1] = v0[1]; sh[c][h * 8 + 2] = v0[2]; sh[c][h * 8 + 3] = v0[3]; sh[c][h * 8 + 4] = v1[0]; sh[c][h * 8 + 5] = v1[1]; sh[c][h * 8 + 6] = v1[2]; sh[c][h * 8 + 7] = v1[3]; } }
        for (int s = gw; s < nrows; s += NGW) {
            const u32x4 w0 = *(const u32x4*)(wt + (size_t)s * D + lane * 8), w1 = *(const u32x4*)(wt + (size_t)s * D + 512 + lane * 8);
            float wv[16];
#pragma unroll
            for (int q = 0; q < 4; ++q) { wv[2 * q] = __uint_as_float(w0[q] << 16); wv[2 * q + 1] = __uint_as_float(w0[q] & 0xffff0000u); wv[8 + 2 * q] = __uint_as_float(w1[q] << 16); wv[8 + 2 * q + 1] = __uint_as_float(w1[q] & 0xffff0000u); }
            const int col = slot_col(kind, s);
#pragma unroll
            for (int c = 0; c < 5; ++c) { float d = 0.f;
#pragma unroll
                for (int e = 0; e < 16; ++e) d += sh[c][e] * wv[e];
                d = wave_sum(d);
                if (lane == 0) bias[(size_t)c * nrows + col] = d; }
        }
    }
    { bf16_t* AP = (bf16_t*)(ws + WS_AP); float* ssq = (float*)(ws + WS_SSQ1);
      for (int m = gw; m < MTOT; m += NGW) {
          const float* xr = m < MCTX ? a.in[0] + (size_t)m * D : a.in[1] + (size_t)(m - MCTX) * D;
          const int c = m < MCTX ? 4 : (m - MCTX) >> 10;
          const float* sc = mod + (size_t)(0 * 5 + c) * NMOD + 1024; const float* nw = a.in[10];
          float ss = 0.f;
#pragma unroll
          for (int h = 0; h < 2; ++h) { const int k = h * 512 + lane * 8;
              const f32x4 x0 = *(const f32x4*)(xr + k), x1 = *(const f32x4*)(xr + k + 4), s0 = *(const f32x4*)(sc + k), s1 = *(const f32x4*)(sc + k + 4), n0 = *(const f32x4*)(nw + k), n1 = *(const f32x4*)(nw + k + 4);
              ss += (x0[0] * x0[0] + x0[1] * x0[1]) + (x0[2] * x0[2] + x0[3] * x0[3]) + (x1[0] * x1[0] + x1[1] * x1[1]) + (x1[2] * x1[2] + x1[3] * x1[3]);
              const f32x4 y0 = x0 * (n0 * (s0 + 1.f)), y1 = x1 * (n1 * (s1 + 1.f));
              u32x4 o; o.x = pk2(y0[0], y0[1]); o.y = pk2(y0[2], y0[3]); o.z = pk2(y1[0], y1[1]); o.w = pk2(y1[2], y1[3]);
              *(u32x4*)(AP + (size_t)m * D + k) = o; }
          ss = wave_sum(ss);
          if (lane < 16) ssq[(size_t)m * 16 + lane] = lane == 0 ? ss : 0.f;
      } }
}
__device__ __forceinline__ float row_rstd(const float* ssq, int row) {
    const f32x4* sp = (const f32x4*)(ssq + (size_t)row * 16); const f32x4 s0 = sp[0], s1 = sp[1], s2 = sp[2], s3 = sp[3];
    const f32x4 t = (s0 + s1) + (s2 + s3); const float ss = (t[0] + t[1]) + (t[2] + t[3]);
    return 1.0f / sqrtf(ss * (1.f / D) + EPS);
}
struct EpiIn {
    static constexpr bool PERM = false, AFTER_DRAIN = false;
    int l; bf16_t* PQ; float* out; const float* ssq; const float* bias; const float* rope; const float *qna, *kna, *qnb, *knb;
    __device__ __forceinline__ void operator()(const f32x4 (&acc)[2][2][4][2], const pg8::Unit& u, int wr, int wc, int fr, int fq) const {
        const int pm = u.pm, pn = u.pn; const bool lat = pm >= 32; const int cond = lat ? (pm - 32) >> 2 : 4;
        const int cb = 256 * pn + 64 * wc + 8 * fq;
        const float* gain = nullptr; float gsc = 1.f;
        if (pn < 2) { gain = qna; gsc = C2; } else if (pn < 4) gain = kna; else if (pn < 6) gain = nullptr; else if (pn < 8) { gain = qnb; gsc = C2; } else if (wc < 2) gain = knb;
        float* obase = nullptr; int ocol = 0, opitch = 0;
        if (!lat) {
            if (pn == 2 || pn == 3) { obase = out + O_DK; ocol = cb - 512; opitch = 512; }
            else if (pn == 4 || pn == 5) { obase = out + O_DV; ocol = cb - 1024; opitch = 512; }
            else if (pn == 8) { if (wc < 2) { obase = out + O_GK; ocol = cb - 2048; } else { obase = out + O_GV; ocol = cb - 2176; } opitch = 128; }
        }
        f32x4 bv[2][2], gv[2][2];
#pragma unroll
        for (int bj = 0; bj < 2; ++bj)
#pragma unroll
            for (int n = 0; n < 2; ++n) { bv[bj][n] = *(const f32x4*)(bias + (size_t)cond * INC + cb + 32 * bj + 4 * n);
                gv[bj][n] = gain ? *(const f32x4*)(gain + 32 * bj + 8 * fq + 4 * n) * gsc : (f32x4){1.f, 1.f, 1.f, 1.f}; }
#pragma unroll
        for (int ai = 0; ai < 2; ++ai)
#pragma unroll
            for (int m = 0; m < 4; ++m) {
                const int row = pm * 256 + ai * 128 + wr * 64 + m * 16 + fr;
                const float rstd = row_rstd(ssq, row);
                f32x4 v[2][2];
#pragma unroll
                for (int bj = 0; bj < 2; ++bj)
#pragma unroll
                    for (int n = 0; n < 2; ++n) v[bj][n] = acc[ai][bj][m][n] * rstd + bv[bj][n];
                if (obase && pn != 2 && pn != 3 && !(pn == 8 && wc < 2)) {
                    float* op = obase + ((size_t)(pm * 2 + l) * 256 + (row & 255)) * opitch + ocol;
#pragma unroll
                    for (int bj = 0; bj < 2; ++bj) { *(f32x4*)(op + 32 * bj) = v[bj][0]; *(f32x4*)(op + 32 * bj + 4) = v[bj][1]; }
                }
                if (gain) {
                    float q = 0.f;
#pragma unroll
                    for (int bj = 0; bj < 2; ++bj)
#pragma unroll
                        for (int n = 0; n < 2; ++n) q += (v[bj][n][0] * v[bj][n][0] + v[bj][n][1] * v[bj][n][1]) + (v[bj][n][2] * v[bj][n][2] + v[bj][n][3] * v[bj][n][3]);
                    q += __shfl_xor(q, 16); q += __shfl_xor(q, 32);
                    const float rn = 1.0f / sqrtf(q * (1.f / 64.f) + EPS);
                    if (obase) {
                        float* op = obase + ((size_t)(pm * 2 + l) * 256 + (row & 255)) * opitch + ocol;
#pragma unroll
                        for (int bj = 0; bj < 2; ++bj) { *(f32x4*)(op + 32 * bj) = v[bj][0] * rn * gv[bj][0]; *(f32x4*)(op + 32 * bj + 4) = v[bj][1] * rn * gv[bj][1]; }
                    }
#pragma unroll
                    for (int bj = 0; bj < 2; ++bj)
#pragma unroll
                        for (int n = 0; n < 2; ++n) v[bj][n] = v[bj][n] * rn * gv[bj][n];
                    if (lat) {
                        const int t = (row - MCTX) & 1023;
#pragma unroll
                        for (int n = 0; n < 2; ++n) { const f32x4 cs = *(const f32x4*)(rope + (size_t)t * 32 + 8 * fq + 4 * n), sn = *(const f32x4*)(rope + 32768 + (size_t)t * 32 + 8 * fq + 4 * n);
                            const f32x4 x1 = v[0][n], x2 = v[1][n]; v[0][n] = x1 * cs - x2 * sn; v[1][n] = x2 * cs + x1 * sn; }
                    }
                }
                bf16_t* pp = PQ + (size_t)row * INC + cb;
#pragma unroll
                for (int bj = 0; bj < 2; ++bj) { u32x4 w; w.x = pg8::cvt_pk_bf16(v[bj][0][0], v[bj][0][1]); w.y = pg8::cvt_pk_bf16(v[bj][0][2], v[bj][0][3]); w.z = pg8::cvt_pk_bf16(v[bj][1][0], v[bj][1][1]); w.w = pg8::cvt_pk_bf16(v[bj][1][2], v[bj][1][3]);
                    *(u32x4*)(pp + 32 * bj) = w; }
            }
    }
};
struct EpiRes {
    static constexpr bool PERM = false, AFTER_DRAIN = false;
    const float* xin_ctx; const float* xin_lat; float* xout; const float* gate; const float* gtab; bf16_t* AP; float* ssq;
    __device__ __forceinline__ void operator()(const f32x4 (&acc)[2][2][4][2], const pg8::Unit& u, int wr, int wc, int fr, int fq) const {
        const int pm = u.pm, pn = u.pn; const bool lat = pm >= 32; const int cond = lat ? (pm - 32) >> 2 : 4;
        const int cb = 256 * pn + 32 * wc + 8 * fq;
        const float* xin = lat ? xin_lat : xin_ctx;
        f32x4 gv[2][2], Gv[2][2];
#pragma unroll
        for (int bj = 0; bj < 2; ++bj)
#pragma unroll
            for (int n = 0; n < 2; ++n) { gv[bj][n] = *(const f32x4*)(gate + (size_t)cond * NMOD + cb + 128 * bj + 4 * n);
                Gv[bj][n] = gtab ? *(const f32x4*)(gtab + (size_t)cond * D + cb + 128 * bj + 4 * n) : (f32x4){0.f, 0.f, 0.f, 0.f}; }
#pragma unroll
        for (int ai = 0; ai < 2; ++ai)
#pragma unroll
            for (int m = 0; m < 4; ++m) {
                const int row = pm * 256 + ai * 128 + wr * 64 + m * 16 + fr;
                const size_t ro = (size_t)row * D + cb;
                float ss = 0.f;
#pragma unroll
                for (int bj = 0; bj < 2; ++bj) { f32x4 xn[2];
#pragma unroll
                    for (int n = 0; n < 2; ++n) { const f32x4 xo = *(const f32x4*)(xin + ro + 128 * bj + 4 * n); xn[n] = xo + gv[bj][n] * acc[ai][bj][m][n];
                        *(f32x4*)(xout + ro + 128 * bj + 4 * n) = xn[n];
                        ss += (xn[n][0] * xn[n][0] + xn[n][1] * xn[n][1]) + (xn[n][2] * xn[n][2] + xn[n][3] * xn[n][3]); }
                    if (gtab) { const f32x4 y0 = xn[0] * Gv[bj][0], y1 = xn[1] * Gv[bj][1];
                        u32x4 w; w.x = pg8::cvt_pk_bf16(y0[0], y0[1]); w.y = pg8::cvt_pk_bf16(y0[2], y0[3]); w.z = pg8::cvt_pk_bf16(y1[0], y1[1]); w.w = pg8::cvt_pk_bf16(y1[2], y1[3]);
                        *(u32x4*)(AP + ro + 128 * bj) = w; } }
                if (gtab) { ss += __shfl_xor(ss, 16); ss += __shfl_xor(ss, 32); if (fq == 0) ssq[(size_t)row * 16 + 4 * pn + wc] = ss; }
            }
    }
};
struct EpiGU {
    static constexpr bool PERM = false, AFTER_DRAIN = false;
    bf16_t* HD; const float* ssq; const float* bias;
    __device__ __forceinline__ void operator()(const f32x4 (&acc)[2][2][4][2], const pg8::Unit& u, int wr, int wc, int fr, int fq) const {
        const int pm = u.pm, pn = u.pn; const bool lat = pm >= 32; const int cond = lat ? (pm - 32) >> 2 : 4;
        const int cbh = 128 * pn + 32 * wc + 8 * fq;
        f32x4 bg[2], bu[2];
#pragma unroll
        for (int n = 0; n < 2; ++n) { bg[n] = *(const f32x4*)(bias + (size_t)cond * 2 * FH + cbh + 4 * n); bu[n] = *(const f32x4*)(bias + (size_t)cond * 2 * FH + FH + cbh + 4 * n); }
#pragma unroll
        for (int ai = 0; ai < 2; ++ai)
#pragma unroll
            for (int m = 0; m < 4; ++m) {
                const int row = pm * 256 + ai * 128 + wr * 64 + m * 16 + fr;
                const float rstd = row_rstd(ssq, row);
                float h[8];
#pragma unroll
                for (int n = 0; n < 2; ++n) { const f32x4 g = acc[ai][0][m][n] * rstd + bg[n], uu = acc[ai][1][m][n] * rstd + bu[n];
#pragma unroll
                    for (int i = 0; i < 4; ++i) h[4 * n + i] = g[i] * __builtin_amdgcn_rcpf(1.f + __builtin_amdgcn_exp2f(-g[i] * LOG2E)) * uu[i]; }
                u32x4 w; w.x = pg8::cvt_pk_bf16(h[0], h[1]); w.y = pg8::cvt_pk_bf16(h[2], h[3]); w.z = pg8::cvt_pk_bf16(h[4], h[5]); w.w = pg8::cvt_pk_bf16(h[6], h[7]);
                *(u32x4*)(HD + (size_t)row * FH + cbh) = w;
            }
    }
};
namespace at {
constexpr int STAGE = 32768, SLOT_K = 0, SLOT_V = 16384;
struct UnitDesc { int diff; int lat; int b; int head; int qb; };
__device__ __forceinline__ v4i16_t vtr(const LAS unsigned char* p) { return __builtin_amdgcn_ds_read_tr16_b64_v4i16((LAS v4i16_t*)p); }
__device__ __forceinline__ float swap_max(float v) { auto rr = __builtin_amdgcn_permlane32_swap(__float_as_uint(v), __float_as_uint(v), false, false); return fmaxf(__uint_as_float(rr[0]), __uint_as_float(rr[1])); }
__device__ __forceinline__ float swap_sum(float v) { auto rr = __builtin_amdgcn_permlane32_swap(__float_as_uint(v), __float_as_uint(v), false, false); return __uint_as_float(rr[0]) + __uint_as_float(rr[1]); }

template <bool DIFF>
__device__ __forceinline__ void attn_unit(LAS unsigned char* lds, const UnitDesc& U, int l, const bf16_t* PQ, const unsigned char* ws, bf16_t* O, const float* subln_l) {
    constexpr int ND0 = DIFF ? 4 : 2;
    int tid_ = threadIdx.x; asm volatile("" : "+v"(tid_));
    const int tid = tid_, lane = tid & 63, r32 = lane & 31, hi = lane >> 5, wid = __builtin_amdgcn_readfirstlane(tid >> 6);
    const int comp = DIFF ? (wid >> 2) : 0;
    const int rowbase = U.lat ? MCTX + U.b * 1024 : U.b * 256;
    const int qrow0 = rowbase + (DIFF ? U.qb * 128 + (wid & 3) * 32 : U.qb * 256 + wid * 32);
    const int NOWN = U.lat ? 16 : 4, NT = U.lat ? 24 : 4;
    const int g = U.head >> 2;
    const int qcol = DIFF ? U.head * 128 + comp * 64 : 1536 + U.head * 64;
    const int kcol = DIFF ? 512 + U.head * 128 : 2048 + g * 64;
    const int vcol = DIFF ? 1024 + U.head * 128 : 2176 + g * 64;
    const bf16_t* Kown = PQ + (size_t)rowbase * INC + kcol;
    const bf16_t* Vown = PQ + (size_t)rowbase * INC + vcol;
    const bf16_t* Kc = DIFF ? (const bf16_t*)(ws + WS_CDK) + (size_t)(U.b * 2 + l) * 512 * 512 + U.head * 128 : (const bf16_t*)(ws + WS_CGK) + (size_t)(U.b * 2 + l) * 512 * 128 + g * 64;
    const bf16_t* Vc = DIFF ? (const bf16_t*)(ws + WS_CDV) + (size_t)(U.b * 2 + l) * 512 * 512 + U.head * 128 : (const bf16_t*)(ws + WS_CGV) + (size_t)(U.b * 2 + l) * 512 * 128 + g * 64;
    const int cpitch = DIFF ? 512 : 128;
    bf16x8 qr[4];
    { const bf16_t* Qw = PQ + (size_t)(qrow0 + r32) * INC + qcol;
#pragma unroll
      for (int d0 = 0; d0 < 4; ++d0) qr[d0] = *(const bf16x8*)(Qw + d0 * 16 + hi * 8); }
    auto dma = [&](int t) {
        const bool own = t < NOWN; const int tt = own ? t : t - NOWN; const int pitch = own ? INC : cpitch;
        const bf16_t* kb = (own ? Kown : Kc) + (size_t)tt * 64 * pitch;
        const bf16_t* vb = (own ? Vown : Vc) + (size_t)tt * 64 * pitch;
        LAS unsigned char* st = lds + (t & 1) * STAGE;
        __builtin_amdgcn_global_load_lds((const unsigned*)(kb + (size_t)lane * pitch + wid * 8), (LAS unsigned*)(st + SLOT_K + wid * 1024), 16, 0, 0);
        if (DIFF) __builtin_amdgcn_global_load_lds((const unsigned*)(kb + 64 + (size_t)lane * pitch + wid * 8), (LAS unsigned*)(st + SLOT_K + 8192 + wid * 1024), 16, 0, 0);
        { const int p = wid; __builtin_amdgcn_global_load_lds((const unsigned*)(vb + (size_t)(16 * (p & 3) + (lane >> 2)) * pitch + (p >> 2) * 32 + (lane & 3) * 8), (LAS unsigned*)(st + SLOT_V + p * 1024), 16, 0, 0); }
        if (DIFF) { const int p = wid + 8; __builtin_amdgcn_global_load_lds((const unsigned*)(vb + (size_t)(16 * (p & 3) + (lane >> 2)) * pitch + (p >> 2) * 32 + (lane & 3) * 8), (LAS unsigned*)(st + SLOT_V + p * 1024), 16, 0, 0); }
    };
    f32x16 o[ND0];
#pragma unroll
    for (int d0 = 0; d0 < ND0; ++d0) o[d0] = f32x16{};
    float mrun = -1e30f, lrun = 0.f;
    dma(0);
    for (int t = 0; t < NT; ++t) {
        asm volatile("s_waitcnt vmcnt(0)" ::: "memory");
        __builtin_amdgcn_s_barrier();
        asm volatile("" ::: "memory");
        if (t + 1 < NT) dma(t + 1);
        const LAS unsigned char* st = lds + (t & 1) * STAGE;
        const LAS unsigned char* kp = st + SLOT_K + comp * 8192 + hi * 1024 + r32 * 16;
        f32x16 p0 = f32x16{}, p1 = f32x16{};
#pragma unroll
        for (int d0 = 0; d0 < 4; ++d0) {
            const bf16x8 b0 = *(const LAS bf16x8*)(kp + d0 * 2048), b1 = *(const LAS bf16x8*)(kp + d0 * 2048 + 512);
            p0 = __builtin_amdgcn_mfma_f32_32x32x16_bf16(b0, qr[d0], p0, 0, 0, 0);
            p1 = __builtin_amdgcn_mfma_f32_32x32x16_bf16(b1, qr[d0], p1, 0, 0, 0);
        }
        float rm = fmaxf(p0[0], p1[0]);
#pragma unroll
        for (int r = 1; r < 16; ++r) rm = fmaxf(rm, fmaxf(p0[r], p1[r]));
        rm = swap_max(rm);
        const float mn = fmaxf(mrun, rm), f = __builtin_amdgcn_exp2f(mrun - mn);
        mrun = mn;
        float ls = 0.f;
#pragma unroll
        for (int r = 0; r < 16; ++r) { p0[r] = __builtin_amdgcn_exp2f(p0[r] - mn); p1[r] = __builtin_amdgcn_exp2f(p1[r] - mn); ls += p0[r] + p1[r]; }
        lrun = lrun * f + ls;
#pragma unroll
        for (int d0 = 0; d0 < ND0; ++d0)
#pragma unroll
            for (int r = 0; r < 16; ++r) o[d0][r] *= f;
        u32x4 pw[4];
#pragma unroll
        for (int q = 0; q < 4; ++q) { pw[0][q] = pg8::cvt_pk_bf16(p0[2 * q], p0[2 * q + 1]); pw[1][q] = pg8::cvt_pk_bf16(p0[8 + 2 * q], p0[8 + 2 * q + 1]);
                                      pw[2][q] = pg8::cvt_pk_bf16(p1[2 * q], p1[2 * q + 1]); pw[3][q] = pg8::cvt_pk_bf16(p1[8 + 2 * q], p1[8 + 2 * q + 1]); }
        const LAS unsigned char* vp = st + SLOT_V + ((lane >> 4) & 1) * 32 + (lane & 3) * 8 + (4 * hi + ((lane & 15) >> 2)) * 64;
#pragma unroll
        for (int d0 = 0; d0 < ND0; ++d0)
#pragma unroll
            for (int ks = 0; ks < 4; ++ks) {
                const v4i16_t lo = vtr(vp + d0 * 4096 + ks * 1024), hh = vtr(vp + d0 * 4096 + ks * 1024 + 512);
                const bf16x8 vf = (bf16x8){lo[0], lo[1], lo[2], lo[3], hh[0], hh[1], hh[2], hh[3]};
                o[d0] = __builtin_amdgcn_mfma_f32_32x32x16_bf16(vf, __builtin_bit_cast(bf16x8, pw[ks]), o[d0], 0, 0, 0);
            }
    }
    lrun = swap_sum(lrun);
    const float inv = 1.0f / lrun;
#pragma unroll
    for (int d0 = 0; d0 < ND0; ++d0)
#pragma unroll
        for (int r = 0; r < 16; ++r) o[d0][r] *= inv;
    const int orow = qrow0 + r32;
    if (DIFF) {
        const float lam = ((const float*)(ws + WS_LAM))[l], li = ((const float*)(ws + WS_LAM))[2 + l];
        asm volatile("s_waitcnt lgkmcnt(0)" ::: "memory");
        __builtin_amdgcn_s_barrier();
        asm volatile("" ::: "memory");
        LAS float* xch = (LAS float*)(lds + (wid & 3) * 16384);
        if (comp == 1) {
#pragma unroll
            for (int d0 = 0; d0 < ND0; ++d0)
#pragma unroll
                for (int r = 0; r < 16; ++r) xch[(d0 * 16 + r) * 64 + lane] = o[d0][r];
        }
        asm volatile("s_waitcnt lgkmcnt(0)" ::: "memory");
        __builtin_amdgcn_s_barrier();
        asm volatile("" ::: "memory");
        if (comp == 0) {
            float ss = 0.f;
#pragma unroll
            for (int d0 = 0; d0 < ND0; ++d0)
#pragma unroll
                for (int r = 0; r < 16; ++r) { o[d0][r] -= lam * xch[(d0 * 16 + r) * 64 + lane]; ss += o[d0][r] * o[d0][r]; }
            ss = swap_sum(ss);
            const float rs = (1.0f / sqrtf(ss * (1.f / 128.f) + EPS)) * (1.f - li);
            bf16_t* op = O + (size_t)orow * D + U.head * 128;
#pragma unroll
            for (int d0 = 0; d0 < ND0; ++d0)
#pragma unroll
                for (int q = 0; q < 4; ++q) { const int dv0 = 32 * d0 + 8 * q + 4 * hi; const f32x4 sw = *(const f32x4*)(subln_l + dv0);
                    u32x2 w; w.x = pg8::cvt_pk_bf16(o[d0][4 * q] * rs * sw[0], o[d0][4 * q + 1] * rs * sw[1]); w.y = pg8::cvt_pk_bf16(o[d0][4 * q + 2] * rs * sw[2], o[d0][4 * q + 3] * rs * sw[3]);
                    *(u32x2*)(op + dv0) = w; }
        }
    } else {
        bf16_t* op = O + (size_t)orow * D + 512 + U.head * 64;
#pragma unroll
        for (int d0 = 0; d0 < ND0; ++d0)
#pragma unroll
            for (int q = 0; q < 4; ++q) { const int dv0 = 32 * d0 + 8 * q + 4 * hi;
                u32x2 w; w.x = pg8::cvt_pk_bf16(o[d0][4 * q], o[d0][4 * q + 1]); w.y = pg8::cvt_pk_bf16(o[d0][4 * q + 2], o[d0][4 * q + 3]);
                *(u32x2*)(op + dv0) = w; }
    }
    asm volatile("s_waitcnt lgkmcnt(0)" ::: "memory");
    __builtin_amdgcn_s_barrier();
    asm volatile("" ::: "memory");
}
__device__ __forceinline__ UnitDesc mk_ld(int i) { UnitDesc u; u.diff = 1; u.lat = 1; u.b = i >> 5; u.head = (i >> 3) & 3; u.qb = i & 7; return u; }
__device__ __forceinline__ UnitDesc mk_lg(int i) { UnitDesc u; u.diff = 0; u.lat = 1; u.b = i >> 5; u.head = (i >> 2) & 7; u.qb = i & 3; return u; }
__device__ __forceinline__ UnitDesc mk_cd(int i) { UnitDesc u; u.diff = 1; u.lat = 0; u.b = i >> 3; u.head = (i >> 1) & 3; u.qb = i & 1; return u; }
__device__ __forceinline__ UnitDesc mk_cg(int i) { UnitDesc u; u.diff = 0; u.lat = 0; u.b = i >> 3; u.head = i & 7; u.qb = 0; return u; }
__device__ __forceinline__ void run_unit(LAS unsigned char* lds, const UnitDesc& U, int l, const bf16_t* PQ, const unsigned char* ws, bf16_t* O, const float* subln_l) {
    if (U.diff) attn_unit<true>(lds, U, l, PQ, ws, O, subln_l); else attn_unit<false>(lds, U, l, PQ, ws, O, subln_l);
}
__device__ __forceinline__ void attn_phase(LAS unsigned char* lds, int l, const bf16_t* PQ, const unsigned char* ws, bf16_t* O, const float* subln_l) {
    const int G = gridDim.x, j = blockIdx.x;
    if (G == 256) {
        if (j < 128) { run_unit(lds, mk_ld(j), l, PQ, ws, O, subln_l); run_unit(lds, mk_cg(j), l, PQ, ws, O, subln_l); }
        else { const int k = j - 128; run_unit(lds, mk_lg(k), l, PQ, ws, O, subln_l); run_unit(lds, mk_cd(2 * k), l, PQ, ws, O, subln_l); run_unit(lds, mk_cd(2 * k + 1), l, PQ, ws, O, subln_l); run_unit(lds, mk_cg(j), l, PQ, ws, O, subln_l); }
    } else {
        for (int i = j; i < 768; i += G) { UnitDesc u; if (i < 128) u = mk_ld(i); else if (i < 256) u = mk_lg(i - 128); else if (i < 512) u = mk_cd(i - 256); else u = mk_cg(i - 512); run_unit(lds, u, l, PQ, ws, O, subln_l); }
    }
}
}
#ifndef PHMASK
#define PHMASK 127
#endif
__global__ void __launch_bounds__(512, 2) fwd(Args a) {
    extern __shared__ __attribute__((aligned(16))) unsigned char lds_raw[];
    LAS unsigned char* lds = (LAS unsigned char*)lds_raw;
    cg::grid_group grid = cg::this_grid();
    unsigned char* ws = a.ws;
    const int G = gridDim.x;
    for (int ph = a.ph_lo; ph < a.ph_hi; ++ph) {
        if (ph == 0) { if (PHMASK & 1) phase0(a, lds); }
        else if (ph == 1) { if (PHMASK & 2) phase1(a); }
        else {
            const int l = (ph - 2) / 5, k = (ph - 2) % 5;
            const unsigned char* wt = ws + WS_WT + (size_t)l * WT_LAYER;
            const float* mod_l = (const float*)(ws + WS_MOD) + (size_t)l * 5 * NMOD;
            if (k == 0) { if (PHMASK & 4) {
                pg8::Gemm g{(const bf16_t*)(ws + WS_AP), (const bf16_t*)(wt + WT_IN), MTOT, INC, D}; pg8::StaticOrder S; S.init(MTOT, INC, G, (int)blockIdx.x);
                EpiIn E{l, (bf16_t*)(ws + WS_PQ), a.out, (const float*)(ws + WS_SSQ1), (const float*)(ws + WS_BIN) + (size_t)l * 5 * INC, (const float*)(ws + WS_ROPE),
                        a.in[12] + l * 64, a.in[13] + l * 64, a.in[19] + l * 64, a.in[20] + l * 64};
                pg8::gemm_phase<EpiIn, pg8::StaticOrder, true, true>(lds, g, S, E); }
            } else if (k == 1) {
                if (PHMASK & 8) at::attn_phase(lds, l, (const bf16_t*)(ws + WS_PQ), ws, (bf16_t*)(ws + WS_O), a.in[18] + l * 128);
            } else if (k == 2) { if (PHMASK & 16) {
                pg8::Gemm g{(const bf16_t*)(ws + WS_O), (const bf16_t*)(wt + WT_OUT), MTOT, D, D}; pg8::StaticOrder S; S.init(MTOT, D, G, (int)blockIdx.x);
                EpiRes E{l == 0 ? a.in[0] : a.out, l == 0 ? a.in[1] - (size_t)MCTX * D : a.out, a.out, mod_l + 2048, (const float*)(ws + WS_GTAB) + (size_t)(l * 2 + 1) * 5 * D, (bf16_t*)(ws + WS_AP), (float*)(ws + WS_SSQ2)};
                pg8::gemm_phase<EpiRes, pg8::StaticOrder, true, true>(lds, g, S, E); }
            } else if (k == 3) { if (PHMASK & 32) {
                pg8::Gemm g{(const bf16_t*)(ws + WS_AP), (const bf16_t*)(wt + WT_GU), MTOT, 2 * FH, D}; pg8::StaticOrder S; S.init(MTOT, 2 * FH, G, (int)blockIdx.x);
                EpiGU E{(bf16_t*)(ws + WS_HD), (const float*)(ws + WS_SSQ2), (const float*)(ws + WS_BGU) + (size_t)l * 5 * 2 * FH};
                pg8::gemm_phase<EpiGU, pg8::StaticOrder, true, true>(lds, g, S, E); }
            } else { if (PHMASK & 64) {
                pg8::Gemm g{(const bf16_t*)(ws + WS_HD), (const bf16_t*)(wt + WT_DN), MTOT, D, FH}; pg8::StaticOrder S; S.init(MTOT, D, G, (int)blockIdx.x);
                EpiRes E{a.out, a.out, a.out, mod_l + 5120, l == 0 ? (const float*)(ws + WS_GTAB) + (size_t)(1 * 2 + 0) * 5 * D : nullptr, (bf16_t*)(ws + WS_AP), (float*)(ws + WS_SSQ1)};
                pg8::gemm_phase<EpiRes, pg8::StaticOrder, true, true>(lds, g, S, E); }
            }
        }
        if (ph + 1 < a.ph_hi) grid.sync();
    }
}
constexpr int N_PHASES = 12;
static int g_grid = 0;
static int fast_grid() {
    if (g_grid == 0) {
        int dev = 0, cus = 0, per_cu = 0;
        if (hipGetDevice(&dev) != hipSuccess || hipDeviceGetAttribute(&cus, hipDeviceAttributeMultiprocessorCount, dev) != hipSuccess) { fprintf(stderr, "device query failed\n"); g_grid = -1; return g_grid; }
        if (hipFuncSetAttribute((const void*)fwd, hipFuncAttributeMaxDynamicSharedMemorySize, LDS_BYTES) != hipSuccess) { fprintf(stderr, "hipFuncSetAttribute failed\n"); g_grid = -1; return g_grid; }
        if (hipOccupancyMaxActiveBlocksPerMultiprocessor(&per_cu, (const void*)fwd, 512, LDS_BYTES) != hipSuccess || per_cu < 1) { fprintf(stderr, "occupancy query: %d blocks per CU\n", per_cu); (void)hipGetLastError(); per_cu = 1; }
        g_grid = cus;
    }
    return g_grid;
}
static Args make_args(void* const* d_in, void* d_out, void* d_ws) { Args a{}; for (int i = 0; i < 25; ++i) a.in[i] = (const float*)d_in[i]; a.out = (float*)d_out; a.ws = (unsigned char*)d_ws; return a; }
static void launch_phases(void* const* d_in, void* d_out, void* d_ws, int lo, int hi, hipStream_t stream) {
    const int grid = fast_grid(); if (grid <= 0) return;
    Args a = make_args(d_in, d_out, d_ws); a.ph_lo = lo; a.ph_hi = hi;
    void* args[] = {&a};
    hipError_t e = hipLaunchCooperativeKernel((const void*)fwd, dim3(grid), dim3(512), args, LDS_BYTES, stream);
    if (e != hipSuccess) fprintf(stderr, "cooperative launch failed: %s (grid %d)\n", hipGetErrorString(e), grid);
}
#undef LAS
}
extern "C" void kernel_launch(void* const* d_in, const int* in_sizes, int n_in, void* d_out, int out_size, void* d_ws, size_t ws_size, hipStream_t stream) {
    (void)in_sizes; (void)n_in; (void)out_size; (void)ws_size;
    fx::launch_phases(d_in, d_out, d_ws, 0, fx::N_PHASES, stream);
}
```

```cpp
#include <hip/hip_runtime.h>
#include <hip/hip_cooperative_groups.h>
#include <hip/hip_bf16.h>
#include <cstdio>
#include <cstdint>
#include <cmath>
namespace cg = cooperative_groups;

namespace pg8 {
#define PG8_LAS __attribute__((address_space(3)))
typedef unsigned short bf16_t;
typedef short bf16x8 __attribute__((ext_vector_type(8)));
typedef float f32x4 __attribute__((ext_vector_type(4)));
typedef unsigned u32x4 __attribute__((ext_vector_type(4)));
constexpr int BM = 256, BK = 64, HALF = 128, HTB = HALF * BK * 2  , STAGE_BYTES = 8 * HTB, NXCD = 8, WGM = 8;

__host__ __device__ __forceinline__ int lds_byte(int r, int c) { const int st = (r >> 4) * 2 + (c >> 5), rr = r & 15, cc = c & 31, ob = rr * 64 + cc * 2; return st * 1024 + (ob ^ (((ob >> 9) & 1) << 5)); }
__host__ __device__ __forceinline__ void stage_rc(int b, int& R, int& C) { const int st = b / 1024, sb = b % 1024, swz = sb ^ (((sb >> 9) & 1) << 5); R = (st >> 1) * 16 + swz / 64; C = (st & 1) * 32 + (swz % 64) / 2; }
__host__ __device__ __forceinline__ int perm32(int rho) { const int n = rho >> 4, i = rho & 15; return 8 * (i >> 2) + 4 * n + (i & 3); }

struct Unit { int pm, pn; };
struct Gemm { const bf16_t* A; const bf16_t* Bt; int M, N, K; };

struct StaticOrder {
    int nM, nN, nwg, G, c;
    __host__ __device__ void init(int M, int N, int G_, int c_) { nM = M / BM; nN = N / BM; nwg = nM * nN; G = G_; c = c_; }
    __host__ __device__ bool next(int i, Unit& u) const {
        const long L = (long)i * G + c; if (L >= nwg) return false;
        int wgid = (int)L; { const int q = nwg / NXCD, r = nwg % NXCD, xcd = wgid % NXCD, off = wgid / NXCD; wgid = (xcd < r ? xcd * (q + 1) : r * (q + 1) + (xcd - r) * q) + off; }
        const int nig = WGM * nN, gid = wgid / nig, fm = gid * WGM, gsz = (nM - fm) < WGM ? (nM - fm) : WGM;
        u.pm = fm + ((wgid % nig) % gsz); u.pn = (wgid % nig) / gsz; return true;
    }
    __device__ __forceinline__ void a_ready(const Unit&) const {}
    __device__ __forceinline__ void done(const Unit&) const {}
};

__device__ __forceinline__ unsigned cvt_pk_bf16(float lo, float hi) { unsigned r; asm volatile("v_cvt_pk_bf16_f32 %0, %1, %2" : "=v"(r) : "v"(lo), "v"(hi)); return r; }
template <class Epi, class Sched, bool ALIGN_EPI = false, bool SP2 = false>
__device__ __forceinline__ void gemm_phase(PG8_LAS unsigned char* lds, const Gemm g, const Sched& S, const Epi& E) {
    int tid_ = threadIdx.x; asm volatile("" : "+v"(tid_));
    const int tid = tid_, wid = __builtin_amdgcn_readfirstlane(tid >> 6), lane = tid & 63, wr = wid >> 2, wc = wid & 3, fr = lane & 15, fq = lane >> 4;
    const int K = g.K, nt = K / BK;
    unsigned voffA[2], voffB[2];
#pragma unroll
    for (int i = 0; i < 2; ++i) { int R, C; stage_rc(tid * 16 + i * 8192, R, C); const int Rb = Epi::PERM ? ((R & ~31) + perm32(R & 31)) : R;
        voffA[i] = (unsigned)(R * K + C) * 2u; voffB[i] = (unsigned)(Rb * K + C) * 2u; }
    const size_t kstep = (size_t)(BK * 2);
    const size_t hstep = (size_t)HALF * K * 2;
    const size_t tstep = 2 * hstep;
    const unsigned ldsw = (unsigned)wid * 1024u;
    const int aoff = lds_byte(wr * 64 + fr, fq * 8), boff = lds_byte(wc * 32 + fr, fq * 8);
#define PG8_SA(b, h) (((b) * 2 + (h)) * HTB)
#define PG8_SB(b, h) ((4 + (b) * 2 + (h)) * HTB)
#define PG8_STAGE(bufoff, gbase, voff) do { _Pragma("unroll") for (int _i = 0; _i < 2; ++_i) \
        __builtin_amdgcn_global_load_lds((const unsigned*)((const char*)(gbase) + (voff)[_i]), (PG8_LAS unsigned*)(lds + (bufoff) + ldsw + _i * 8192), 16, 0, 0); } while (0)
#define PG8_LDA(dst, b, h) do { _Pragma("unroll") for (int m = 0; m < 4; ++m) _Pragma("unroll") for (int k = 0; k < 2; ++k) dst[m][k] = *(const PG8_LAS bf16x8*)(lds + PG8_SA(b, h) + aoff + m * 2048 + k * 1024); } while (0)
#define PG8_LDB(dst, b, h) do { _Pragma("unroll") for (int n = 0; n < 2; ++n) _Pragma("unroll") for (int k = 0; k < 2; ++k) dst[n][k] = *(const PG8_LAS bf16x8*)(lds + PG8_SB(b, h) + boff + n * 2048 + k * 1024); } while (0)
#define PG8_MMA(ai, bj, At, Bt) do { __builtin_amdgcn_s_setprio(1); _Pragma("unroll") for (int m = 0; m < 4; ++m) _Pragma("unroll") for (int n = 0; n < 2; ++n) _Pragma("unroll") for (int k = 0; k < 2; ++k) \
        acc[ai][bj][m][n] = __builtin_amdgcn_mfma_f32_16x16x32_bf16(Bt[n][k], At[m][k], acc[ai][bj][m][n], 0, 0, 0); __builtin_amdgcn_s_setprio(0); } while (0)
#define PG8_WAIT_V(n) asm volatile("s_waitcnt vmcnt(" #n ")" ::: "memory")
#define PG8_WAIT_L(n) asm volatile("s_waitcnt lgkmcnt(" #n ")" ::: "memory")
#define PG8_BAR __builtin_amdgcn_s_barrier()
#define PG8_SCHED __builtin_amdgcn_sched_barrier(0)
    Unit cur, nxt; int ui = 0;
    if (!S.next(0, cur)) return;
    f32x4 acc[2][2][4][2];
#pragma unroll
    for (int a = 0; a < 2; ++a)
#pragma unroll
        for (int b = 0; b < 2; ++b)
#pragma unroll
            for (int m = 0; m < 4; ++m)
#pragma unroll
                for (int n = 0; n < 2; ++n) acc[a][b][m][n] = (f32x4){0.f, 0.f, 0.f, 0.f};
    bf16x8 At[4][2], B0[2][2], B1[2][2];
    const char* cA = (const char*)g.A + (size_t)cur.pm * tstep; const char* cB = (const char*)g.Bt + (size_t)cur.pn * tstep;
    S.a_ready(cur);
    if constexpr (SP2) {
        PG8_STAGE(PG8_SB(0, 0), cB, voffB); PG8_STAGE(PG8_SB(0, 1), cB + hstep, voffB); PG8_STAGE(PG8_SA(0, 0), cA, voffA); PG8_STAGE(PG8_SA(0, 1), cA + hstep, voffA);
        if (wr == 1) PG8_BAR;
        PG8_WAIT_V(2); PG8_BAR;
        PG8_STAGE(PG8_SB(1, 0), cB + kstep, voffB); PG8_STAGE(PG8_SA(1, 0), cA + kstep, voffA); PG8_STAGE(PG8_SB(1, 1), cB + hstep + kstep, voffB);
        PG8_WAIT_V(6); PG8_BAR;
    } else {
        PG8_STAGE(PG8_SB(0, 0), cB, voffB); PG8_STAGE(PG8_SA(0, 0), cA, voffA); PG8_STAGE(PG8_SB(0, 1), cB + hstep, voffB); PG8_STAGE(PG8_SA(0, 1), cA + hstep, voffA);
        if (wr == 1) PG8_BAR;
        PG8_WAIT_V(4); PG8_BAR;
        PG8_STAGE(PG8_SB(1, 0), cB + kstep, voffB); PG8_STAGE(PG8_SA(1, 0), cA + kstep, voffA); PG8_STAGE(PG8_SB(1, 1), cB + hstep + kstep, voffB);
        PG8_WAIT_V(6); PG8_BAR;
    }
    for (;;) {
        const bool has_next = S.next(ui + 1, nxt);
        const char* nA = has_next ? (const char*)g.A + (size_t)nxt.pm * tstep : cA; const char* nB = has_next ? (const char*)g.Bt + (size_t)nxt.pn * tstep : cB;
        for (int t = 0; t < nt; t += 2) {
            const bool last = (t == nt - 2);
            const char* a1 = cA + (size_t)(t + 1) * kstep;
            const char* a2 = last ? nA : cA + (size_t)(t + 2) * kstep; const char* b2 = last ? nB : cB + (size_t)(t + 2) * kstep;
            const char* a3 = a2 + kstep; const char* b3 = b2 + kstep;
            if (last && has_next) S.a_ready(nxt);
            if constexpr (SP2) {
            PG8_LDB(B0, 0, 0); PG8_LDB(B1, 0, 1); PG8_SCHED; PG8_LDA(At, 0, 0); PG8_STAGE(PG8_SA(1, 1), a1 + hstep, voffA);
            PG8_WAIT_V(8); PG8_WAIT_L(0); PG8_BAR; PG8_MMA(0, 0, At, B0); PG8_MMA(0, 1, At, B1); PG8_BAR; PG8_SCHED;
            PG8_LDA(At, 0, 1); PG8_STAGE(PG8_SB(0, 0), b2, voffB); PG8_STAGE(PG8_SB(0, 1), b2 + hstep, voffB); PG8_STAGE(PG8_SA(0, 0), a2, voffA);
            PG8_WAIT_V(8); PG8_WAIT_L(0); PG8_BAR; PG8_MMA(1, 0, At, B0); PG8_MMA(1, 1, At, B1); PG8_BAR; PG8_SCHED;
            PG8_LDB(B0, 1, 0); PG8_LDB(B1, 1, 1); PG8_SCHED; PG8_LDA(At, 1, 0); PG8_STAGE(PG8_SA(0, 1), a2 + hstep, voffA);
            PG8_WAIT_V(8); PG8_WAIT_L(0); PG8_BAR; PG8_MMA(0, 0, At, B0); PG8_MMA(0, 1, At, B1); PG8_BAR; PG8_SCHED;
            PG8_LDA(At, 1, 1); PG8_STAGE(PG8_SB(1, 0), b3, voffB); PG8_STAGE(PG8_SB(1, 1), b3 + hstep, voffB); PG8_STAGE(PG8_SA(1, 0), a3, voffA);
            PG8_WAIT_V(8); PG8_WAIT_L(0); PG8_BAR; PG8_MMA(1, 0, At, B0); PG8_MMA(1, 1, At, B1); PG8_BAR; PG8_SCHED;
            } else {
            PG8_LDB(B0, 0, 0); PG8_SCHED; PG8_LDA(At, 0, 0); PG8_STAGE(PG8_SA(1, 1), a1 + hstep, voffA);
            PG8_WAIT_L(8); PG8_BAR; PG8_WAIT_L(0); PG8_MMA(0, 0, At, B0); PG8_BAR; PG8_SCHED;
            PG8_LDB(B1, 0, 1); PG8_STAGE(PG8_SB(0, 0), b2, voffB);
            PG8_BAR; PG8_WAIT_L(0); PG8_MMA(0, 1, At, B1); PG8_BAR;
            PG8_LDA(At, 0, 1); PG8_STAGE(PG8_SA(0, 0), a2, voffA);
            PG8_BAR; PG8_WAIT_L(0); PG8_MMA(1, 0, At, B0); PG8_BAR; PG8_SCHED;
            PG8_STAGE(PG8_SB(0, 1), b2 + hstep, voffB);
            PG8_WAIT_V(6); PG8_BAR; PG8_MMA(1, 1, At, B1); PG8_BAR;
            PG8_LDB(B0, 1, 0); PG8_SCHED; PG8_LDA(At, 1, 0); PG8_STAGE(PG8_SA(0, 1), a2 + hstep, voffA);
            PG8_WAIT_L(8); PG8_BAR; PG8_WAIT_L(0); PG8_MMA(0, 0, At, B0); PG8_BAR; PG8_SCHED;
            PG8_LDB(B1, 1, 1); PG8_STAGE(PG8_SB(1, 0), b3, voffB);
            PG8_BAR; PG8_WAIT_L(0); PG8_MMA(0, 1, At, B1); PG8_BAR;
            PG8_LDA(At, 1, 1); PG8_STAGE(PG8_SA(1, 0), a3, voffA);
            PG8_BAR; PG8_WAIT_L(0); PG8_MMA(1, 0, At, B0); PG8_BAR; PG8_SCHED;
            PG8_STAGE(PG8_SB(1, 1), b3 + hstep, voffB);
            PG8_WAIT_V(6); PG8_BAR; PG8_MMA(1, 1, At, B1); PG8_BAR;
            }
        }
        if constexpr (ALIGN_EPI) { if (wr == 0) PG8_BAR; }
        if constexpr (!Epi::AFTER_DRAIN) { E(acc, cur, wr, wc, fr, fq); S.done(cur); }
        if (!has_next) break;
#pragma unroll
        for (int a = 0; a < 2; ++a)
#pragma unroll
            for (int b = 0; b < 2; ++b)
#pragma unroll
                for (int m = 0; m < 4; ++m)
#pragma unroll
                    for (int n = 0; n < 2; ++n) acc[a][b][m][n] = (f32x4){0.f, 0.f, 0.f, 0.f};
        cur = nxt; cA = nA; cB = nB; ++ui;
        if constexpr (ALIGN_EPI) { if (wr == 1) PG8_BAR; }
    }
    PG8_WAIT_V(0);
    if constexpr (!ALIGN_EPI) { if (wr == 0) PG8_BAR; }
    PG8_BAR;
    if constexpr (Epi::AFTER_DRAIN) { E.fused(acc, cur, wr, wc, fr, fq, lds, wid, lane); S.done(cur); }
#undef PG8_SA
#undef PG8_SB
#undef PG8_STAGE
#undef PG8_LDA
#undef PG8_LDB
#undef PG8_MMA
#undef PG8_WAIT_V
#undef PG8_WAIT_L
#undef PG8_BAR
#undef PG8_SCHED
}
}
namespace fx {
using pg8::bf16_t; using pg8::bf16x8; using pg8::f32x4; using pg8::u32x4;
#define LAS __attribute__((address_space(3)))
typedef float f32x16 __attribute__((ext_vector_type(16)));
typedef unsigned u32x2 __attribute__((ext_vector_type(2)));
typedef short v4i16_t __attribute__((ext_vector_type(4)));
constexpr int D = 1024, INC = 2304, FH = 2816, NMOD = 6144, MTOT = 12288, MCTX = 8192;
constexpr float EPS = 1e-6f;
constexpr float LOG2E = 1.4426950408889634f;
constexpr float C2 = 0.125f * LOG2E;
constexpr size_t MiB = 1u << 20;
constexpr size_t WS_MOD = 0;
constexpr size_t WS_LAM = 256 * 1024;
constexpr size_t WS_GTAB = 320 * 1024;
constexpr size_t WS_BIN = 512 * 1024;
constexpr size_t WS_BGU = 768 * 1024;
constexpr size_t WS_ROPE = 1 * MiB;
constexpr size_t WS_SSQ1 = 2 * MiB;
constexpr size_t WS_SSQ2 = 3 * MiB;
constexpr size_t WS_CTL = 3840 * 1024, CTL_BYTES = 16384;
constexpr size_t WS_WT = 4 * MiB;
constexpr size_t WT_IN = 0, WT_OUT = 4718592, WT_GU = WT_OUT + 2097152, WT_DN = WT_GU + 11534336, WT_LAYER = WT_DN + 5767168;
static_assert(WT_LAYER == 23 * MiB, "weight copies per layer");
constexpr size_t WS_CACHE = WS_WT + 2 * WT_LAYER;
constexpr size_t WS_CDK = WS_CACHE, WS_CDV = WS_CACHE + 4 * MiB, WS_CGK = WS_CACHE + 8 * MiB, WS_CGV = WS_CACHE + 9 * MiB;
constexpr size_t WS_AP = WS_CACHE + 10 * MiB;
constexpr size_t WS_PQ = WS_AP + 24 * MiB;
constexpr size_t WS_O = WS_PQ + 54 * MiB;
constexpr size_t WS_HD = WS_PQ;
constexpr size_t WS_FAST_END = WS_O + 24 * MiB;
constexpr size_t O_Y = 0, O_DK = (size_t)12288 * 1024, O_DV = O_DK + (size_t)8192 * 2 * 512, O_GK = O_DV + (size_t)8192 * 2 * 512, O_GV = O_GK + (size_t)8192 * 2 * 128;
constexpr int LDS_BYTES = 147456;

__device__ __forceinline__ unsigned f2bf(float f) { unsigned u = __builtin_bit_cast(unsigned, f); return (u + 0x7fffu + ((u >> 16) & 1u)) >> 16; }
__device__ __forceinline__ unsigned pk2(float lo, float hi) { return f2bf(lo) | (f2bf(hi) << 16); }
__device__ __forceinline__ float wave_sum(float v) {
#pragma unroll
    for (int o = 1; o < 64; o <<= 1) v += __shfl_xor(v, o);
    return v;
}
__host__ __device__ __forceinline__ int col_slot(int kind, int col) {
    int pn, bj, wc, j;
    if (kind == 0) { pn = col >> 8; const int c = col & 255; wc = c >> 6; bj = (c >> 5) & 1; j = c & 31; }
    else if (kind == 1) { pn = col >> 8; const int c = col & 255; bj = c >> 7; wc = (c >> 5) & 3; j = c & 31; }
    else { bj = col >= FH ? 1 : 0; const int cc = col - FH * bj; pn = cc >> 7; wc = (cc >> 5) & 3; j = cc & 31; }
    const int fq = j >> 3, n = (j >> 2) & 1, i = j & 3;
    return 256 * pn + 128 * bj + 32 * wc + 16 * n + 4 * fq + i;
}
__host__ __device__ __forceinline__ int slot_col(int kind, int s) {
    const int pn = s >> 8, t = s & 255, bj = t >> 7, wc = (t >> 5) & 3, n = (t >> 4) & 1, fq = (t >> 2) & 3, i = t & 3;
    if (kind == 0) return 256 * pn + 64 * wc + 32 * bj + 8 * fq + 4 * n + i;
    if (kind == 1) return 256 * pn + 128 * bj + 32 * wc + 8 * fq + 4 * n + i;
    return FH * bj + 128 * pn + 32 * wc + 8 * fq + 4 * n + i;
}

struct Args { const float* in[25]; float* out; unsigned char* ws; int ph_lo, ph_hi; };

__device__ __forceinline__ void p0_transpose_item(const float* W, int K, int N, bf16_t* WT, int kind, LAS float* scr, int item, int lane) {
    const int nblk = N / 32, kb = item / nblk, nb = item % nblk, k0 = 64 * kb, n0 = 32 * nb;
#pragma unroll 8
    for (int i = 0; i < 32; ++i) { const int kk = 2 * i + (lane >> 5); scr[kk * 33 + (lane & 31)] = W[(size_t)(k0 + kk) * N + n0 + (lane & 31)]; }
    asm volatile("s_waitcnt lgkmcnt(0)" ::: "memory");
    const int c = lane & 7;
#pragma unroll
    for (int j = 0; j < 4; ++j) { const int n = (lane >> 3) + 8 * j; const LAS float* s = scr + (8 * c) * 33 + n;
        u32x4 o; o.x = pk2(s[0 * 33], s[1 * 33]); o.y = pk2(s[2 * 33], s[3 * 33]); o.z = pk2(s[4 * 33], s[5 * 33]); o.w = pk2(s[6 * 33], s[7 * 33]);
        *(u32x4*)(WT + (size_t)col_slot(kind, n0 + n) * K + k0 + 8 * c) = o; }
    asm volatile("s_waitcnt lgkmcnt(0)" ::: "memory");
}
__device__ __forceinline__ void phase0(const Args& a, LAS unsigned char* lds) {
    int tid_ = threadIdx.x; asm volatile("" : "+v"(tid_));
    const int tid = tid_, lane = tid & 63, wid = __builtin_amdgcn_readfirstlane(tid >> 6);
    const int G = gridDim.x, bx = blockIdx.x;
    unsigned char* ws = a.ws;
    for (int u = bx; u < 192; u += G) {
        LAS float* s = (LAS float*)lds;
        LAS float* red = (LAS float*)(lds + 20480);
        for (int i = tid; i < 5 * 1024; i += 512) { const int c = i >> 10, k = i & 1023; const float x = c < 4 ? a.in[6][c * 1024 + k] : a.in[7][k]; s[i] = x / (1.f + __expf(-x)); }
        __syncthreads();
        const int l = u / 96, n0 = (u % 96) * 64;
        const float* w = a.in[8] + (size_t)l * 1024 * NMOD + (size_t)(wid * 128) * NMOD + n0 + lane;
        float a0 = 0.f, a1 = 0.f, a2 = 0.f, a3 = 0.f, a4 = 0.f;
#pragma unroll 16
        for (int k = 0; k < 128; ++k) { const float wv = w[(size_t)k * NMOD]; const int kk = wid * 128 + k;
            a0 += s[kk] * wv; a1 += s[1024 + kk] * wv; a2 += s[2048 + kk] * wv; a3 += s[3072 + kk] * wv; a4 += s[4096 + kk] * wv; }
        red[(wid * 5 + 0) * 64 + lane] = a0; red[(wid * 5 + 1) * 64 + lane] = a1; red[(wid * 5 + 2) * 64 + lane] = a2; red[(wid * 5 + 3) * 64 + lane] = a3; red[(wid * 5 + 4) * 64 + lane] = a4;
        __syncthreads();
        if (tid < 320) { const int c = tid >> 6; float sum = 0.f;
#pragma unroll
            for (int ww = 0; ww < 8; ++ww) sum += red[(ww * 5 + c) * 64 + lane];
            ((float*)(ws + WS_MOD))[(size_t)(l * 5 + c) * NMOD + n0 + lane] = sum + a.in[9][l * NMOD + n0 + lane]; }
        __syncthreads();
    }
    if (bx == G - 1 && wid < 2) {
        const int ll = wid;
        const float s1 = wave_sum(a.in[14][ll * 64 + lane] * a.in[15][ll * 64 + lane]), s2 = wave_sum(a.in[16][ll * 64 + lane] * a.in[17][ll * 64 + lane]);
        const float li = 0.8f - 0.6f * expf(-0.3f * (float)ll);
        if (lane == 0) { float* lm = (float*)(ws + WS_LAM); lm[ll] = expf(s1) - expf(s2) + li; lm[2 + ll] = li; }
    }
    {
        LAS float* scr = (LAS float*)(lds + 32768 + wid * 8704);
        const int gw = bx * 8 + wid, NGW = G * 8;
        constexpr int I_IN = 16 * 72, I_OUT = 16 * 32, I_GU = 16 * 176, I_DN = 44 * 32, I_L = I_IN + I_OUT + I_GU + I_DN;
        for (int it = gw; it < 2 * I_L; it += NGW) {
            const int l = it / I_L; int r = it % I_L;
            bf16_t* wt = (bf16_t*)(ws + WS_WT + (size_t)l * WT_LAYER);
            if (r < I_IN) { p0_transpose_item(a.in[11] + (size_t)l * D * INC, D, INC, (bf16_t*)((unsigned char*)wt + WT_IN), 0, scr, r, lane); continue; } r -= I_IN;
            if (r < I_OUT) { p0_transpose_item(a.in[21] + (size_t)l * D * D, D, D, (bf16_t*)((unsigned char*)wt + WT_OUT), 1, scr, r, lane); continue; } r -= I_OUT;
            if (r < I_GU) { p0_transpose_item(a.in[23] + (size_t)l * D * 2 * FH, D, 2 * FH, (bf16_t*)((unsigned char*)wt + WT_GU), 2, scr, r, lane); continue; } r -= I_GU;
            p0_transpose_item(a.in[24] + (size_t)l * FH * D, FH, D, (bf16_t*)((unsigned char*)wt + WT_DN), 1, scr, r, lane);
        }
    }
    {
        const size_t gt = (size_t)bx * 512 + tid, GT = (size_t)G * 512;
        constexpr size_t N_DK = 2097152 / 8, N_GK = 524288 / 8;
        for (size_t i = gt; i < 2 * N_DK + 2 * N_GK; i += GT) {
            const float* src; bf16_t* dst; size_t j = i;
            if (j < N_DK) { src = a.in[2]; dst = (bf16_t*)(ws + WS_CDK); }
            else if (j < 2 * N_DK) { j -= N_DK; src = a.in[3]; dst = (bf16_t*)(ws + WS_CDV); }
            else if (j < 2 * N_DK + N_GK) { j -= 2 * N_DK; src = a.in[4]; dst = (bf16_t*)(ws + WS_CGK); }
            else { j -= 2 * N_DK + N_GK; src = a.in[5]; dst = (bf16_t*)(ws + WS_CGV); }
            const f32x4 v0 = *(const f32x4*)(src + j * 8), v1 = *(const f32x4*)(src + j * 8 + 4);
            u32x4 o; o.x = pk2(v0[0], v0[1]); o.y = pk2(v0[2], v0[3]); o.z = pk2(v1[0], v1[1]); o.w = pk2(v1[2], v1[3]);
            *(u32x4*)(dst + j * 8) = o;
        }
        float* rope = (float*)(ws + WS_ROPE);
        for (size_t i = gt; i < 32768; i += GT) { const int t = (int)(i >> 5), ii = (int)(i & 31);
            const float pos = (ii < 16) ? (float)(t >> 6) : (float)(t & 63);
            const float freq = powf(10000.0f, -(float)(2 * (ii & 15)) / 32.0f);
            const float ang = pos * freq; rope[i] = cosf(ang); rope[32768 + i] = sinf(ang); }
    }
}
__device__ __forceinline__ void phase1(const Args& a) {
    int tid_ = threadIdx.x; asm volatile("" : "+v"(tid_));
    const int tid = tid_, lane = tid & 63, wid = __builtin_amdgcn_readfirstlane(tid >> 6);
    const int G = gridDim.x, bx = blockIdx.x;
    unsigned char* ws = a.ws;
    const float* mod = (const float*)(ws + WS_MOD);
    const size_t gt = (size_t)bx * 512 + tid, GT = (size_t)G * 512;
    { float* gt_ = (float*)(ws + WS_GTAB);
      for (size_t i = gt; i < 2 * 2 * 5 * 1024; i += GT) { const int k = (int)(i & 1023), c = (int)((i >> 10) % 5), w = (int)((i / 5120) & 1), l = (int)(i / 10240);
          const float nw = w == 0 ? a.in[10][l * D + k] : a.in[22][l * D + k];
          gt_[i] = nw * (1.f + mod[(size_t)(l * 5 + c) * NMOD + (w == 0 ? 1024 : 4096) + k]); } }
    const int gw = bx * 8 + wid, NGW = G * 8;
    for (int grp = 0; grp < 4; ++grp) {
        const int l = grp >> 1, isgu = grp & 1, nrows = isgu ? 2 * FH : INC, kind = isgu ? 2 : 0;
        const bf16_t* wt = (const bf16_t*)(ws + WS_WT + (size_t)l * WT_LAYER + (isgu ? WT_GU : WT_IN));
        float* bias = (float*)(ws + (isgu ? WS_BGU : WS_BIN)) + (size_t)l * 5 * nrows;
        float sh[5][16];
#pragma unroll
        for (int c = 0; c < 5; ++c) { const float* sp = mod + (size_t)(l * 5 + c) * NMOD + (isgu ? 3072 : 0);
#pragma unroll
            for (int h = 0; h < 2; ++h) { const f32x4 v0 = *(const f32x4*)(sp + h * 512 + lane * 8), v1 = *(const f32x4*)(sp + h * 512 + lane * 8 + 4);
                sh[c][h * 8 + 0] = v0[0]; sh[c][h * 8 + 1] = v0[1]; sh[c][h * 8 + 2] = v0[2]; sh[c][h * 8 + 3] = v0[3]; sh[c][h * 8 + 4] = v1[0]; sh[c][h * 8 + 5] = v1[1]; sh[c][h * 8 + 6] = v1[2]; sh[c][h * 8 + 7] = v1[3]; } }
        for (int s = gw; s < nrows; s += NGW) {
            const u32x4 w0 = *(const u32x4*)(wt + (size_t)s * D + lane * 8), w1 = *(const u32x4*)(wt + (size_t)s * D + 512 + lane * 8);
            float wv[16];
#pragma unroll
            for (int q = 0; q < 4; ++q) { wv[2 * q] = __uint_as_float(w0[q] << 16); wv[2 * q + 1] = __uint_as_float(w0[q] & 0xffff0000u); wv[8 + 2 * q] = __uint_as_float(w1[q] << 16); wv[8 + 2 * q + 1] = __uint_as_float(w1[q] & 0xffff0000u); }
            const int col = slot_col(kind, s);
#pragma unroll
            for (int c = 0; c < 5; ++c) { float d = 0.f;
#pragma unroll
                for (int e = 0; e < 16; ++e) d += sh[c][e] * wv[e];
                d = wave_sum(d);
                if (lane == 0) bias[(size_t)c * nrows + col] = d; }
        }
    }
    { bf16_t* AP = (bf16_t*)(ws + WS_AP); float* ssq = (float*)(ws + WS_SSQ1);
      for (int m = gw; m < MTOT; m += NGW) {
          const float* xr = m < MCTX ? a.in[0] + (size_t)m * D : a.in[1] + (size_t)(m - MCTX) * D;
          const int c = m < MCTX ? 4 : (m - MCTX) >> 10;
          const float* sc = mod + (size_t)(0 * 5 + c) * NMOD + 1024; const float* nw = a.in[10];
          float ss = 0.f;
#pragma unroll
          for (int h = 0; h < 2; ++h) { const int k = h * 512 + lane * 8;
              const f32x4 x0 = *(const f32x4*)(xr + k), x1 = *(const f32x4*)(xr + k + 4), s0 = *(const f32x4*)(sc + k), s1 = *(const f32x4*)(sc + k + 4), n0 = *(const f32x4*)(nw + k), n1 = *(const f32x4*)(nw + k + 4);
              ss += (x0[0] * x0[0] + x0[1] * x0[1]) + (x0[2] * x0[2] + x0[3] * x0[3]) + (x1[0] * x1[0] + x1[1] * x1[1]) + (x1[2] * x1[2] + x1[3] * x1[3]);
              const f32x4 y0 = x0 * (n0 * (s0 + 1.f)), y1 = x1 * (n1 * (s1 + 1.f));
              u32x4 o; o.x = pk2(y0[0], y0[1]); o.y = pk2(y0[2], y0[3]); o.z = pk2(y1[0], y1[1]); o.w = pk2(y1[2], y1[3]);
              *(u32x4*)(AP + (size_t)m * D + k) = o; }
          ss = wave_sum(ss);
          if (lane < 16) ssq[(size_t)m * 16 + lane] = lane == 0 ? ss : 0.f;
      } }
}
__device__ __forceinline__ float row_rstd(const float* ssq, int row) {
    const f32x4* sp = (const f32x4*)(ssq + (size_t)row * 16); const f32x4 s0 = sp[0], s1 = sp[1], s2 = sp[2], s3 = sp[3];
    const f32x4 t = (s0 + s1) + (s2 + s3); const float ss = (t[0] + t[1]) + (t[2] + t[3]);
    return 1.0f / sqrtf(ss * (1.f / D) + EPS);
}
struct EpiIn {
    static constexpr bool PERM = false, AFTER_DRAIN = false;
    int l; bf16_t* PQ; float* out; const float* ssq; const float* bias; const float* rope; const float *qna, *kna, *qnb, *knb;
    __device__ __forceinline__ void operator()(const f32x4 (&acc)[2][2][4][2], const pg8::Unit& u, int wr, int wc, int fr, int fq) const {
        const int pm = u.pm, pn = u.pn; const bool lat = pm >= 32; const int cond = lat ? (pm - 32) >> 2 : 4;
        const int cb = 256 * pn + 64 * wc + 8 * fq;
        const float* gain = nullptr; float gsc = 1.f;
        if (pn < 2) { gain = qna; gsc = C2; } else if (pn < 4) gain = kna; else if (pn < 6) gain = nullptr; else if (pn < 8) { gain = qnb; gsc = C2; } else if (wc < 2) gain = knb;
        float* obase = nullptr; int ocol = 0, opitch = 0;
        if (!lat) {
            if (pn == 2 || pn == 3) { obase = out + O_DK; ocol = cb - 512; opitch = 512; }
            else if (pn == 4 || pn == 5) { obase = out + O_DV; ocol = cb - 1024; opitch = 512; }
            else if (pn == 8) { if (wc < 2) { obase = out + O_GK; ocol = cb - 2048; } else { obase = out + O_GV; ocol = cb - 2176; } opitch = 128; }
        }
        f32x4 bv[2][2], gv[2][2];
#pragma unroll
        for (int bj = 0; bj < 2; ++bj)
#pragma unroll
            for (int n = 0; n < 2; ++n) { bv[bj][n] = *(const f32x4*)(bias + (size_t)cond * INC + cb + 32 * bj + 4 * n);
                gv[bj][n] = gain ? *(const f32x4*)(gain + 32 * bj + 8 * fq + 4 * n) * gsc : (f32x4){1.f, 1.f, 1.f, 1.f}; }
#pragma unroll
        for (int ai = 0; ai < 2; ++ai)
#pragma unroll
            for (int m = 0; m < 4; ++m) {
                const int row = pm * 256 + ai * 128 + wr * 64 + m * 16 + fr;
                const float rstd = row_rstd(ssq, row);
                f32x4 v[2][2];
#pragma unroll
                for (int bj = 0; bj < 2; ++bj)
#pragma unroll
                    for (int n = 0; n < 2; ++n) v[bj][n] = acc[ai][bj][m][n] * rstd + bv[bj][n];
                if (obase && pn != 2 && pn != 3 && !(pn == 8 && wc < 2)) {
                    float* op = obase + ((size_t)(pm * 2 + l) * 256 + (row & 255)) * opitch + ocol;
#pragma unroll
                    for (int bj = 0; bj < 2; ++bj) { *(f32x4*)(op + 32 * bj) = v[bj][0]; *(f32x4*)(op + 32 * bj + 4) = v[bj][1]; }
                }
                if (gain) {
                    float q = 0.f;
#pragma unroll
                    for (int bj = 0; bj < 2; ++bj)
#pragma unroll
                        for (int n = 0; n < 2; ++n) q += (v[bj][n][0] * v[bj][n][0] + v[bj][n][1] * v[bj][n][1]) + (v[bj][n][2] * v[bj][n][2] + v[bj][n][3] * v[bj][n][3]);
                    q += __shfl_xor(q, 16); q += __shfl_xor(q, 32);
                    const float rn = 1.0f / sqrtf(q * (1.f / 64.f) + EPS);
                    if (obase) {
                        float* op = obase + ((size_t)(pm * 2 + l) * 256 + (row & 255)) * opitch + ocol;
#pragma unroll
                        for (int bj = 0; bj < 2; ++bj) { *(f32x4*)(op + 32 * bj) = v[bj][0] * rn * gv[bj][0]; *(f32x4*)(op + 32 * bj + 4) = v[bj][1] * rn * gv[bj][1]; }
                    }
#pragma unroll
                    for (int bj = 0; bj < 2; ++bj)
#pragma unroll
                        for (int n = 0; n < 2; ++n) v[bj][n] = v[bj][n] * rn * gv[bj][n];
                    if (lat) {
                        const int t = (row - MCTX) & 1023;
#pragma unroll
                        for (int n = 0; n < 2; ++n) { const f32x4 cs = *(const f32x4*)(rope + (size_t)t * 32 + 8 * fq + 4 * n), sn = *(const f32x4*)(rope + 32768 + (size_t)t * 32 + 8 * fq + 4 * n);
                            const f32x4 x1 = v[0][n], x2 = v[1][n]; v[0][n] = x1 * cs - x2 * sn; v[1][n] = x2 * cs + x1 * sn; }
                    }
                }
                bf16_t* pp = PQ + (size_t)row * INC + cb;
#pragma unroll
                for (int bj = 0; bj < 2; ++bj) { u32x4 w; w.x = pg8::cvt_pk_bf16(v[bj][0][0], v[bj][0][1]); w.y = pg8::cvt_pk_bf16(v[bj][0][2], v[bj][0][3]); w.z = pg8::cvt_pk_bf16(v[bj][1][0], v[bj][1][1]); w.w = pg8::cvt_pk_bf16(v[bj][1][2], v[bj][1][3]);
                    *(u32x4*)(pp + 32 * bj) = w; }
            }
    }
};
struct EpiRes {
    static constexpr bool PERM = false, AFTER_DRAIN = false;
    const float* xin_ctx; const float* xin_lat; float* xout; const float* gate; const float* gtab; bf16_t* AP; float* ssq;
    __device__ __forceinline__ void operator()(const f32x4 (&acc)[2][2][4][2], const pg8::Unit& u, int wr, int wc, int fr, int fq) const {
        const int pm = u.pm, pn = u.pn; const bool lat = pm >= 32; const int cond = lat ? (pm - 32) >> 2 : 4;
        const int cb = 256 * pn + 32 * wc + 8 * fq;
        const float* xin = lat ? xin_lat : xin_ctx;
        f32x4 gv[2][2], Gv[2][2];
#pragma unroll
        for (int bj = 0; bj < 2; ++bj)
#pragma unroll
            for (int n = 0; n < 2; ++n) { gv[bj][n] = *(const f32x4*)(gate + (size_t)cond * NMOD + cb + 128 * bj + 4 * n);
                Gv[bj][n] = gtab ? *(const f32x4*)(gtab + (size_t)cond * D + cb + 128 * bj + 4 * n) : (f32x4){0.f, 0.f, 0.f, 0.f}; }
#pragma unroll
        for (int ai = 0; ai < 2; ++ai)
#pragma unroll
            for (int m = 0; m < 4; ++m) {
                const int row = pm * 256 + ai * 128 + wr * 64 + m * 16 + fr;
                const size_t ro = (size_t)row * D + cb;
                float ss = 0.f;
#pragma unroll
                for (int bj = 0; bj < 2; ++bj) { f32x4 xn[2];
#pragma unroll
                    for (int n = 0; n < 2; ++n) { const f32x4 xo = *(const f32x4*)(xin + ro + 128 * bj + 4 * n); xn[n] = xo + gv[bj][n] * acc[ai][bj][m][n];
                        *(f32x4*)(xout + ro + 128 * bj + 4 * n) = xn[n];
                        ss += (xn[n][0] * xn[n][0] + xn[n][1] * xn[n][1]) + (xn[n][2] * xn[n][2] + xn[n][3] * xn[n][3]); }
                    if (gtab) { const f32x4 y0 = xn[0] * Gv[bj][0], y1 = xn[1] * Gv[bj][1];
                        u32x4 w; w.x = pg8::cvt_pk_bf16(y0[0], y0[1]); w.y = pg8::cvt_pk_bf16(y0[2], y0[3]); w.z = pg8::cvt_pk_bf16(y1[0], y1[1]); w.w = pg8::cvt_pk_bf16(y1[2], y1[3]);
                        *(u32x4*)(AP + ro + 128 * bj) = w; } }
                if (gtab) { ss += __shfl_xor(ss, 16); ss += __shfl_xor(ss, 32); if (fq == 0) ssq[(size_t)row * 16 + 4 * pn + wc] = ss; }
            }
    }
};
struct EpiGU {
    static constexpr bool PERM = false, AFTER_DRAIN = false;
    bf16_t* HD; const float* ssq; const float* bias;
    __device__ __forceinline__ void operator()(const f32x4 (&acc)[2][2][4][2], const pg8::Unit& u, int wr, int wc, int fr, int fq) const {
        const int pm = u.pm, pn = u.pn; const bool lat = pm >= 32; const int cond = lat ? (pm - 32) >> 2 : 4;
        const int cbh = 128 * pn + 32 * wc + 8 * fq;
        f32x4 bg[2], bu[2];
#pragma unroll
        for (int n = 0; n < 2; ++n) { bg[n] = *(const f32x4*)(bias + (size_t)cond * 2 * FH + cbh + 4 * n); bu[n] = *(const f32x4*)(bias + (size_t)cond * 2 * FH + FH + cbh + 4 * n); }
#pragma unroll
        for (int ai = 0; ai < 2; ++ai)
#pragma unroll
            for (int m = 0; m < 4; ++m) {
                const int row = pm * 256 + ai * 128 + wr * 64 + m * 16 + fr;
                const float rstd = row_rstd(ssq, row);
                float h[8];
#pragma unroll
                for (int n = 0; n < 2; ++n) { const f32x4 g = acc[ai][0][m][n] * rstd + bg[n], uu = acc[ai][1][m][n] * rstd + bu[n];
#pragma unroll
                    for (int i = 0; i < 4; ++i) h[4 * n + i] = g[i] * __builtin_amdgcn_rcpf(1.f + __builtin_amdgcn_exp2f(-g[i] * LOG2E)) * uu[i]; }
                u32x4 w; w.x = pg8::cvt_pk_bf16(h[0], h[1]); w.y = pg8::cvt_pk_bf16(h[2], h[3]); w.z = pg8::cvt_pk_bf16(h[4], h[5]); w.w = pg8::cvt_pk_bf16(h[6], h[7]);
                *(u32x4*)(HD + (size_t)row * FH + cbh) = w;
            }
    }
};
namespace at {
constexpr int STAGE = 32768, SLOT_K = 0, SLOT_V = 16384;
struct UnitDesc { int diff; int lat; int b; int head; int qb; };
__device__ __forceinline__ v4i16_t vtr(const LAS unsigned char* p) { return __builtin_amdgcn_ds_read_tr16_b64_v4i16((LAS v4i16_t*)p); }
__device__ __forceinline__ float swap_max(float v) { auto rr = __builtin_amdgcn_permlane32_swap(__float_as_uint(v), __float_as_uint(v), false, false); return fmaxf(__uint_as_float(rr[0]), __uint_as_float(rr[1])); }
__device__ __forceinline__ float swap_sum(float v) { auto rr = __builtin_amdgcn_permlane32_swap(__float_as_uint(v), __float_as_uint(v), false, false); return __uint_as_float(rr[0]) + __uint_as_float(rr[1]); }

template <bool DIFF>
__device__ __forceinline__ void attn_unit(LAS unsigned char* lds, const UnitDesc& U, int l, const bf16_t* PQ, const unsigned char* ws, bf16_t* O, const float* subln_l) {
    constexpr int ND0 = DIFF ? 4 : 2;
    int tid_ = threadIdx.x; asm volatile("" : "+v"(tid_));
    const int tid = tid_, lane = tid & 63, r32 = lane & 31, hi = lane >> 5, wid = __builtin_amdgcn_readfirstlane(tid >> 6);
    const int comp = DIFF ? (wid >> 2) : 0;
    const int rowbase = U.lat ? MCTX + U.b * 1024 : U.b * 256;
    const int qrow0 = rowbase + (DIFF ? U.qb * 128 + (wid & 3) * 32 : U.qb * 256 + wid * 32);
    const int NOWN = U.lat ? 16 : 4, NT = U.lat ? 24 : 4;
    const int g = U.head >> 2;
    const int qcol = DIFF ? U.head * 128 + comp * 64 : 1536 + U.head * 64;
    const int kcol = DIFF ? 512 + U.head * 128 : 2048 + g * 64;
    const int vcol = DIFF ? 1024 + U.head * 128 : 2176 + g * 64;
    const bf16_t* Kown = PQ + (size_t)rowbase * INC + kcol;
    const bf16_t* Vown = PQ + (size_t)rowbase * INC + vcol;
    const bf16_t* Kc = DIFF ? (const bf16_t*)(ws + WS_CDK) + (size_t)(U.b * 2 + l) * 512 * 512 + U.head * 128 : (const bf16_t*)(ws + WS_CGK) + (size_t)(U.b * 2 + l) * 512 * 128 + g * 64;
    const bf16_t* Vc = DIFF ? (const bf16_t*)(ws + WS_CDV) + (size_t)(U.b * 2 + l) * 512 * 512 + U.head * 128 : (const bf16_t*)(ws + WS_CGV) + (size_t)(U.b * 2 + l) * 512 * 128 + g * 64;
    const int cpitch = DIFF ? 512 : 128;
    bf16x8 qr[4];
    { const bf16_t* Qw = PQ + (size_t)(qrow0 + r32) * INC + qcol;
#pragma unroll
      for (int d0 = 0; d0 < 4; ++d0) qr[d0] = *(const bf16x8*)(Qw + d0 * 16 + hi * 8); }
    auto dma = [&](int t) {
        const bool own = t < NOWN; const int tt = own ? t : t - NOWN; const int pitch = own ? INC : cpitch;
        const bf16_t* kb = (own ? Kown : Kc) + (size_t)tt * 64 * pitch;
        const bf16_t* vb = (own ? Vown : Vc) + (size_t)tt * 64 * pitch;
        LAS unsigned char* st = lds + (t & 1) * STAGE;
        __builtin_amdgcn_global_load_lds((const unsigned*)(kb + (size_t)lane * pitch + wid * 8), (LAS unsigned*)(st + SLOT_K + wid * 1024), 16, 0, 0);
        if (DIFF) __builtin_amdgcn_global_load_lds((const unsigned*)(kb + 64 + (size_t)lane * pitch + wid * 8), (LAS unsigned*)(st + SLOT_K + 8192 + wid * 1024), 16, 0, 0);
        { const int p = wid; __builtin_amdgcn_global_load_lds((const unsigned*)(vb + (size_t)(16 * (p & 3) + (lane >> 2)) * pitch + (p >> 2) * 32 + (lane & 3) * 8), (LAS unsigned*)(st + SLOT_V + p * 1024), 16, 0, 0); }
        if (DIFF) { const int p = wid + 8; __builtin_amdgcn_global_load_lds((const unsigned*)(vb + (size_t)(16 * (p & 3) + (lane >> 2)) * pitch + (p >> 2) * 32 + (lane & 3) * 8), (LAS unsigned*)(st + SLOT_V + p * 1024), 16, 0, 0); }
    };
    f32x16 o[ND0];
#pragma unroll
    for (int d0 = 0; d0 < ND0; ++d0) o[d0] = f32x16{};
    float mrun = -1e30f, lrun = 0.f;
    dma(0);
    for (int t = 0; t < NT; ++t) {
        asm volatile("s_waitcnt vmcnt(0)" ::: "memory");
        __builtin_amdgcn_s_barrier();
        asm volatile("" ::: "memory");
        if (t + 1 < NT) dma(t + 1);
        const LAS unsigned char* st = lds + (t & 1) * STAGE;
        const LAS unsigned char* kp = st + SLOT_K + comp * 8192 + hi * 1024 + r32 * 16;
        f32x16 p0 = f32x16{}, p1 = f32x16{};
#pragma unroll
        for (int d0 = 0; d0 < 4; ++d0) {
            const bf16x8 b0 = *(const LAS bf16x8*)(kp + d0 * 2048), b1 = *(const LAS bf16x8*)(kp + d0 * 2048 + 512);
            p0 = __builtin_amdgcn_mfma_f32_32x32x16_bf16(b0, qr[d0], p0, 0, 0, 0);
            p1 = __builtin_amdgcn_mfma_f32_32x32x16_bf16(b1, qr[d0], p1, 0, 0, 0);
        }
        float rm = fmaxf(p0[0], p1[0]);
#pragma unroll
        for (int r = 1; r < 16; ++r) rm = fmaxf(rm, fmaxf(p0[r], p1[r]));
        rm = swap_max(rm);
        const float mn = fmaxf(mrun, rm), f = __builtin_amdgcn_exp2f(mrun - mn);
        mrun = mn;
        float ls = 0.f;
#pragma unroll
        for (int r = 0; r < 16; ++r) { p0[r] = __builtin_amdgcn_exp2f(p0[r] - mn); p1[r] = __builtin_amdgcn_exp2f(p1[r] - mn); ls += p0[r] + p1[r]; }
        lrun = lrun * f + ls;
#pragma unroll
        for (int d0 = 0; d0 < ND0; ++d0)
#pragma unroll
            for (int r = 0; r < 16; ++r) o[d0][r] *= f;
        u32x4 pw[4];
#pragma unroll
        for (int q = 0; q < 4; ++q) { pw[0][q] = pg8::cvt_pk_bf16(p0[2 * q], p0[2 * q + 1]); pw[1][q] = pg8::cvt_pk_bf16(p0[8 + 2 * q], p0[8 + 2 * q + 1]);
                                      pw[2][q] = pg8::cvt_pk_bf16(p1[2 * q], p1[2 * q + 1]); pw[3][q] = pg8::cvt_pk_bf16(p1[8 + 2 * q], p1[8 + 2 * q + 1]); }
        const LAS unsigned char* vp = st + SLOT_V + ((lane >> 4) & 1) * 32 + (lane & 3) * 8 + (4 * hi + ((lane & 15) >> 2)) * 64;
#pragma unroll
        for (int d0 = 0; d0 < ND0; ++d0)
#pragma unroll
            for (int ks = 0; ks < 4; ++ks) {
                const v4i16_t lo = vtr(vp + d0 * 4096 + ks * 1024), hh = vtr(vp + d0 * 4096 + ks * 1024 + 512);
                const bf16x8 vf = (bf16x8){lo[0], lo[1], lo[2], lo[3], hh[0], hh[1], hh[2], hh[3]};
                o[d0] = __builtin_amdgcn_mfma_f32_32x32x16_bf16(vf, __builtin_bit_cast(bf16x8, pw[ks]), o[d0], 0, 0, 0);
            }
    }
    lrun = swap_sum(lrun);
    const float inv = 1.0f / lrun;
#pragma unroll
    for (int d0 = 0; d0 < ND0; ++d0)
#pragma unroll
        for (int r = 0; r < 16; ++r) o[d0][r] *= inv;
    const int orow = qrow0 + r32;
    if (DIFF) {
        const float lam = ((const float*)(ws + WS_LAM))[l], li = ((const float*)(ws + WS_LAM))[2 + l];
        asm volatile("s_waitcnt lgkmcnt(0)" ::: "memory");
        __builtin_amdgcn_s_barrier();
        asm volatile("" ::: "memory");
        LAS float* xch = (LAS float*)(lds + (wid & 3) * 16384);
        if (comp == 1) {
#pragma unroll
            for (int d0 = 0; d0 < ND0; ++d0)
#pragma unroll
                for (int r = 0; r < 16; ++r) xch[(d0 * 16 + r) * 64 + lane] = o[d0][r];
        }
        asm volatile("s_waitcnt lgkmcnt(0)" ::: "memory");
        __builtin_amdgcn_s_barrier();
        asm volatile("" ::: "memory");
        if (comp == 0) {
            float ss = 0.f;
#pragma unroll
            for (int d0 = 0; d0 < ND0; ++d0)
#pragma unroll
                for (int r = 0; r < 16; ++r) { o[d0][r] -= lam * xch[(d0 * 16 + r) * 64 + lane]; ss += o[d0][r] * o[d0][r]; }
            ss = swap_sum(ss);
            const float rs = (1.0f / sqrtf(ss * (1.f / 128.f) + EPS)) * (1.f - li);
            bf16_t* op = O + (size_t)orow * D + U.head * 128;
#pragma unroll
            for (int d0 = 0; d0 < ND0; ++d0)
#pragma unroll
                for (int q = 0; q < 4; ++q) { const int dv0 = 32 * d0 + 8 * q + 4 * hi; const f32x4 sw = *(const f32x4*)(subln_l + dv0);
                    u32x2 w; w.x = pg8::cvt_pk_bf16(o[d0][4 * q] * rs * sw[0], o[d0][4 * q + 1] * rs * sw[1]); w.y = pg8::cvt_pk_bf16(o[d0][4 * q + 2] * rs * sw[2], o[d0][4 * q + 3] * rs * sw[3]);
                    *(u32x2*)(op + dv0) = w; }
        }
    } else {
        bf16_t* op = O + (size_t)orow * D + 512 + U.head * 64;
#pragma unroll
        for (int d0 = 0; d0 < ND0; ++d0)
#pragma unroll
            for (int q = 0; q < 4; ++q) { const int dv0 = 32 * d0 + 8 * q + 4 * hi;
                u32x2 w; w.x = pg8::cvt_pk_bf16(o[d0][4 * q], o[d0][4 * q + 1]); w.y = pg8::cvt_pk_bf16(o[d0][4 * q + 2], o[d0][4 * q + 3]);
                *(u32x2*)(op + dv0) = w; }
    }
    asm volatile("s_waitcnt lgkmcnt(0)" ::: "memory");
    __builtin_amdgcn_s_barrier();
    asm volatile("" ::: "memory");
}
__device__ __forceinline__ UnitDesc mk_ld(int i) { UnitDesc u; u.diff = 1; u.lat = 1; u.b = i >> 5; u.head = (i >> 3) & 3; u.qb = i & 7; return u; }
__device__ __forceinline__ UnitDesc mk_lg(int i) { UnitDesc u; u.diff = 0; u.lat = 1; u.b = i >> 5; u.head = (i >> 2) & 7; u.qb = i & 3; return u; }
__device__ __forceinline__ UnitDesc mk_cd(int i) { UnitDesc u; u.diff = 1; u.lat = 0; u.b = i >> 3; u.head = (i >> 1) & 3; u.qb = i & 1; return u; }
__device__ __forceinline__ UnitDesc mk_cg(int i) { UnitDesc u; u.diff = 0; u.lat = 0; u.b = i >> 3; u.head = i & 7; u.qb = 0; return u; }
__device__ __forceinline__ void run_unit(LAS unsigned char* lds, const UnitDesc& U, int l, const bf16_t* PQ, const unsigned char* ws, bf16_t* O, const float* subln_l) {
    if (U.diff) attn_unit<true>(lds, U, l, PQ, ws, O, subln_l); else attn_unit<false>(lds, U, l, PQ, ws, O, subln_l);
}
__device__ __forceinline__ void attn_phase(LAS unsigned char* lds, int l, const bf16_t* PQ, const unsigned char* ws, bf16_t* O, const float* subln_l) {
    const int G = gridDim.x, j = blockIdx.x;
    if (G == 256) {
        if (j < 128) { run_unit(lds, mk_ld(j), l, PQ, ws, O, subln_l); run_unit(lds, mk_cg(j), l, PQ, ws, O, subln_l); }
        else { const int k = j - 128; run_unit(lds, mk_lg(k), l, PQ, ws, O, subln_l); run_unit(lds, mk_cd(2 * k), l, PQ, ws, O, subln_l); run_unit(lds, mk_cd(2 * k + 1), l, PQ, ws, O, subln_l); run_unit(lds, mk_cg(j), l, PQ, ws, O, subln_l); }
    } else {
        for (int i = j; i < 768; i += G) { UnitDesc u; if (i < 128) u = mk_ld(i); else if (i < 256) u = mk_lg(i - 128); else if (i < 512) u = mk_cd(i - 256); else u = mk_cg(i - 512); run_unit(lds, u, l, PQ, ws, O, subln_l); }
    }
}
}
#define RLX_AGENT __ATOMIC_RELAXED, __HIP_MEMORY_SCOPE_AGENT
#define XB_TMO      128
#define XB_XCNT(j)  (256  + 64 * (j))
#define XB_XSUB(j)  (1280 + 64 * (j))
#define XB_XGEN(j)  (2304 + 64 * (j))
#define XB_TOP      3328
#define XB_TOPGEN   3392
#define XCD_BAR_WORDS 3456
#define XB_SPIN_CAP (1u << 18)

__device__ __forceinline__ unsigned xb_ld(unsigned* p)              { return __hip_atomic_load(p, __ATOMIC_RELAXED, __HIP_MEMORY_SCOPE_AGENT); }
__device__ __forceinline__ unsigned xb_add(unsigned* p, unsigned v) { return __hip_atomic_fetch_add(p, v, __ATOMIC_RELAXED, __HIP_MEMORY_SCOPE_AGENT); }
__device__ __forceinline__ unsigned xb_xcc_id() { return (unsigned)__builtin_amdgcn_s_getreg((3 << 11) | 20) & 0xFu; }
#define XB_SPIN(cond, bar) do { unsigned _sp = 0; while (cond) { __builtin_amdgcn_s_sleep(1); \
    if ((++_sp & 255u) == 0u) { if (xb_ld(&(bar)[XB_TMO])) break; if (_sp > XB_SPIN_CAP) { atomicAdd(&(bar)[XB_TMO], 1u); break; } } } } while (0)

struct XcdBarrier {
    unsigned* bar; unsigned x;
    volatile LAS unsigned* st;
};

__device__ __forceinline__ XcdBarrier xcd_barrier_post(unsigned* bar, volatile LAS unsigned* st) {
    XcdBarrier b; b.bar = bar; b.x = xb_xcc_id(); b.st = st;
    if (threadIdx.x == 0) (void)xb_add(&bar[XB_XCNT(b.x)], 1u);
    return b;
}
__device__ __forceinline__ void xcd_barrier_complete(unsigned* bar, unsigned x, unsigned& nloc, unsigned& nx) {
    const unsigned G = gridDim.x * gridDim.y * gridDim.z;
    unsigned sum, cnt, mine, sp = 0u;
    for (;;) {
        sum = 0u; cnt = 0u; mine = 0u;
#pragma unroll
        for (unsigned j = 0; j < 16; ++j) { const unsigned c = xb_ld(&bar[XB_XCNT(j)]); sum += c; cnt += (c > 0u) ? 1u : 0u; mine = (j == x) ? c : mine; }
        if (sum == G) break;
        __builtin_amdgcn_s_sleep(1);
        if ((++sp & 255u) == 0u) { if (xb_ld(&bar[XB_TMO])) break; if (sp > XB_SPIN_CAP) { atomicAdd(&bar[XB_TMO], 1u); break; } }
    }
    nloc = mine > 0u ? mine : 1u; nx = cnt > 0u ? cnt : 1u;
}

__device__ __forceinline__ void xcd_barrier(const XcdBarrier& b) {
    asm volatile("s_waitcnt vmcnt(0)" ::: "memory");
    __syncthreads();
    if (threadIdx.x == 0) {
        unsigned* bar = b.bar;
        __builtin_amdgcn_s_waitcnt(0);
        unsigned nloc = b.st[0], nx = b.st[1];
        if (nloc == 0u) { xcd_barrier_complete(bar, b.x, nloc, nx); b.st[0] = nloc; b.st[1] = nx; }
        const unsigned old = xb_add(&bar[XB_XSUB(b.x)], 1u);
        const unsigned gen = old / nloc;
        if (old + 1u == (gen + 1u) * nloc) {
            __builtin_amdgcn_fence(__ATOMIC_RELEASE, "agent");
            asm volatile("s_waitcnt vmcnt(0)" ::: "memory");
            const unsigned og = xb_add(&bar[XB_TOP], 1u);
            const unsigned tg = og / nx;
            if (og + 1u == (tg + 1u) * nx) xb_add(&bar[XB_TOPGEN], 1u);
            else XB_SPIN(xb_ld(&bar[XB_TOPGEN]) == tg, bar);
            __builtin_amdgcn_fence(__ATOMIC_ACQUIRE, "agent");
            xb_add(&bar[XB_XGEN(b.x)], 1u);
            asm volatile("s_waitcnt vmcnt(0)" ::: "memory");
        } else {
            XB_SPIN(xb_ld(&bar[XB_XGEN(b.x)]) == gen, bar);
            __builtin_amdgcn_fence(__ATOMIC_ACQUIRE, "agent");
            asm volatile("s_waitcnt vmcnt(0)" ::: "memory");
        }
    }
    __syncthreads();
}

#ifndef PHMASK
#define PHMASK 127
#endif
__global__ void __launch_bounds__(512, 2) fwd(Args a) {
    extern __shared__ __attribute__((aligned(16))) unsigned char lds_raw[];
    LAS unsigned char* lds = (LAS unsigned char*)lds_raw;
    cg::grid_group grid = cg::this_grid();
    unsigned char* ws = a.ws;
    const int G = gridDim.x;
    volatile LAS unsigned* bst = (volatile LAS unsigned*)(lds + 131072 + 1024);
    if (threadIdx.x < 2) bst[threadIdx.x] = 0u;
    __syncthreads();
    XcdBarrier bar = xcd_barrier_post((unsigned*)(ws + WS_CTL), bst);
    if (a.ph_lo < -5) grid.sync();
    for (int ph = a.ph_lo; ph < a.ph_hi; ++ph) {
#ifdef REPEAT_KIND
      for (int rep_ = 0; rep_ < ((ph >= 2 && (ph - 2) % 5 == REPEAT_KIND) || (REPEAT_KIND >= 10 && ph == REPEAT_KIND - 10) || (REPEAT_KIND <= -100 && ph == -REPEAT_KIND - 100) ? 2 : 1); ++rep_) {
#else
      {
#endif
        if (ph == 0) { if (PHMASK & 1) phase0(a, lds); }
        else if (ph == 1) { if (PHMASK & 2) phase1(a); }
        else {
            const int l = (ph - 2) / 5, k = (ph - 2) % 5;
            const unsigned char* wt = ws + WS_WT + (size_t)l * WT_LAYER;
            const float* mod_l = (const float*)(ws + WS_MOD) + (size_t)l * 5 * NMOD;
            if (k == 0) { if (PHMASK & 4) {
                pg8::Gemm g{(const bf16_t*)(ws + WS_AP), (const bf16_t*)(wt + WT_IN), MTOT, INC, D}; pg8::StaticOrder S; S.init(MTOT, INC, G, (int)blockIdx.x);
                EpiIn E{l, (bf16_t*)(ws + WS_PQ), a.out, (const float*)(ws + WS_SSQ1), (const float*)(ws + WS_BIN) + (size_t)l * 5 * INC, (const float*)(ws + WS_ROPE),
                        a.in[12] + l * 64, a.in[13] + l * 64, a.in[19] + l * 64, a.in[20] + l * 64};
                pg8::gemm_phase<EpiIn, pg8::StaticOrder, true, true>(lds, g, S, E); }
            } else if (k == 1) {
                if (PHMASK & 8) at::attn_phase(lds, l, (const bf16_t*)(ws + WS_PQ), ws, (bf16_t*)(ws + WS_O), a.in[18] + l * 128);
            } else if (k == 2) { if (PHMASK & 16) {
                pg8::Gemm g{(const bf16_t*)(ws + WS_O), (const bf16_t*)(wt + WT_OUT), MTOT, D, D}; pg8::StaticOrder S; S.init(MTOT, D, G, (int)blockIdx.x);
                EpiRes E{l == 0 ? a.in[0] : a.out, l == 0 ? a.in[1] - (size_t)MCTX * D : a.out, a.out, mod_l + 2048, (const float*)(ws + WS_GTAB) + (size_t)(l * 2 + 1) * 5 * D, (bf16_t*)(ws + WS_AP), (float*)(ws + WS_SSQ2)};
                pg8::gemm_phase<EpiRes, pg8::StaticOrder, true, true>(lds, g, S, E); }
            } else if (k == 3) { if (PHMASK & 32) {
                pg8::Gemm g{(const bf16_t*)(ws + WS_AP), (const bf16_t*)(wt + WT_GU), MTOT, 2 * FH, D}; pg8::StaticOrder S; S.init(MTOT, 2 * FH, G, (int)blockIdx.x);
                EpiGU E{(bf16_t*)(ws + WS_HD), (const float*)(ws + WS_SSQ2), (const float*)(ws + WS_BGU) + (size_t)l * 5 * 2 * FH};
                pg8::gemm_phase<EpiGU, pg8::StaticOrder, true, true>(lds, g, S, E); }
            } else { if (PHMASK & 64) {
                pg8::Gemm g{(const bf16_t*)(ws + WS_HD), (const bf16_t*)(wt + WT_DN), MTOT, D, FH}; pg8::StaticOrder S; S.init(MTOT, D, G, (int)blockIdx.x);
                EpiRes E{a.out, a.out, a.out, mod_l + 5120, l == 0 ? (const float*)(ws + WS_GTAB) + (size_t)(1 * 2 + 0) * 5 * D : nullptr, (bf16_t*)(ws + WS_AP), (float*)(ws + WS_SSQ1)};
                pg8::gemm_phase<EpiRes, pg8::StaticOrder, true, true>(lds, g, S, E); }
            }
        }
      }
        if (ph + 1 < a.ph_hi) xcd_barrier(bar);
#ifdef EXTRA_SYNC
        if (ph + 1 < a.ph_hi) xcd_barrier(bar);
#endif
    }
}
constexpr int N_PHASES = 12;
static int g_grid = 0;
static int fast_grid() {
    if (g_grid == 0) {
        int dev = 0, cus = 0, per_cu = 0;
        if (hipGetDevice(&dev) != hipSuccess || hipDeviceGetAttribute(&cus, hipDeviceAttributeMultiprocessorCount, dev) != hipSuccess) { fprintf(stderr, "device query failed\n"); g_grid = -1; return g_grid; }
        if (hipFuncSetAttribute((const void*)fwd, hipFuncAttributeMaxDynamicSharedMemorySize, LDS_BYTES) != hipSuccess) { fprintf(stderr, "hipFuncSetAttribute failed\n"); g_grid = -1; return g_grid; }
        if (hipOccupancyMaxActiveBlocksPerMultiprocessor(&per_cu, (const void*)fwd, 512, LDS_BYTES) != hipSuccess || per_cu < 1) { fprintf(stderr, "occupancy query: %d blocks per CU\n", per_cu); (void)hipGetLastError(); per_cu = 1; }
        g_grid = cus;
    }
    return g_grid;
}
static Args make_args(void* const* d_in, void* d_out, void* d_ws) { Args a{}; for (int i = 0; i < 25; ++i) a.in[i] = (const float*)d_in[i]; a.out = (float*)d_out; a.ws = (unsigned char*)d_ws; return a; }
static void launch_phases(void* const* d_in, void* d_out, void* d_ws, int lo, int hi, hipStream_t stream) {
    const int grid = fast_grid(); if (grid <= 0) return;
    Args a = make_args(d_in, d_out, d_ws); a.ph_lo = lo; a.ph_hi = hi;
    if (hi - lo > 1 && hipMemsetAsync((unsigned char*)d_ws + WS_CTL, 0, CTL_BYTES, stream) != hipSuccess) { fprintf(stderr, "memset of the barrier words failed\n"); return; }
    void* args[] = {&a};
    hipError_t e = hipLaunchCooperativeKernel((const void*)fwd, dim3(grid), dim3(512), args, LDS_BYTES, stream);
    if (e != hipSuccess) fprintf(stderr, "cooperative launch failed: %s (grid %d)\n", hipGetErrorString(e), grid);
}
#undef LAS
}
extern "C" void kernel_launch(void* const* d_in, const int* in_sizes, int n_in, void* d_out, int out_size, void* d_ws, size_t ws_size, hipStream_t stream) {
    (void)in_sizes; (void)n_in; (void)out_size; (void)ws_size;
    fx::launch_phases(d_in, d_out, d_ws, 0, fx::N_PHASES, stream);
}
```

```cpp
#include <hip/hip_runtime.h>
#include <hip/hip_cooperative_groups.h>
#include <hip/hip_bf16.h>
#include <cstdio>
#include <cstdint>
#include <cmath>
namespace cg = cooperative_groups;

namespace pg8 {
#define PG8_LAS __attribute__((address_space(3)))
typedef unsigned short bf16_t;
typedef short bf16x8 __attribute__((ext_vector_type(8)));
typedef float f32x4 __attribute__((ext_vector_type(4)));
typedef unsigned u32x4 __attribute__((ext_vector_type(4)));
constexpr int BM = 256, BK = 64, HALF = 128, HTB = HALF * BK * 2  , STAGE_BYTES = 8 * HTB, NXCD = 8, WGM = 8;

__host__ __device__ __forceinline__ int lds_byte(int r, int c) { const int st = (r >> 4) * 2 + (c >> 5), rr = r & 15, cc = c & 31, ob = rr * 64 + cc * 2; return st * 1024 + (ob ^ (((ob >> 9) & 1) << 5)); }
__host__ __device__ __forceinline__ void stage_rc(int b, int& R, int& C) { const int st = b / 1024, sb = b % 1024, swz = sb ^ (((sb >> 9) & 1) << 5); R = (st >> 1) * 16 + swz / 64; C = (st & 1) * 32 + (swz % 64) / 2; }
__host__ __device__ __forceinline__ int perm32(int rho) { const int n = rho >> 4, i = rho & 15; return 8 * (i >> 2) + 4 * n + (i & 3); }

struct Unit { int pm, pn; };
struct Gemm { const bf16_t* A; const bf16_t* Bt; int M, N, K; };

struct StaticOrder {
    int nM, nN, nwg, G, c;
    __host__ __device__ void init(int M, int N, int G_, int c_) { nM = M / BM; nN = N / BM; nwg = nM * nN; G = G_; c = c_; }
    __host__ __device__ bool next(int i, Unit& u) const {
        const long L = (long)i * G + c; if (L >= nwg) return false;
        int wgid = (int)L; { const int q = nwg / NXCD, r = nwg % NXCD, xcd = wgid % NXCD, off = wgid / NXCD; wgid = (xcd < r ? xcd * (q + 1) : r * (q + 1) + (xcd - r) * q) + off; }
        const int nig = WGM * nN, gid = wgid / nig, fm = gid * WGM, gsz = (nM - fm) < WGM ? (nM - fm) : WGM;
        u.pm = fm + ((wgid % nig) % gsz); u.pn = (wgid % nig) / gsz; return true;
    }
    __device__ __forceinline__ void a_ready(const Unit&) const {}
    __device__ __forceinline__ void done(const Unit&) const {}
};

__device__ __forceinline__ unsigned cvt_pk_bf16(float lo, float hi) { unsigned r; asm volatile("v_cvt_pk_bf16_f32 %0, %1, %2" : "=v"(r) : "v"(lo), "v"(hi)); return r; }
template <class Epi, class Sched, bool ALIGN_EPI = false, bool SP2 = false>
__device__ __forceinline__ void gemm_phase(PG8_LAS unsigned char* lds, const Gemm g, const Sched& S, const Epi& E) {
    int tid_ = threadIdx.x; asm volatile("" : "+v"(tid_));
    const int tid = tid_, wid = __builtin_amdgcn_readfirstlane(tid >> 6), lane = tid & 63, wr = wid >> 2, wc = wid & 3, fr = lane & 15, fq = lane >> 4;
    const int K = g.K, nt = K / BK;
    unsigned voffA[2], voffB[2];
#pragma unroll
    for (int i = 0; i < 2; ++i) { int R, C; stage_rc(tid * 16 + i * 8192, R, C); const int Rb = Epi::PERM ? ((R & ~31) + perm32(R & 31)) : R;
        voffA[i] = (unsigned)(R * K + C) * 2u; voffB[i] = (unsigned)(Rb * K + C) * 2u; }
    const size_t kstep = (size_t)(BK * 2);
    const size_t hstep = (size_t)HALF * K * 2;
    const size_t tstep = 2 * hstep;
    const unsigned ldsw = (unsigned)wid * 1024u;
    const int aoff = lds_byte(wr * 64 + fr, fq * 8), boff = lds_byte(wc * 32 + fr, fq * 8);
#define PG8_SA(b, h) (((b) * 2 + (h)) * HTB)
#define PG8_SB(b, h) ((4 + (b) * 2 + (h)) * HTB)
#define PG8_STAGE(bufoff, gbase, voff) do { _Pragma("unroll") for (int _i = 0; _i < 2; ++_i) \
        __builtin_amdgcn_global_load_lds((const unsigned*)((const char*)(gbase) + (voff)[_i]), (PG8_LAS unsigned*)(lds + (bufoff) + ldsw + _i * 8192), 16, 0, 0); } while (0)
#define PG8_LDA(dst, b, h) do { _Pragma("unroll") for (int m = 0; m < 4; ++m) _Pragma("unroll") for (int k = 0; k < 2; ++k) dst[m][k] = *(const PG8_LAS bf16x8*)(lds + PG8_SA(b, h) + aoff + m * 2048 + k * 1024); } while (0)
#define PG8_LDB(dst, b, h) do { _Pragma("unroll") for (int n = 0; n < 2; ++n) _Pragma("unroll") for (int k = 0; k < 2; ++k) dst[n][k] = *(const PG8_LAS bf16x8*)(lds + PG8_SB(b, h) + boff + n * 2048 + k * 1024); } while (0)
#define PG8_MMA(ai, bj, At, Bt) do { __builtin_amdgcn_s_setprio(1); _Pragma("unroll") for (int m = 0; m < 4; ++m) _Pragma("unroll") for (int n = 0; n < 2; ++n) _Pragma("unroll") for (int k = 0; k < 2; ++k) \
        acc[ai][bj][m][n] = __builtin_amdgcn_mfma_f32_16x16x32_bf16(Bt[n][k], At[m][k], acc[ai][bj][m][n], 0, 0, 0); __builtin_amdgcn_s_setprio(0); } while (0)
#define PG8_WAIT_V(n) asm volatile("s_waitcnt vmcnt(" #n ")" ::: "memory")
#define PG8_WAIT_L(n) asm volatile("s_waitcnt lgkmcnt(" #n ")" ::: "memory")
#define PG8_BAR __builtin_amdgcn_s_barrier()
#define PG8_SCHED __builtin_amdgcn_sched_barrier(0)
    Unit cur, nxt; int ui = 0;
    if (!S.next(0, cur)) return;
    f32x4 acc[2][2][4][2];
#pragma unroll
    for (int a = 0; a < 2; ++a)
#pragma unroll
        for (int b = 0; b < 2; ++b)
#pragma unroll
            for (int m = 0; m < 4; ++m)
#pragma unroll
                for (int n = 0; n < 2; ++n) acc[a][b][m][n] = (f32x4){0.f, 0.f, 0.f, 0.f};
    bf16x8 At[4][2], B0[2][2], B1[2][2];
    const char* cA = (const char*)g.A + (size_t)cur.pm * tstep; const char* cB = (const char*)g.Bt + (size_t)cur.pn * tstep;
    S.a_ready(cur);
    if constexpr (SP2) {
        PG8_STAGE(PG8_SB(0, 0), cB, voffB); PG8_STAGE(PG8_SB(0, 1), cB + hstep, voffB); PG8_STAGE(PG8_SA(0, 0), cA, voffA); PG8_STAGE(PG8_SA(0, 1), cA + hstep, voffA);
        if (wr == 1) PG8_BAR;
        PG8_WAIT_V(2); PG8_BAR;
        PG8_STAGE(PG8_SB(1, 0), cB + kstep, voffB); PG8_STAGE(PG8_SA(1, 0), cA + kstep, voffA); PG8_STAGE(PG8_SB(1, 1), cB + hstep + kstep, voffB);
        PG8_WAIT_V(6); PG8_BAR;
    } else {
        PG8_STAGE(PG8_SB(0, 0), cB, voffB); PG8_STAGE(PG8_SA(0, 0), cA, voffA); PG8_STAGE(PG8_SB(0, 1), cB + hstep, voffB); PG8_STAGE(PG8_SA(0, 1), cA + hstep, voffA);
        if (wr == 1) PG8_BAR;
        PG8_WAIT_V(4); PG8_BAR;
        PG8_STAGE(PG8_SB(1, 0), cB + kstep, voffB); PG8_STAGE(PG8_SA(1, 0), cA + kstep, voffA); PG8_STAGE(PG8_SB(1, 1), cB + hstep + kstep, voffB);
        PG8_WAIT_V(6); PG8_BAR;
    }
    for (;;) {
        const bool has_next = S.next(ui + 1, nxt);
        const char* nA = has_next ? (const char*)g.A + (size_t)nxt.pm * tstep : cA; const char* nB = has_next ? (const char*)g.Bt + (size_t)nxt.pn * tstep : cB;
        for (int t = 0; t < nt; t += 2) {
            const bool last = (t == nt - 2);
            const char* a1 = cA + (size_t)(t + 1) * kstep;
            const char* a2 = last ? nA : cA + (size_t)(t + 2) * kstep; const char* b2 = last ? nB : cB + (size_t)(t + 2) * kstep;
            const char* a3 = a2 + kstep; const char* b3 = b2 + kstep;
            if (last && has_next) S.a_ready(nxt);
            if constexpr (SP2) {
            PG8_LDB(B0, 0, 0); PG8_LDB(B1, 0, 1); PG8_SCHED; PG8_LDA(At, 0, 0); PG8_STAGE(PG8_SA(1, 1), a1 + hstep, voffA);
            PG8_WAIT_V(8); PG8_WAIT_L(0); PG8_BAR; PG8_MMA(0, 0, At, B0); PG8_MMA(0, 1, At, B1); PG8_BAR; PG8_SCHED;
            PG8_LDA(At, 0, 1); PG8_STAGE(PG8_SB(0, 0), b2, voffB); PG8_STAGE(PG8_SB(0, 1), b2 + hstep, voffB); PG8_STAGE(PG8_SA(0, 0), a2, voffA);
            PG8_WAIT_V(8); PG8_WAIT_L(0); PG8_BAR; PG8_MMA(1, 0, At, B0); PG8_MMA(1, 1, At, B1); PG8_BAR; PG8_SCHED;
            PG8_LDB(B0, 1, 0); PG8_LDB(B1, 1, 1); PG8_SCHED; PG8_LDA(At, 1, 0); PG8_STAGE(PG8_SA(0, 1), a2 + hstep, voffA);
            PG8_WAIT_V(8); PG8_WAIT_L(0); PG8_BAR; PG8_MMA(0, 0, At, B0); PG8_MMA(0, 1, At, B1); PG8_BAR; PG8_SCHED;
            PG8_LDA(At, 1, 1); PG8_STAGE(PG8_SB(1, 0), b3, voffB); PG8_STAGE(PG8_SB(1, 1), b3 + hstep, voffB); PG8_STAGE(PG8_SA(1, 0), a3, voffA);
            PG8_WAIT_V(8); PG8_WAIT_L(0); PG8_BAR; PG8_MMA(1, 0, At, B0); PG8_MMA(1, 1, At, B1); PG8_BAR; PG8_SCHED;
            } else {
            PG8_LDB(B0, 0, 0); PG8_SCHED; PG8_LDA(At, 0, 0); PG8_STAGE(PG8_SA(1, 1), a1 + hstep, voffA);
            PG8_WAIT_L(8); PG8_BAR; PG8_WAIT_L(0); PG8_MMA(0, 0, At, B0); PG8_BAR; PG8_SCHED;
            PG8_LDB(B1, 0, 1); PG8_STAGE(PG8_SB(0, 0), b2, voffB);
            PG8_BAR; PG8_WAIT_L(0); PG8_MMA(0, 1, At, B1); PG8_BAR;
            PG8_LDA(At, 0, 1); PG8_STAGE(PG8_SA(0, 0), a2, voffA);
            PG8_BAR; PG8_WAIT_L(0); PG8_MMA(1, 0, At, B0); PG8_BAR; PG8_SCHED;
            PG8_STAGE(PG8_SB(0, 1), b2 + hstep, voffB);
            PG8_WAIT_V(6); PG8_BAR; PG8_MMA(1, 1, At, B1); PG8_BAR;
            PG8_LDB(B0, 1, 0); PG8_SCHED; PG8_LDA(At, 1, 0); PG8_STAGE(PG8_SA(0, 1), a2 + hstep, voffA);
            PG8_WAIT_L(8); PG8_BAR; PG8_WAIT_L(0); PG8_MMA(0, 0, At, B0); PG8_BAR; PG8_SCHED;
            PG8_LDB(B1, 1, 1); PG8_STAGE(PG8_SB(1, 0), b3, voffB);
            PG8_BAR; PG8_WAIT_L(0); PG8_MMA(0, 1, At, B1); PG8_BAR;
            PG8_LDA(At, 1, 1); PG8_STAGE(PG8_SA(1, 0), a3, voffA);
            PG8_BAR; PG8_WAIT_L(0); PG8_MMA(1, 0, At, B0); PG8_BAR; PG8_SCHED;
            PG8_STAGE(PG8_SB(1, 1), b3 + hstep, voffB);
            PG8_WAIT_V(6); PG8_BAR; PG8_MMA(1, 1, At, B1); PG8_BAR;
            }
        }
        if constexpr (ALIGN_EPI) { if (wr == 0) PG8_BAR; }
        if constexpr (!Epi::AFTER_DRAIN) { E(acc, cur, wr, wc, fr, fq); S.done(cur); }
        if (!has_next) break;
#pragma unroll
        for (int a = 0; a < 2; ++a)
#pragma unroll
            for (int b = 0; b < 2; ++b)
#pragma unroll
                for (int m = 0; m < 4; ++m)
#pragma unroll
                    for (int n = 0; n < 2; ++n) acc[a][b][m][n] = (f32x4){0.f, 0.f, 0.f, 0.f};
        cur = nxt; cA = nA; cB = nB; ++ui;
        if constexpr (ALIGN_EPI) { if (wr == 1) PG8_BAR; }
    }
    PG8_WAIT_V(0);
    if constexpr (!ALIGN_EPI) { if (wr == 0) PG8_BAR; }
    PG8_BAR;
    if constexpr (Epi::AFTER_DRAIN) { E.fused(acc, cur, wr, wc, fr, fq, lds, wid, lane); S.done(cur); }
#undef PG8_SA
#undef PG8_SB
#undef PG8_STAGE
#undef PG8_LDA
#undef PG8_LDB
#undef PG8_MMA
#undef PG8_WAIT_V
#undef PG8_WAIT_L
#undef PG8_BAR
#undef PG8_SCHED
}
}
namespace fx {
using pg8::bf16_t; using pg8::bf16x8; using pg8::f32x4; using pg8::u32x4;
#define LAS __attribute__((address_space(3)))
typedef float f32x16 __attribute__((ext_vector_type(16)));
typedef unsigned u32x2 __attribute__((ext_vector_type(2)));
typedef short v4i16_t __attribute__((ext_vector_type(4)));
constexpr int D = 1024, INC = 2304, FH = 2816, NMOD = 6144, MTOT = 12288, MCTX = 8192;
constexpr float EPS = 1e-6f;
constexpr float LOG2E = 1.4426950408889634f;
constexpr float C2 = 0.125f * LOG2E;
constexpr size_t MiB = 1u << 20;
constexpr size_t WS_MOD = 0;
constexpr size_t WS_LAM = 256 * 1024;
constexpr size_t WS_GTAB = 320 * 1024;
constexpr size_t WS_BIN = 512 * 1024;
constexpr size_t WS_BGU = 768 * 1024;
constexpr size_t WS_ROPE = 1 * MiB;
constexpr size_t WS_SSQ1 = 2 * MiB;
constexpr size_t WS_SSQ2 = 3 * MiB;
constexpr size_t WS_CTL = 3840 * 1024, CTL_BYTES = 16384;
constexpr size_t WS_WT = 4 * MiB;
constexpr size_t WT_IN = 0, WT_OUT = 4718592, WT_GU = WT_OUT + 2097152, WT_DN = WT_GU + 11534336, WT_LAYER = WT_DN + 5767168;
static_assert(WT_LAYER == 23 * MiB, "weight copies per layer");
constexpr size_t WS_CACHE = WS_WT + 2 * WT_LAYER;
constexpr size_t WS_CDK = WS_CACHE, WS_CDV = WS_CACHE + 4 * MiB, WS_CGK = WS_CACHE + 8 * MiB, WS_CGV = WS_CACHE + 9 * MiB;
constexpr size_t WS_AP = WS_CACHE + 10 * MiB;
constexpr size_t WS_PQ = WS_AP + 24 * MiB;
constexpr size_t WS_O = WS_PQ + 54 * MiB;
constexpr size_t WS_HD = WS_PQ;
constexpr size_t WS_FAST_END = WS_O + 24 * MiB;
constexpr size_t O_Y = 0, O_DK = (size_t)12288 * 1024, O_DV = O_DK + (size_t)8192 * 2 * 512, O_GK = O_DV + (size_t)8192 * 2 * 512, O_GV = O_GK + (size_t)8192 * 2 * 128;
constexpr int LDS_BYTES = 147456;

__device__ __forceinline__ unsigned f2bf(float f) { unsigned u = __builtin_bit_cast(unsigned, f); return (u + 0x7fffu + ((u >> 16) & 1u)) >> 16; }
__device__ __forceinline__ unsigned pk2(float lo, float hi) { return f2bf(lo) | (f2bf(hi) << 16); }
__device__ __forceinline__ float wave_sum(float v) {
#pragma unroll
    for (int o = 1; o < 64; o <<= 1) v += __shfl_xor(v, o);
    return v;
}
__host__ __device__ __forceinline__ int col_slot(int kind, int col) {
    int pn, bj, wc, j;
    if (kind == 0) { pn = col >> 8; const int c = col & 255; wc = c >> 6; bj = (c >> 5) & 1; j = c & 31; }
    else if (kind == 1) { pn = col >> 8; const int c = col & 255; bj = c >> 7; wc = (c >> 5) & 3; j = c & 31; }
    else { bj = col >= FH ? 1 : 0; const int cc = col - FH * bj; pn = cc >> 7; wc = (cc >> 5) & 3; j = cc & 31; }
    const int fq = j >> 3, n = (j >> 2) & 1, i = j & 3;
    return 256 * pn + 128 * bj + 32 * wc + 16 * n + 4 * fq + i;
}
__host__ __device__ __forceinline__ int slot_col(int kind, int s) {
    const int pn = s >> 8, t = s & 255, bj = t >> 7, wc = (t >> 5) & 3, n = (t >> 4) & 1, fq = (t >> 2) & 3, i = t & 3;
    if (kind == 0) return 256 * pn + 64 * wc + 32 * bj + 8 * fq + 4 * n + i;
    if (kind == 1) return 256 * pn + 128 * bj + 32 * wc + 8 * fq + 4 * n + i;
    return FH * bj + 128 * pn + 32 * wc + 8 * fq + 4 * n + i;
}

struct Args { const float* in[25]; float* out; unsigned char* ws; int ph_lo, ph_hi; };

__device__ __forceinline__ void p0_transpose_pair(const float* W, int K, int N, bf16_t* WT, int kind, LAS float* scr, int itemA, int itemB, bool hasB, int lane) {
    const int nblk = N / 32;
    const int k0a = 64 * (itemA / nblk), n0a = 32 * (itemA % nblk), k0b = 64 * (itemB / nblk), n0b = 32 * (itemB % nblk);
    float va[32], vb[32];
#pragma unroll
    for (int i = 0; i < 32; ++i) va[i] = W[(size_t)(k0a + 2 * i + (lane >> 5)) * N + n0a + (lane & 31)];
    if (hasB) {
#pragma unroll
        for (int i = 0; i < 32; ++i) vb[i] = W[(size_t)(k0b + 2 * i + (lane >> 5)) * N + n0b + (lane & 31)];
    }
    const int c = lane & 7;
#pragma unroll
    for (int i = 0; i < 32; ++i) scr[(2 * i + (lane >> 5)) * 33 + (lane & 31)] = va[i];
    asm volatile("s_waitcnt lgkmcnt(0)" ::: "memory");
#pragma unroll
    for (int j = 0; j < 4; ++j) { const int n = (lane >> 3) + 8 * j; const LAS float* s = scr + (8 * c) * 33 + n;
        u32x4 o; o.x = pk2(s[0 * 33], s[1 * 33]); o.y = pk2(s[2 * 33], s[3 * 33]); o.z = pk2(s[4 * 33], s[5 * 33]); o.w = pk2(s[6 * 33], s[7 * 33]);
        *(u32x4*)(WT + (size_t)col_slot(kind, n0a + n) * K + k0a + 8 * c) = o; }
    asm volatile("s_waitcnt lgkmcnt(0)" ::: "memory");
    if (hasB) {
#pragma unroll
        for (int i = 0; i < 32; ++i) scr[(2 * i + (lane >> 5)) * 33 + (lane & 31)] = vb[i];
        asm volatile("s_waitcnt lgkmcnt(0)" ::: "memory");
#pragma unroll
        for (int j = 0; j < 4; ++j) { const int n = (lane >> 3) + 8 * j; const LAS float* s = scr + (8 * c) * 33 + n;
            u32x4 o; o.x = pk2(s[0 * 33], s[1 * 33]); o.y = pk2(s[2 * 33], s[3 * 33]); o.z = pk2(s[4 * 33], s[5 * 33]); o.w = pk2(s[6 * 33], s[7 * 33]);
            *(u32x4*)(WT + (size_t)col_slot(kind, n0b + n) * K + k0b + 8 * c) = o; }
        asm volatile("s_waitcnt lgkmcnt(0)" ::: "memory");
    }
}
__device__ __forceinline__ void cache_item(const Args& a, int item, int lane) {
    unsigned char* ws = a.ws; const float* src; bf16_t* dst; int j = item;
    if (j < 512) { src = a.in[2]; dst = (bf16_t*)(ws + WS_CDK); } else if (j < 1024) { j -= 512; src = a.in[3]; dst = (bf16_t*)(ws + WS_CDV); }
    else if (j < 1152) { j -= 1024; src = a.in[4]; dst = (bf16_t*)(ws + WS_CGK); } else { j -= 1152; src = a.in[5]; dst = (bf16_t*)(ws + WS_CGV); }
#pragma unroll
    for (int i = 0; i < 8; ++i) { const size_t e = (size_t)j * 4096 + (size_t)i * 512 + lane * 8;
        const f32x4 v0 = *(const f32x4*)(src + e), v1 = *(const f32x4*)(src + e + 4);
        u32x4 o; o.x = pk2(v0[0], v0[1]); o.y = pk2(v0[2], v0[3]); o.z = pk2(v1[0], v1[1]); o.w = pk2(v1[2], v1[3]);
        *(u32x4*)(dst + e) = o; }
}
__device__ __forceinline__ void conv_mat(const Args& a, LAS float* scr, int mat, int l, int gw, int NGW, int lane) {
    unsigned char* wt = a.ws + WS_WT + (size_t)l * WT_LAYER;
    const float* W; int K, N, kind, NI; bf16_t* WT;
    if (mat == 0)      { W = a.in[11] + (size_t)l * D * INC;    K = D;  N = INC;    kind = 0; NI = 16 * 72;  WT = (bf16_t*)(wt + WT_IN); }
    else if (mat == 1) { W = a.in[21] + (size_t)l * D * D;      K = D;  N = D;      kind = 1; NI = 16 * 32;  WT = (bf16_t*)(wt + WT_OUT); }
    else if (mat == 2) { W = a.in[23] + (size_t)l * D * 2 * FH; K = D;  N = 2 * FH; kind = 2; NI = 16 * 176; WT = (bf16_t*)(wt + WT_GU); }
    else               { W = a.in[24] + (size_t)l * FH * D;     K = FH; N = D;      kind = 1; NI = 44 * 32;  WT = (bf16_t*)(wt + WT_DN); }
    for (int it = gw; it < NI; it += 2 * NGW) { const int itB = it + NGW; const bool hasB = itB < NI; p0_transpose_pair(W, K, N, WT, kind, scr, it, hasB ? itB : it, hasB, lane); }
}
__device__ __forceinline__ void phase0(const Args& a, LAS unsigned char* lds) {
    int tid_ = threadIdx.x; asm volatile("" : "+v"(tid_));
    const int tid = tid_, lane = tid & 63, wid = __builtin_amdgcn_readfirstlane(tid >> 6);
    const int G = gridDim.x, bx = blockIdx.x;
    unsigned char* ws = a.ws;
    for (int u = bx; u < 192; u += G) {
        LAS float* s = (LAS float*)lds;
        LAS float* red = (LAS float*)(lds + 20480);
        for (int i = tid; i < 5 * 1024; i += 512) { const int c = i >> 10, k = i & 1023; const float x = c < 4 ? a.in[6][c * 1024 + k] : a.in[7][k]; s[i] = x / (1.f + __expf(-x)); }
        __syncthreads();
        const int l = u / 96, n0 = (u % 96) * 64;
        const float* w = a.in[8] + (size_t)l * 1024 * NMOD + (size_t)(wid * 128) * NMOD + n0 + lane;
        float a0 = 0.f, a1 = 0.f, a2 = 0.f, a3 = 0.f, a4 = 0.f;
#pragma unroll 16
        for (int k = 0; k < 128; ++k) { const float wv = w[(size_t)k * NMOD]; const int kk = wid * 128 + k;
            a0 += s[kk] * wv; a1 += s[1024 + kk] * wv; a2 += s[2048 + kk] * wv; a3 += s[3072 + kk] * wv; a4 += s[4096 + kk] * wv; }
        red[(wid * 5 + 0) * 64 + lane] = a0; red[(wid * 5 + 1) * 64 + lane] = a1; red[(wid * 5 + 2) * 64 + lane] = a2; red[(wid * 5 + 3) * 64 + lane] = a3; red[(wid * 5 + 4) * 64 + lane] = a4;
        __syncthreads();
        if (tid < 320) { const int c = tid >> 6; float sum = 0.f;
#pragma unroll
            for (int ww = 0; ww < 8; ++ww) sum += red[(ww * 5 + c) * 64 + lane];
            ((float*)(ws + WS_MOD))[(size_t)(l * 5 + c) * NMOD + n0 + lane] = sum + a.in[9][l * NMOD + n0 + lane]; }
        __syncthreads();
    }
    if (bx == G - 1 && wid < 2) {
        const int ll = wid;
        const float s1 = wave_sum(a.in[14][ll * 64 + lane] * a.in[15][ll * 64 + lane]), s2 = wave_sum(a.in[16][ll * 64 + lane] * a.in[17][ll * 64 + lane]);
        const float li = 0.8f - 0.6f * expf(-0.3f * (float)ll);
        if (lane == 0) { float* lm = (float*)(ws + WS_LAM); lm[ll] = expf(s1) - expf(s2) + li; lm[2 + ll] = li; }
    }
    {
        LAS float* scr = (LAS float*)(lds + 32768 + wid * 8704);
        const int gw = bx * 8 + wid, NGW = G * 8;
        conv_mat(a, scr, 0, 0, gw, NGW, lane); conv_mat(a, scr, 1, 0, gw, NGW, lane);
        for (int it = gw; it < 1280; it += NGW) cache_item(a, it, lane);
    }
    {
        const size_t gt = (size_t)bx * 512 + tid, GT = (size_t)G * 512;
        float* rope = (float*)(ws + WS_ROPE);
        for (size_t i = gt; i < 32768; i += GT) { const int t = (int)(i >> 5), ii = (int)(i & 31);
            const float pos = (ii < 16) ? (float)(t >> 6) : (float)(t & 63);
            const float freq = powf(10000.0f, -(float)(2 * (ii & 15)) / 32.0f);
            const float ang = pos * freq; rope[i] = cosf(ang); rope[32768 + i] = sinf(ang); }
    }
}
__device__ __forceinline__ void bias_rows(const Args& a, LAS float* red, int l, int isgu, int gw, int NGW, int lane) {
    unsigned char* ws = a.ws; const float* mod = (const float*)(ws + WS_MOD);
    const int nrows = isgu ? 2 * FH : INC, kind = isgu ? 2 : 0;
    const bf16_t* wt = (const bf16_t*)(ws + WS_WT + (size_t)l * WT_LAYER + (isgu ? WT_GU : WT_IN));
    float* bias = (float*)(ws + (isgu ? WS_BGU : WS_BIN)) + (size_t)l * 5 * nrows;
    float sh[5][16];
#pragma unroll
    for (int c = 0; c < 5; ++c) { const float* sp = mod + (size_t)(l * 5 + c) * NMOD + (isgu ? 3072 : 0);
#pragma unroll
        for (int h = 0; h < 2; ++h) { const f32x4 v0 = *(const f32x4*)(sp + h * 512 + lane * 8), v1 = *(const f32x4*)(sp + h * 512 + lane * 8 + 4);
            sh[c][h * 8 + 0] = v0[0]; sh[c][h * 8 + 1] = v0[1]; sh[c][h * 8 + 2] = v0[2]; sh[c][h * 8 + 3] = v0[3]; sh[c][h * 8 + 4] = v1[0]; sh[c][h * 8 + 5] = v1[1]; sh[c][h * 8 + 6] = v1[2]; sh[c][h * 8 + 7] = v1[3]; } }
    for (int s0 = gw * 8; s0 < nrows; s0 += NGW * 8) {
        u32x4 w0[8], w1[8];
#pragma unroll
        for (int j = 0; j < 8; ++j) { w0[j] = *(const u32x4*)(wt + (size_t)(s0 + j) * D + lane * 8); w1[j] = *(const u32x4*)(wt + (size_t)(s0 + j) * D + 512 + lane * 8); }
#pragma unroll
        for (int j = 0; j < 8; ++j) {
            float wv[16];
#pragma unroll
            for (int q = 0; q < 4; ++q) { wv[2 * q] = __uint_as_float(w0[j][q] << 16); wv[2 * q + 1] = __uint_as_float(w0[j][q] & 0xffff0000u); wv[8 + 2 * q] = __uint_as_float(w1[j][q] << 16); wv[8 + 2 * q + 1] = __uint_as_float(w1[j][q] & 0xffff0000u); }
#pragma unroll
            for (int c = 0; c < 5; ++c) { float d = 0.f;
#pragma unroll
                for (int e = 0; e < 16; ++e) d += sh[c][e] * wv[e];
                red[(j * 5 + c) * 64 + lane] = d; }
        }
        asm volatile("s_waitcnt lgkmcnt(0)" ::: "memory");
        if (lane < 40) {
            const LAS f32x4* rp = (const LAS f32x4*)(red + lane * 64); f32x4 acc = rp[0];
#pragma unroll
            for (int q = 1; q < 16; ++q) acc += rp[q];
            const float d = (acc[0] + acc[1]) + (acc[2] + acc[3]);
            const int j = lane / 5, c = lane - 5 * j;
            bias[(size_t)c * nrows + slot_col(kind, s0 + j)] = d;
        }
        asm volatile("s_waitcnt lgkmcnt(0)" ::: "memory");
    }
}
__device__ __forceinline__ void phase1(const Args& a, LAS unsigned char* lds) {
    int tid_ = threadIdx.x; asm volatile("" : "+v"(tid_));
    const int tid = tid_, lane = tid & 63, wid = __builtin_amdgcn_readfirstlane(tid >> 6);
    const int G = gridDim.x, bx = blockIdx.x;
    unsigned char* ws = a.ws;
    const float* mod = (const float*)(ws + WS_MOD);
    const size_t gt = (size_t)bx * 512 + tid, GT = (size_t)G * 512;
    { float* gt_ = (float*)(ws + WS_GTAB);
      for (size_t i = gt; i < 2 * 2 * 5 * 1024; i += GT) { const int k = (int)(i & 1023), c = (int)((i >> 10) % 5), w = (int)((i / 5120) & 1), l = (int)(i / 10240);
          const float nw = w == 0 ? a.in[10][l * D + k] : a.in[22][l * D + k];
          gt_[i] = nw * (1.f + mod[(size_t)(l * 5 + c) * NMOD + (w == 0 ? 1024 : 4096) + k]); } }
    const int gw = bx * 8 + wid, NGW = G * 8;
    bias_rows(a, (LAS float*)(lds + wid * 10240), 0, 0, gw, NGW, lane);
    { bf16_t* AP = (bf16_t*)(ws + WS_AP); float* ssq = (float*)(ws + WS_SSQ1);
      for (int m = gw; m < MTOT; m += NGW) {
          const float* xr = m < MCTX ? a.in[0] + (size_t)m * D : a.in[1] + (size_t)(m - MCTX) * D;
          const int c = m < MCTX ? 4 : (m - MCTX) >> 10;
          const float* sc = mod + (size_t)(0 * 5 + c) * NMOD + 1024; const float* nw = a.in[10];
          float ss = 0.f;
#pragma unroll
          for (int h = 0; h < 2; ++h) { const int k = h * 512 + lane * 8;
              const f32x4 x0 = *(const f32x4*)(xr + k), x1 = *(const f32x4*)(xr + k + 4), s0 = *(const f32x4*)(sc + k), s1 = *(const f32x4*)(sc + k + 4), n0 = *(const f32x4*)(nw + k), n1 = *(const f32x4*)(nw + k + 4);
              ss += (x0[0] * x0[0] + x0[1] * x0[1]) + (x0[2] * x0[2] + x0[3] * x0[3]) + (x1[0] * x1[0] + x1[1] * x1[1]) + (x1[2] * x1[2] + x1[3] * x1[3]);
              const f32x4 y0 = x0 * (n0 * (s0 + 1.f)), y1 = x1 * (n1 * (s1 + 1.f));
              u32x4 o; o.x = pk2(y0[0], y0[1]); o.y = pk2(y0[2], y0[3]); o.z = pk2(y1[0], y1[1]); o.w = pk2(y1[2], y1[3]);
              *(u32x4*)(AP + (size_t)m * D + k) = o; }
          ss = wave_sum(ss);
          if (lane < 16) ssq[(size_t)m * 16 + lane] = lane == 0 ? ss : 0.f;
      } }
}
__device__ __forceinline__ void side_job(const Args& a, LAS unsigned char* lds, int job) {
    int tid_ = threadIdx.x; asm volatile("" : "+v"(tid_));
    const int lane = tid_ & 63, wid = __builtin_amdgcn_readfirstlane(tid_ >> 6);
    const int G = gridDim.x, bx = blockIdx.x;
    int first = job == 0 ? 176 : job == 2 ? 32 : 192;
#ifdef JOB3_ALL
    if (job == 3) first = 0;
#endif
    if (G != 256) first = 0;
    if (bx < first) return;
    const int gw = (bx - first) * 8 + wid, NGW = (G - first) * 8;
    LAS float* scr = (LAS float*)(lds + wid * 10240);
    if (job == 0) conv_mat(a, scr, 2, 0, gw, NGW, lane);
    else if (job == 1) { conv_mat(a, scr, 3, 0, gw, NGW, lane); conv_mat(a, scr, 0, 1, gw, NGW, lane); bias_rows(a, (LAS float*)(lds + wid * 10240), 0, 1, gw, NGW, lane); }
    else if (job == 2) { conv_mat(a, scr, 1, 1, gw, NGW, lane); conv_mat(a, scr, 2, 1, gw, NGW, lane); conv_mat(a, scr, 3, 1, gw, NGW, lane); }
    else { bias_rows(a, (LAS float*)(lds + wid * 10240), 1, 0, gw, NGW, lane); bias_rows(a, (LAS float*)(lds + wid * 10240), 1, 1, gw, NGW, lane); }
}
__device__ __forceinline__ void rows_rstd(const float* ssq, int row0, int fq, float (&rstd)[4]) {
    f32x4 p[4];
#pragma unroll
    for (int mm = 0; mm < 4; ++mm) p[mm] = *(const f32x4*)(ssq + (size_t)(row0 + mm * 16) * 16 + fq * 4);
#pragma unroll
    for (int mm = 0; mm < 4; ++mm) { float s = (p[mm][0] + p[mm][1]) + (p[mm][2] + p[mm][3]); s += __shfl_xor(s, 16); s += __shfl_xor(s, 32);
        rstd[mm] = 1.0f / sqrtf(s * (1.f / D) + EPS); }
}
struct EpiIn {
    static constexpr bool PERM = false, AFTER_DRAIN = false;
    int l; bf16_t* PQ; float* out; const float* ssq; const float* bias; const float* rope; const float *qna, *kna, *qnb, *knb;
    __device__ __forceinline__ void operator()(const f32x4 (&acc)[2][2][4][2], const pg8::Unit& u, int wr, int wc, int fr, int fq) const {
        const int pm = u.pm, pn = u.pn; const bool lat = pm >= 32; const int cond = lat ? (pm - 32) >> 2 : 4;
        const int cb = 256 * pn + 64 * wc + 8 * fq;
        const float* gain = nullptr; float gsc = 1.f;
        if (pn < 2) { gain = qna; gsc = C2; } else if (pn < 4) gain = kna; else if (pn < 6) gain = nullptr; else if (pn < 8) { gain = qnb; gsc = C2; } else if (wc < 2) gain = knb;
        float* obase = nullptr; int ocol = 0, opitch = 0;
        if (!lat) {
            if (pn == 2 || pn == 3) { obase = out + O_DK; ocol = cb - 512; opitch = 512; }
            else if (pn == 4 || pn == 5) { obase = out + O_DV; ocol = cb - 1024; opitch = 512; }
            else if (pn == 8) { if (wc < 2) { obase = out + O_GK; ocol = cb - 2048; } else { obase = out + O_GV; ocol = cb - 2176; } opitch = 128; }
        }
        f32x4 bv[2][2], gv[2][2];
#pragma unroll
        for (int bj = 0; bj < 2; ++bj)
#pragma unroll
            for (int n = 0; n < 2; ++n) { bv[bj][n] = *(const f32x4*)(bias + (size_t)cond * INC + cb + 32 * bj + 4 * n);
                gv[bj][n] = gain ? *(const f32x4*)(gain + 32 * bj + 8 * fq + 4 * n) * gsc : (f32x4){1.f, 1.f, 1.f, 1.f}; }
#pragma unroll
        for (int ai = 0; ai < 2; ++ai) {
            float rstd_[4]; rows_rstd(ssq, pm * 256 + ai * 128 + wr * 64 + fr, fq, rstd_);
#pragma unroll
            for (int m = 0; m < 4; ++m) {
                const int row = pm * 256 + ai * 128 + wr * 64 + m * 16 + fr;
                const float rstd = rstd_[m];
                f32x4 v[2][2];
#pragma unroll
                for (int bj = 0; bj < 2; ++bj)
#pragma unroll
                    for (int n = 0; n < 2; ++n) v[bj][n] = acc[ai][bj][m][n] * rstd + bv[bj][n];
                if (obase && pn != 2 && pn != 3 && !(pn == 8 && wc < 2)) {
                    float* op = obase + ((size_t)(pm * 2 + l) * 256 + (row & 255)) * opitch + ocol;
#pragma unroll
                    for (int bj = 0; bj < 2; ++bj) { __builtin_nontemporal_store(v[bj][0], (f32x4*)(op + 32 * bj)); __builtin_nontemporal_store(v[bj][1], (f32x4*)(op + 32 * bj + 4)); }
                }
                if (gain) {
                    float q = 0.f;
#pragma unroll
                    for (int bj = 0; bj < 2; ++bj)
#pragma unroll
                        for (int n = 0; n < 2; ++n) q += (v[bj][n][0] * v[bj][n][0] + v[bj][n][1] * v[bj][n][1]) + (v[bj][n][2] * v[bj][n][2] + v[bj][n][3] * v[bj][n][3]);
                    q += __shfl_xor(q, 16); q += __shfl_xor(q, 32);
                    const float rn = 1.0f / sqrtf(q * (1.f / 64.f) + EPS);
                    if (obase) {
                        float* op = obase + ((size_t)(pm * 2 + l) * 256 + (row & 255)) * opitch + ocol;
#pragma unroll
                        for (int bj = 0; bj < 2; ++bj) { __builtin_nontemporal_store(v[bj][0] * rn * gv[bj][0], (f32x4*)(op + 32 * bj)); __builtin_nontemporal_store(v[bj][1] * rn * gv[bj][1], (f32x4*)(op + 32 * bj + 4)); }
                    }
#pragma unroll
                    for (int bj = 0; bj < 2; ++bj)
#pragma unroll
                        for (int n = 0; n < 2; ++n) v[bj][n] = v[bj][n] * rn * gv[bj][n];
                    if (lat) {
                        const int t = (row - MCTX) & 1023;
#pragma unroll
                        for (int n = 0; n < 2; ++n) { const f32x4 cs = *(const f32x4*)(rope + (size_t)t * 32 + 8 * fq + 4 * n), sn = *(const f32x4*)(rope + 32768 + (size_t)t * 32 + 8 * fq + 4 * n);
                            const f32x4 x1 = v[0][n], x2 = v[1][n]; v[0][n] = x1 * cs - x2 * sn; v[1][n] = x2 * cs + x1 * sn; }
                    }
                }
                bf16_t* pp = PQ + (size_t)row * INC + cb;
#pragma unroll
                for (int bj = 0; bj < 2; ++bj) { u32x4 w; w.x = pg8::cvt_pk_bf16(v[bj][0][0], v[bj][0][1]); w.y = pg8::cvt_pk_bf16(v[bj][0][2], v[bj][0][3]); w.z = pg8::cvt_pk_bf16(v[bj][1][0], v[bj][1][1]); w.w = pg8::cvt_pk_bf16(v[bj][1][2], v[bj][1][3]);
                    *(u32x4*)(pp + 32 * bj) = w; }
            }
        }
    }
};
struct EpiRes {
    static constexpr bool PERM = false, AFTER_DRAIN = false;
    const float* xin_ctx; const float* xin_lat; float* xout; const float* gate; const float* gtab; bf16_t* AP; float* ssq;
    __device__ __forceinline__ void operator()(const f32x4 (&acc)[2][2][4][2], const pg8::Unit& u, int wr, int wc, int fr, int fq) const {
        const int pm = u.pm, pn = u.pn; const bool lat = pm >= 32; const int cond = lat ? (pm - 32) >> 2 : 4;
        const int cb = 256 * pn + 32 * wc + 8 * fq;
        const float* xin = lat ? xin_lat : xin_ctx;
        f32x4 gv[2][2], Gv[2][2];
#pragma unroll
        for (int bj = 0; bj < 2; ++bj)
#pragma unroll
            for (int n = 0; n < 2; ++n) { gv[bj][n] = *(const f32x4*)(gate + (size_t)cond * NMOD + cb + 128 * bj + 4 * n);
                Gv[bj][n] = gtab ? *(const f32x4*)(gtab + (size_t)cond * D + cb + 128 * bj + 4 * n) : (f32x4){0.f, 0.f, 0.f, 0.f}; }
#pragma unroll
        for (int ai = 0; ai < 2; ++ai)
#pragma unroll
            for (int m = 0; m < 4; ++m) {
                const int row = pm * 256 + ai * 128 + wr * 64 + m * 16 + fr;
                const size_t ro = (size_t)row * D + cb;
                float ss = 0.f;
#pragma unroll
                for (int bj = 0; bj < 2; ++bj) { f32x4 xn[2];
#pragma unroll
                    for (int n = 0; n < 2; ++n) { const f32x4 xo = *(const f32x4*)(xin + ro + 128 * bj + 4 * n); xn[n] = xo + gv[bj][n] * acc[ai][bj][m][n];
                        *(f32x4*)(xout + ro + 128 * bj + 4 * n) = xn[n];
                        ss += (xn[n][0] * xn[n][0] + xn[n][1] * xn[n][1]) + (xn[n][2] * xn[n][2] + xn[n][3] * xn[n][3]); }
                    if (gtab) { const f32x4 y0 = xn[0] * Gv[bj][0], y1 = xn[1] * Gv[bj][1];
                        u32x4 w; w.x = pg8::cvt_pk_bf16(y0[0], y0[1]); w.y = pg8::cvt_pk_bf16(y0[2], y0[3]); w.z = pg8::cvt_pk_bf16(y1[0], y1[1]); w.w = pg8::cvt_pk_bf16(y1[2], y1[3]);
                        *(u32x4*)(AP + ro + 128 * bj) = w; } }
                if (gtab) { ss += __shfl_xor(ss, 16); ss += __shfl_xor(ss, 32); if (fq == 0) ssq[(size_t)row * 16 + 4 * pn + wc] = ss; }
            }
    }
};
struct EpiGU {
    static constexpr bool PERM = false, AFTER_DRAIN = false;
    bf16_t* HD; const float* ssq; const float* bias;
    __device__ __forceinline__ void operator()(const f32x4 (&acc)[2][2][4][2], const pg8::Unit& u, int wr, int wc, int fr, int fq) const {
        const int pm = u.pm, pn = u.pn; const bool lat = pm >= 32; const int cond = lat ? (pm - 32) >> 2 : 4;
        const int cbh = 128 * pn + 32 * wc + 8 * fq;
        f32x4 bg[2], bu[2];
#pragma unroll
        for (int n = 0; n < 2; ++n) { bg[n] = *(const f32x4*)(bias + (size_t)cond * 2 * FH + cbh + 4 * n); bu[n] = *(const f32x4*)(bias + (size_t)cond * 2 * FH + FH + cbh + 4 * n); }
#pragma unroll
        for (int ai = 0; ai < 2; ++ai) {
            float rstd_[4]; rows_rstd(ssq, pm * 256 + ai * 128 + wr * 64 + fr, fq, rstd_);
#pragma unroll
            for (int m = 0; m < 4; ++m) {
                const int row = pm * 256 + ai * 128 + wr * 64 + m * 16 + fr;
                const float rstd = rstd_[m];
                float h[8];
#pragma unroll
                for (int n = 0; n < 2; ++n) { const f32x4 g = acc[ai][0][m][n] * rstd + bg[n], uu = acc[ai][1][m][n] * rstd + bu[n];
#pragma unroll
                    for (int i = 0; i < 4; ++i) h[4 * n + i] = g[i] * __builtin_amdgcn_rcpf(1.f + __builtin_amdgcn_exp2f(-g[i] * LOG2E)) * uu[i]; }
                u32x4 w; w.x = pg8::cvt_pk_bf16(h[0], h[1]); w.y = pg8::cvt_pk_bf16(h[2], h[3]); w.z = pg8::cvt_pk_bf16(h[4], h[5]); w.w = pg8::cvt_pk_bf16(h[6], h[7]);
                *(u32x4*)(HD + (size_t)row * FH + cbh) = w;
            }
        }
    }
};
namespace at {
constexpr int STAGE = 32768, SLOT_K = 0, SLOT_V = 16384;
struct UnitDesc { int diff; int lat; int b; int head; int qb; };
__device__ __forceinline__ v4i16_t vtr(const LAS unsigned char* p) { return __builtin_amdgcn_ds_read_tr16_b64_v4i16((LAS v4i16_t*)p); }
__device__ __forceinline__ float swap_max(float v) { auto rr = __builtin_amdgcn_permlane32_swap(__float_as_uint(v), __float_as_uint(v), false, false); return fmaxf(__uint_as_float(rr[0]), __uint_as_float(rr[1])); }
__device__ __forceinline__ float swap_sum(float v) { auto rr = __builtin_amdgcn_permlane32_swap(__float_as_uint(v), __float_as_uint(v), false, false); return __uint_as_float(rr[0]) + __uint_as_float(rr[1]); }

struct Strm { const bf16_t* Q; const bf16_t* Kown; const bf16_t* Vown; const bf16_t* Kc; const bf16_t* Vc; int cpitch; int NOWN; int NT; int diff; };
__device__ __forceinline__ Strm mk_strm(const UnitDesc U, int l, const bf16_t* PQ, const unsigned char* ws, int wid) {
    Strm s; const int comp = U.diff ? (wid >> 2) : 0, g = U.head >> 2;
    const int rowbase = U.lat ? MCTX + U.b * 1024 : U.b * 256;
    const int qrow0 = rowbase + (U.diff ? U.qb * 128 + (wid & 3) * 32 : U.qb * 256 + wid * 32);
    const int qcol = U.diff ? U.head * 128 + comp * 64 : 1536 + U.head * 64;
    const int kcol = U.diff ? 512 + U.head * 128 : 2048 + g * 64, vcol = U.diff ? 1024 + U.head * 128 : 2176 + g * 64;
    s.Q = PQ + (size_t)qrow0 * INC + qcol;
    s.Kown = PQ + (size_t)rowbase * INC + kcol; s.Vown = PQ + (size_t)rowbase * INC + vcol;
    s.Kc = U.diff ? (const bf16_t*)(ws + WS_CDK) + (size_t)(U.b * 2 + l) * 512 * 512 + U.head * 128 : (const bf16_t*)(ws + WS_CGK) + (size_t)(U.b * 2 + l) * 512 * 128 + g * 64;
    s.Vc = U.diff ? (const bf16_t*)(ws + WS_CDV) + (size_t)(U.b * 2 + l) * 512 * 512 + U.head * 128 : (const bf16_t*)(ws + WS_CGV) + (size_t)(U.b * 2 + l) * 512 * 128 + g * 64;
    s.cpitch = U.diff ? 512 : 128; s.NOWN = U.lat ? 16 : 4; s.NT = U.lat ? 24 : 4; s.diff = U.diff;
    return s;
}
__device__ __forceinline__ void glds16(const void* gsrc, unsigned lds_dst) { unsigned keep;
    asm volatile("s_mov_b32 %0, m0\n\ts_mov_b32 m0, %2\n\ts_nop 0\n\tglobal_load_lds_dwordx4 %1, off\n\ts_mov_b32 m0, %0" : "=&s"(keep) : "v"(gsrc), "s"(lds_dst) : "memory"); }
constexpr int KRING = 0, VRING = 32768, SLOT = 16384, XCH = 65536, QPARK = 98304;
__device__ __forceinline__ void dma_k(LAS unsigned char* lds, const Strm s, int t, int lane, int wid) {
    const bool own = t < s.NOWN; const int tt = own ? t : t - s.NOWN; const int pitch = own ? INC : s.cpitch;
    const bf16_t* kb = (own ? s.Kown : s.Kc) + (size_t)tt * 64 * pitch;
    const unsigned st = (unsigned)__builtin_amdgcn_readfirstlane((int)(unsigned)(uintptr_t)(lds + KRING + (t & 1) * SLOT + wid * 1024));
    glds16(kb + (size_t)lane * pitch + wid * 8, st);
    if (s.diff) glds16(kb + 64 + (size_t)lane * pitch + wid * 8, st + 8192u);
}
__device__ __forceinline__ void dma_v(LAS unsigned char* lds, const Strm s, int t, int lane, int wid) {
    const bool own = t < s.NOWN; const int tt = own ? t : t - s.NOWN; const int pitch = own ? INC : s.cpitch;
    const bf16_t* vb = (own ? s.Vown : s.Vc) + (size_t)tt * 64 * pitch;
    const unsigned st = (unsigned)__builtin_amdgcn_readfirstlane((int)(unsigned)(uintptr_t)(lds + VRING + (t & 1) * SLOT + wid * 1024));
    { const int p = wid; glds16(vb + (size_t)(16 * (p & 3) + (lane >> 2)) * pitch + (p >> 2) * 32 + (lane & 3) * 8, st); }
    if (s.diff) { const int p = wid + 8; glds16(vb + (size_t)(16 * (p & 3) + (lane >> 2)) * pitch + (p >> 2) * 32 + (lane & 3) * 8, st + 8192u); }
}
__device__ __forceinline__ void prologue_dma(LAS unsigned char* lds, const Strm s, int lane, int wid) {
    dma_k(lds, s, 0, lane, wid); dma_v(lds, s, 0, lane, wid); dma_k(lds, s, 1, lane, wid);
    const bf16_t* qb = s.Q + (size_t)(lane & 31) * INC + (lane >> 5) * 8;
    const unsigned st = (unsigned)__builtin_amdgcn_readfirstlane((int)(unsigned)(uintptr_t)(lds + QPARK + wid * 4096));
#pragma unroll
    for (int d0 = 0; d0 < 4; ++d0) glds16(qb + d0 * 16, st + d0 * 1024u);
}
#define AT_WAITBAR() do { asm volatile("s_waitcnt vmcnt(0) lgkmcnt(0)" ::: "memory"); __builtin_amdgcn_s_barrier(); asm volatile("" ::: "memory"); } while (0)
template <bool DIFF, int VAR>
__device__ __forceinline__ void attn_unit(LAS unsigned char* lds, const UnitDesc U, const Strm S, const bool has_nxt, const Strm nxt, int l, const unsigned char* ws, bf16_t* O, const float* subln_l) {
    constexpr int ND0 = DIFF ? 4 : 2;
    int tid_ = threadIdx.x; asm volatile("" : "+v"(tid_));
    const int tid = tid_, lane = tid & 63, r32 = lane & 31, hi = lane >> 5, wid = __builtin_amdgcn_readfirstlane(tid >> 6);
    const int comp = DIFF ? (wid >> 2) : 0;
    const int rowbase = U.lat ? MCTX + U.b * 1024 : U.b * 256;
    const int qrow0 = rowbase + (DIFF ? U.qb * 128 + (wid & 3) * 32 : U.qb * 256 + wid * 32);
    const int NT = (VAR == 5) ? 2 : S.NT;
    const LAS unsigned char* qpark = lds + QPARK + wid * 4096 + lane * 16;
#define AT_QK(P0, P1, t) do { const LAS unsigned char* kp_ = lds + KRING + ((t) & 1) * SLOT + comp * 8192 + hi * 1024 + r32 * 16; P0 = f32x16{}; P1 = f32x16{}; \
        _Pragma("unroll") for (int d0 = 0; d0 < 4; ++d0) { const bf16x8 b0_ = *(const LAS bf16x8*)(kp_ + d0 * 2048), b1_ = *(const LAS bf16x8*)(kp_ + d0 * 2048 + 512); \
            const bf16x8 q_ = *(const LAS bf16x8*)(qpark + d0 * 1024); P0 = __builtin_amdgcn_mfma_f32_32x32x16_bf16(b0_, q_, P0, 0, 0, 0); P1 = __builtin_amdgcn_mfma_f32_32x32x16_bf16(b1_, q_, P1, 0, 0, 0); } } while (0)
    f32x16 o[ND0];
#pragma unroll
    for (int d0 = 0; d0 < ND0; ++d0) o[d0] = f32x16{};
    float mrun = -1e30f, lrun = 0.f;
    f32x16 c0, c1, n0, n1;
    AT_WAITBAR();
    AT_QK(c0, c1, 0);
    for (int t = 0; t < NT; ++t) {
        AT_WAITBAR();
        if (t + 2 < NT) dma_k(lds, S, t + 2, lane, wid);
        if (t + 1 < NT) dma_v(lds, S, t + 1, lane, wid);
        if (t + 1 < NT) AT_QK(n0, n1, t + 1);
        else if (has_nxt) prologue_dma(lds, nxt, lane, wid);
        float rm = fmaxf(c0[0], c1[0]);
#pragma unroll
        for (int r = 1; r < 16; ++r) rm = fmaxf(rm, fmaxf(c0[r], c1[r]));
        rm = swap_max(rm);
        if (__any(rm > mrun + 8.0f)) {
            const float mn = fmaxf(mrun, rm), f = __builtin_amdgcn_exp2f(mrun - mn);
            mrun = mn; lrun *= f;
#pragma unroll
            for (int d0 = 0; d0 < ND0; ++d0)
#pragma unroll
                for (int r = 0; r < 16; ++r) o[d0][r] *= f;
        }
        float ls = 0.f;
#pragma unroll
        for (int r = 0; r < 16; ++r) { c0[r] = __builtin_amdgcn_exp2f(c0[r] - mrun); c1[r] = __builtin_amdgcn_exp2f(c1[r] - mrun); ls += c0[r] + c1[r]; }
        lrun += ls;
        u32x4 pw[4];
#pragma unroll
        for (int q = 0; q < 4; ++q) { pw[0][q] = pg8::cvt_pk_bf16(c0[2 * q], c0[2 * q + 1]); pw[1][q] = pg8::cvt_pk_bf16(c0[8 + 2 * q], c0[8 + 2 * q + 1]);
                                      pw[2][q] = pg8::cvt_pk_bf16(c1[2 * q], c1[2 * q + 1]); pw[3][q] = pg8::cvt_pk_bf16(c1[8 + 2 * q], c1[8 + 2 * q + 1]); }
        const LAS unsigned char* vp = lds + VRING + (t & 1) * SLOT + ((lane >> 4) & 1) * 32 + (lane & 3) * 8 + (4 * hi + ((lane & 15) >> 2)) * 64;
#pragma unroll
        for (int ks = 0; ks < 4; ++ks)
#pragma unroll
            for (int d0 = 0; d0 < ND0; ++d0) {
                const v4i16_t lo = vtr(vp + d0 * 4096 + ks * 1024), hh = vtr(vp + d0 * 4096 + ks * 1024 + 512);
                const bf16x8 vf = (bf16x8){lo[0], lo[1], lo[2], lo[3], hh[0], hh[1], hh[2], hh[3]};
                o[d0] = __builtin_amdgcn_mfma_f32_32x32x16_bf16(vf, __builtin_bit_cast(bf16x8, pw[ks]), o[d0], 0, 0, 0);
            }
        c0 = n0; c1 = n1;
    }
#undef AT_QK
    lrun = swap_sum(lrun);
    const float inv = 1.0f / lrun;
#pragma unroll
    for (int d0 = 0; d0 < ND0; ++d0)
#pragma unroll
        for (int r = 0; r < 16; ++r) o[d0][r] *= inv;
    const int orow = qrow0 + r32;
    if (DIFF) {
        const float lam = ((const float*)(ws + WS_LAM))[l], li = ((const float*)(ws + WS_LAM))[2 + l];
        LAS float* xch = (LAS float*)(lds + XCH + (wid & 3) * 8192);
        float ss = 0.f;
#pragma unroll
        for (int half = 0; half < 2; ++half) {
            if (comp == 1) {
#pragma unroll
                for (int d = 0; d < 2; ++d)
#pragma unroll
                    for (int r = 0; r < 16; ++r) xch[(d * 16 + r) * 64 + lane] = o[2 * half + d][r];
            }
            asm volatile("s_waitcnt lgkmcnt(0)" ::: "memory"); __builtin_amdgcn_s_barrier(); asm volatile("" ::: "memory");
            if (comp == 0) {
#pragma unroll
                for (int d = 0; d < 2; ++d)
#pragma unroll
                    for (int r = 0; r < 16; ++r) { o[2 * half + d][r] -= lam * xch[(d * 16 + r) * 64 + lane]; ss += o[2 * half + d][r] * o[2 * half + d][r]; }
            }
            asm volatile("s_waitcnt lgkmcnt(0)" ::: "memory"); __builtin_amdgcn_s_barrier(); asm volatile("" ::: "memory");
        }
        if (comp == 0) {
            ss = swap_sum(ss);
            const float rs = (1.0f / sqrtf(ss * (1.f / 128.f) + EPS)) * (1.f - li);
            bf16_t* op = O + (size_t)orow * D + U.head * 128;
#pragma unroll
            for (int d0 = 0; d0 < ND0; ++d0)
#pragma unroll
                for (int q = 0; q < 4; ++q) { const int dv0 = 32 * d0 + 8 * q + 4 * hi; const f32x4 sw = *(const f32x4*)(subln_l + dv0);
                    u32x2 w; w.x = pg8::cvt_pk_bf16(o[d0][4 * q] * rs * sw[0], o[d0][4 * q + 1] * rs * sw[1]); w.y = pg8::cvt_pk_bf16(o[d0][4 * q + 2] * rs * sw[2], o[d0][4 * q + 3] * rs * sw[3]);
                    *(u32x2*)(op + dv0) = w; }
        }
    } else {
        bf16_t* op = O + (size_t)orow * D + 512 + U.head * 64;
#pragma unroll
        for (int d0 = 0; d0 < ND0; ++d0)
#pragma unroll
            for (int q = 0; q < 4; ++q) { const int dv0 = 32 * d0 + 8 * q + 4 * hi;
                u32x2 w; w.x = pg8::cvt_pk_bf16(o[d0][4 * q], o[d0][4 * q + 1]); w.y = pg8::cvt_pk_bf16(o[d0][4 * q + 2], o[d0][4 * q + 3]);
                *(u32x2*)(op + dv0) = w; }
    }
}
__device__ __forceinline__ UnitDesc mk_ld(int i) { UnitDesc u; u.diff = 1; u.lat = 1; u.b = i >> 5; u.head = (i >> 3) & 3; u.qb = i & 7; return u; }
__device__ __forceinline__ UnitDesc mk_lg(int i) { UnitDesc u; u.diff = 0; u.lat = 1; u.b = i >> 5; u.head = (i >> 2) & 7; u.qb = i & 3; return u; }
__device__ __forceinline__ UnitDesc mk_cd(int i) { UnitDesc u; u.diff = 1; u.lat = 0; u.b = i >> 3; u.head = (i >> 1) & 3; u.qb = i & 1; return u; }
__device__ __forceinline__ UnitDesc mk_cg(int i) { UnitDesc u; u.diff = 0; u.lat = 0; u.b = i >> 3; u.head = i & 7; u.qb = 0; return u; }
__device__ __forceinline__ bool get_unit(int G, int j, int idx, UnitDesc& u) {
    if (G == 256) {
        if (j < 128) { if (idx == 0) { u = mk_ld(j); return true; } if (idx == 1) { u = mk_cg(2 * j); return true; } if (idx == 2) { u = mk_cg(2 * j + 1); return true; } return false; }
        const int k = j - 128;
        if (idx == 0) { u = mk_lg(k); return true; } if (idx == 1) { u = mk_cd(2 * k); return true; } if (idx == 2) { u = mk_cd(2 * k + 1); return true; }
        return false;
    }
    const int i = j + idx * G; if (i >= 768) return false;
    if (i < 128) u = mk_ld(i); else if (i < 256) u = mk_lg(i - 128); else if (i < 512) u = mk_cd(i - 256); else u = mk_cg(i - 512);
    return true;
}
template <int VAR> __device__ __forceinline__ void attn_phase(LAS unsigned char* lds, int l, const bf16_t* PQ, const unsigned char* ws, bf16_t* O, const float* subln_l) {
    const int G = gridDim.x; const int bx = blockIdx.x;
    const int j = (G % 8 == 0) ? (bx % 8) * (G / 8) + bx / 8 : bx;
    int tid_ = threadIdx.x; asm volatile("" : "+v"(tid_));
    const int lane = tid_ & 63, wid = __builtin_amdgcn_readfirstlane(tid_ >> 6);
    UnitDesc U, Un;
    if (VAR == 7 || VAR == 8) {
        for (int idx = 0; get_unit(G, j, idx, U); ++idx) { if ((VAR == 7) != (U.lat != 0)) continue; Strm S1 = mk_strm(U, l, PQ, ws, wid); prologue_dma(lds, S1, lane, wid);
            if (U.diff) attn_unit<true, 0>(lds, U, S1, false, S1, l, ws, O, subln_l); else attn_unit<false, 0>(lds, U, S1, false, S1, l, ws, O, subln_l); AT_WAITBAR(); }
        return; }
    if (!get_unit(G, j, 0, U)) return;
    Strm S = mk_strm(U, l, PQ, ws, wid);
    prologue_dma(lds, S, lane, wid);
    for (int idx = 0;; ++idx) {
        const bool hn = get_unit(G, j, idx + 1, Un);
        Strm Sn = S; if (hn) Sn = mk_strm(Un, l, PQ, ws, wid);
        if (U.diff) attn_unit<true, VAR>(lds, U, S, hn, Sn, l, ws, O, subln_l); else attn_unit<false, VAR>(lds, U, S, hn, Sn, l, ws, O, subln_l);
        if (!hn) break;
        U = Un; S = Sn;
    }
    AT_WAITBAR();
}
#undef AT_WAITBAR
}
#define RLX_AGENT __ATOMIC_RELAXED, __HIP_MEMORY_SCOPE_AGENT
#define XB_TMO      128
#define XB_XCNT(j)  (256  + 64 * (j))
#define XB_XSUB(j)  (1280 + 64 * (j))
#define XB_XGEN(j)  (2304 + 64 * (j))
#define XB_TOP      3328
#define XB_TOPGEN   3392
#define XCD_BAR_WORDS 3456
#define XB_SPIN_CAP (1u << 18)

__device__ __forceinline__ unsigned xb_ld(unsigned* p)              { return __hip_atomic_load(p, __ATOMIC_RELAXED, __HIP_MEMORY_SCOPE_AGENT); }
__device__ __forceinline__ unsigned xb_add(unsigned* p, unsigned v) { return __hip_atomic_fetch_add(p, v, __ATOMIC_RELAXED, __HIP_MEMORY_SCOPE_AGENT); }
__device__ __forceinline__ unsigned xb_xcc_id() { return (unsigned)__builtin_amdgcn_s_getreg((3 << 11) | 20) & 0xFu; }
#define XB_SPIN(cond, bar) do { unsigned _sp = 0; while (cond) { __builtin_amdgcn_s_sleep(1); \
    if ((++_sp & 255u) == 0u) { if (xb_ld(&(bar)[XB_TMO])) break; if (_sp > XB_SPIN_CAP) { atomicAdd(&(bar)[XB_TMO], 1u); break; } } } } while (0)

struct XcdBarrier {
    unsigned* bar; unsigned x;
    volatile LAS unsigned* st;
};

__device__ __forceinline__ XcdBarrier xcd_barrier_post(unsigned* bar, volatile LAS unsigned* st) {
    XcdBarrier b; b.bar = bar; b.x = xb_xcc_id(); b.st = st;
    if (threadIdx.x == 0) (void)xb_add(&bar[XB_XCNT(b.x)], 1u);
    return b;
}
__device__ __forceinline__ void xcd_barrier_complete(unsigned* bar, unsigned x, unsigned& nloc, unsigned& nx) {
    const unsigned G = gridDim.x * gridDim.y * gridDim.z;
    unsigned sum, cnt, mine, sp = 0u;
    for (;;) {
        sum = 0u; cnt = 0u; mine = 0u;
#pragma unroll
        for (unsigned j = 0; j < 16; ++j) { const unsigned c = xb_ld(&bar[XB_XCNT(j)]); sum += c; cnt += (c > 0u) ? 1u : 0u; mine = (j == x) ? c : mine; }
        if (sum == G) break;
        __builtin_amdgcn_s_sleep(1);
        if ((++sp & 255u) == 0u) { if (xb_ld(&bar[XB_TMO])) break; if (sp > XB_SPIN_CAP) { atomicAdd(&bar[XB_TMO], 1u); break; } }
    }
    nloc = mine > 0u ? mine : 1u; nx = cnt > 0u ? cnt : 1u;
}

__device__ __forceinline__ void xcd_barrier(const XcdBarrier& b) {
    asm volatile("s_waitcnt vmcnt(0)" ::: "memory");
    __syncthreads();
    if (threadIdx.x == 0) {
        unsigned* bar = b.bar;
        __builtin_amdgcn_s_waitcnt(0);
        unsigned nloc = b.st[0], nx = b.st[1];
        if (nloc == 0u) { xcd_barrier_complete(bar, b.x, nloc, nx); b.st[0] = nloc; b.st[1] = nx; }
        const unsigned old = xb_add(&bar[XB_XSUB(b.x)], 1u);
        const unsigned gen = old / nloc;
        if (old + 1u == (gen + 1u) * nloc) {
            __builtin_amdgcn_fence(__ATOMIC_RELEASE, "agent");
            asm volatile("s_waitcnt vmcnt(0)" ::: "memory");
            const unsigned og = xb_add(&bar[XB_TOP], 1u);
            const unsigned tg = og / nx;
            if (og + 1u == (tg + 1u) * nx) xb_add(&bar[XB_TOPGEN], 1u);
            else XB_SPIN(xb_ld(&bar[XB_TOPGEN]) == tg, bar);
            __builtin_amdgcn_fence(__ATOMIC_ACQUIRE, "agent");
            xb_add(&bar[XB_XGEN(b.x)], 1u);
            asm volatile("s_waitcnt vmcnt(0)" ::: "memory");
        } else {
            XB_SPIN(xb_ld(&bar[XB_XGEN(b.x)]) == gen, bar);
            __builtin_amdgcn_fence(__ATOMIC_ACQUIRE, "agent");
            asm volatile("s_waitcnt vmcnt(0)" ::: "memory");
        }
    }
    __syncthreads();
}

#ifndef PHMASK
#define PHMASK 127
#endif
#ifndef DOWN1_AP
#define DOWN1_AP 0
#endif
#ifndef SJ_MODE
#define SJ_MODE 1
#endif
__global__ void __launch_bounds__(512, 2) fwd(Args a) {
    extern __shared__ __attribute__((aligned(16))) unsigned char lds_raw[];
    LAS unsigned char* lds = (LAS unsigned char*)lds_raw;
    cg::grid_group grid = cg::this_grid();
    unsigned char* ws = a.ws;
    const int G = gridDim.x;
    volatile LAS unsigned* bst = (volatile LAS unsigned*)(lds + 131072 + 1024);
    if (threadIdx.x < 2) bst[threadIdx.x] = 0u;
    __syncthreads();
    XcdBarrier bar = xcd_barrier_post((unsigned*)(ws + WS_CTL), bst);
    if (a.ph_lo < -5) grid.sync();
#ifdef PROBE_PHASE
    unsigned long long pr_dt = 0ull;
#endif
    for (int ph = a.ph_lo; ph < a.ph_hi; ++ph) {
#ifdef PROBE_PHASE
      const unsigned long long pr_t0 = __builtin_amdgcn_s_memrealtime();
#endif
#ifdef REPEAT_KIND
      for (int rep_ = 0; rep_ < ((ph >= 2 && (ph - 2) % 5 == REPEAT_KIND) || (REPEAT_KIND >= 10 && ph == REPEAT_KIND - 10) || (REPEAT_KIND <= -100 && ph == -REPEAT_KIND - 100) ? 2 : 1); ++rep_) {
#else
      {
#endif
        if (ph == 0) { if (PHMASK & 1) phase0(a, lds); }
        else if (ph == 1) { if (PHMASK & 2) phase1(a, lds); }
        else {
            const int l = (ph - 2) / 5, k = (ph - 2) % 5;
            const unsigned char* wt = ws + WS_WT + (size_t)l * WT_LAYER;
            const float* mod_l = (const float*)(ws + WS_MOD) + (size_t)l * 5 * NMOD;
            if (k == 0) { if (PHMASK & 4) {
                pg8::Gemm g{(const bf16_t*)(ws + WS_AP), (const bf16_t*)(wt + WT_IN), MTOT, INC, D}; pg8::StaticOrder S; S.init(MTOT, INC, G, (int)blockIdx.x);
                EpiIn E{l, (bf16_t*)(ws + WS_PQ), a.out, (const float*)(ws + WS_SSQ1), (const float*)(ws + WS_BIN) + (size_t)l * 5 * INC, (const float*)(ws + WS_ROPE),
                        a.in[12] + l * 64, a.in[13] + l * 64, a.in[19] + l * 64, a.in[20] + l * 64};
                pg8::gemm_phase<EpiIn, pg8::StaticOrder, true, true>(lds, g, S, E);
                if (l == 0) side_job(a, lds, 0); }
            } else if (k == 1) {
                if (PHMASK & 8) at::attn_phase<0>(lds, l, (const bf16_t*)(ws + WS_PQ), ws, (bf16_t*)(ws + WS_O), a.in[18] + l * 128);
#ifdef ATT_EXTRA
                at::attn_phase<ATT_EXTRA>(lds, l, (const bf16_t*)(ws + WS_PQ), ws, (bf16_t*)(ws + WS_AP), a.in[18] + l * 128);
#endif
            } else if (k == 2) { if (PHMASK & 16) {
                pg8::Gemm g{(const bf16_t*)(ws + WS_O), (const bf16_t*)(wt + WT_OUT), MTOT, D, D}; pg8::StaticOrder S; S.init(MTOT, D, G, (int)blockIdx.x);
                EpiRes E{l == 0 ? a.in[0] : a.out, l == 0 ? a.in[1] - (size_t)MCTX * D : a.out, a.out, mod_l + 2048, (const float*)(ws + WS_GTAB) + (size_t)(l * 2 + 1) * 5 * D, (bf16_t*)(ws + WS_AP), (float*)(ws + WS_SSQ2)};
                pg8::gemm_phase<EpiRes, pg8::StaticOrder, true, true>(lds, g, S, E);
                if (l == 0) side_job(a, lds, 1); }
            } else if (k == 3) { if (PHMASK & 32) {
                pg8::Gemm g{(const bf16_t*)(ws + WS_AP), (const bf16_t*)(wt + WT_GU), MTOT, 2 * FH, D}; pg8::StaticOrder S; S.init(MTOT, 2 * FH, G, (int)blockIdx.x);
                EpiGU E{(bf16_t*)(ws + WS_HD), (const float*)(ws + WS_SSQ2), (const float*)(ws + WS_BGU) + (size_t)l * 5 * 2 * FH};
                pg8::gemm_phase<EpiGU, pg8::StaticOrder, true, true>(lds, g, S, E);
                if (l == 0) side_job(a, lds, 2); }
            } else { if (PHMASK & 64) {
                pg8::Gemm g{(const bf16_t*)(ws + WS_HD), (const bf16_t*)(wt + WT_DN), MTOT, D, FH}; pg8::StaticOrder S; S.init(MTOT, D, G, (int)blockIdx.x);
                EpiRes E{a.out, a.out, a.out, mod_l + 5120, (l == 0 || DOWN1_AP) ? (const float*)(ws + WS_GTAB) + (size_t)(1 * 2 + 0) * 5 * D : nullptr, (bf16_t*)(ws + WS_AP), (float*)(ws + WS_SSQ1)};
                pg8::gemm_phase<EpiRes, pg8::StaticOrder, true, true>(lds, g, S, E);
                if (l == 0) side_job(a, lds, 3); }
            }
        }
      }
        if (ph + 1 < a.ph_hi) xcd_barrier(bar);
#ifdef EXTRA_SYNC
        if (ph + 1 < a.ph_hi) xcd_barrier(bar);
#endif
#ifdef PROBE_PHASE
        if (ph == PROBE_PHASE) pr_dt = __builtin_amdgcn_s_memrealtime() - pr_t0;
#endif
    }
#ifdef PROBE_PHASE
    if (blockIdx.x == 0) { const unsigned long long te = __builtin_amdgcn_s_memrealtime(); while (__builtin_amdgcn_s_memrealtime() - te < 4ull * pr_dt) __builtin_amdgcn_s_sleep(4); }
#endif
}
constexpr int N_PHASES = 12;
static int g_grid = 0;
static int fast_grid() {
    if (g_grid == 0) {
        int dev = 0, cus = 0, per_cu = 0;
        if (hipGetDevice(&dev) != hipSuccess || hipDeviceGetAttribute(&cus, hipDeviceAttributeMultiprocessorCount, dev) != hipSuccess) { fprintf(stderr, "device query failed\n"); g_grid = -1; return g_grid; }
        if (hipFuncSetAttribute((const void*)fwd, hipFuncAttributeMaxDynamicSharedMemorySize, LDS_BYTES) != hipSuccess) { fprintf(stderr, "hipFuncSetAttribute failed\n"); g_grid = -1; return g_grid; }
        if (hipOccupancyMaxActiveBlocksPerMultiprocessor(&per_cu, (const void*)fwd, 512, LDS_BYTES) != hipSuccess || per_cu < 1) { fprintf(stderr, "occupancy query: %d blocks per CU\n", per_cu); (void)hipGetLastError(); per_cu = 1; }
        g_grid = cus;
    }
    return g_grid;
}
static Args make_args(void* const* d_in, void* d_out, void* d_ws) { Args a{}; for (int i = 0; i < 25; ++i) a.in[i] = (const float*)d_in[i]; a.out = (float*)d_out; a.ws = (unsigned char*)d_ws; return a; }
static void launch_phases(void* const* d_in, void* d_out, void* d_ws, int lo, int hi, hipStream_t stream) {
    const int grid = fast_grid(); if (grid <= 0) return;
    Args a = make_args(d_in, d_out, d_ws); a.ph_lo = lo; a.ph_hi = hi;
    if ((lo == 0) && hipMemsetAsync((unsigned char*)d_ws + WS_CTL, 0, CTL_BYTES, stream) != hipSuccess) { fprintf(stderr, "memset of the barrier words failed\n"); return; }
    void* args[] = {&a};
    hipError_t e = hipLaunchCooperativeKernel((const void*)fwd, dim3(grid), dim3(512), args, LDS_BYTES, stream);
    if (e != hipSuccess) fprintf(stderr, "cooperative launch failed: %s (grid %d)\n", hipGetErrorString(e), grid);
}
#undef LAS
}
extern "C" void kernel_launch(void* const* d_in, const int* in_sizes, int n_in, void* d_out, int out_size, void* d_ws, size_t ws_size, hipStream_t stream) {
    (void)in_sizes; (void)n_in; (void)out_size; (void)ws_size;
    fx::launch_phases(d_in, d_out, d_ws, 0, fx::N_PHASES, stream);
}
```

```cpp
#include <hip/hip_runtime.h>
#include <hip/hip_cooperative_groups.h>
#include <hip/hip_bf16.h>
#include <cstdio>
#include <cstdint>
#include <cmath>
namespace cg = cooperative_groups;

namespace pg8 {
#define PG8_LAS __attribute__((address_space(3)))
typedef unsigned short bf16_t;
typedef short bf16x8 __attribute__((ext_vector_type(8)));
typedef float f32x4 __attribute__((ext_vector_type(4)));
typedef unsigned u32x4 __attribute__((ext_vector_type(4)));
constexpr int BM = 256, BK = 64, HALF = 128, HTB = HALF * BK * 2  , STAGE_BYTES = 8 * HTB, NXCD = 8, WGM = 8;

__host__ __device__ __forceinline__ int lds_byte(int r, int c) { const int st = (r >> 4) * 2 + (c >> 5), rr = r & 15, cc = c & 31, ob = rr * 64 + cc * 2; return st * 1024 + (ob ^ (((ob >> 9) & 1) << 5)); }
__host__ __device__ __forceinline__ void stage_rc(int b, int& R, int& C) { const int st = b / 1024, sb = b % 1024, swz = sb ^ (((sb >> 9) & 1) << 5); R = (st >> 1) * 16 + swz / 64; C = (st & 1) * 32 + (swz % 64) / 2; }
__host__ __device__ __forceinline__ int perm32(int rho) { const int n = rho >> 4, i = rho & 15; return 8 * (i >> 2) + 4 * n + (i & 3); }

struct Unit { int pm, pn; };
struct Gemm { const bf16_t* A; const bf16_t* Bt; int M, N, K; };

struct StaticOrder {
    int nM, nN, nwg, G, c;
    __host__ __device__ void init(int M, int N, int G_, int c_) { nM = M / BM; nN = N / BM; nwg = nM * nN; G = G_; c = c_; }
    __host__ __device__ bool next(int i, Unit& u) const {
        const long L = (long)i * G + c; if (L >= nwg) return false;
        int wgid = (int)L; { const int q = nwg / NXCD, r = nwg % NXCD, xcd = wgid % NXCD, off = wgid / NXCD; wgid = (xcd < r ? xcd * (q + 1) : r * (q + 1) + (xcd - r) * q) + off; }
        const int nig = WGM * nN, gid = wgid / nig, fm = gid * WGM, gsz = (nM - fm) < WGM ? (nM - fm) : WGM;
        u.pm = fm + ((wgid % nig) % gsz); u.pn = (wgid % nig) / gsz; return true;
    }
    __device__ __forceinline__ void a_ready(const Unit&) const {}
    __device__ __forceinline__ void done(const Unit&) const {}
};

__device__ __forceinline__ unsigned cvt_pk_bf16(float lo, float hi) { unsigned r; asm volatile("v_cvt_pk_bf16_f32 %0, %1, %2" : "=v"(r) : "v"(lo), "v"(hi)); return r; }
template <class Epi, class Sched, bool ALIGN_EPI = false, bool SP2 = false>
__device__ __forceinline__ void gemm_phase(PG8_LAS unsigned char* lds, const Gemm g, const Sched& S, const Epi& E) {
    int tid_ = threadIdx.x; asm volatile("" : "+v"(tid_));
    const int tid = tid_, wid = __builtin_amdgcn_readfirstlane(tid >> 6), lane = tid & 63, wr = wid >> 2, wc = wid & 3, fr = lane & 15, fq = lane >> 4;
    const int K = g.K, nt = K / BK;
    unsigned voffA[2], voffB[2];
#pragma unroll
    for (int i = 0; i < 2; ++i) { int R, C; stage_rc(tid * 16 + i * 8192, R, C); const int Rb = Epi::PERM ? ((R & ~31) + perm32(R & 31)) : R;
        voffA[i] = (unsigned)(R * K + C) * 2u; voffB[i] = (unsigned)(Rb * K + C) * 2u; }
    const size_t kstep = (size_t)(BK * 2);
    const size_t hstep = (size_t)HALF * K * 2;
    const size_t tstep = 2 * hstep;
    const unsigned ldsw = (unsigned)wid * 1024u;
    const int aoff = lds_byte(wr * 64 + fr, fq * 8), boff = lds_byte(wc * 32 + fr, fq * 8);
#define PG8_SA(b, h) (((b) * 2 + (h)) * HTB)
#define PG8_SB(b, h) ((4 + (b) * 2 + (h)) * HTB)
#define PG8_STAGE(bufoff, gbase, voff) do { _Pragma("unroll") for (int _i = 0; _i < 2; ++_i) \
        __builtin_amdgcn_global_load_lds((const unsigned*)((const char*)(gbase) + (voff)[_i]), (PG8_LAS unsigned*)(lds + (bufoff) + ldsw + _i * 8192), 16, 0, 0); } while (0)
#define PG8_LDA(dst, b, h) do { _Pragma("unroll") for (int m = 0; m < 4; ++m) _Pragma("unroll") for (int k = 0; k < 2; ++k) dst[m][k] = *(const PG8_LAS bf16x8*)(lds + PG8_SA(b, h) + aoff + m * 2048 + k * 1024); } while (0)
#define PG8_LDB(dst, b, h) do { _Pragma("unroll") for (int n = 0; n < 2; ++n) _Pragma("unroll") for (int k = 0; k < 2; ++k) dst[n][k] = *(const PG8_LAS bf16x8*)(lds + PG8_SB(b, h) + boff + n * 2048 + k * 1024); } while (0)
#define PG8_MMA(ai, bj, At, Bt) do { __builtin_amdgcn_s_setprio(1); _Pragma("unroll") for (int m = 0; m < 4; ++m) _Pragma("unroll") for (int n = 0; n < 2; ++n) _Pragma("unroll") for (int k = 0; k < 2; ++k) \
        acc[ai][bj][m][n] = __builtin_amdgcn_mfma_f32_16x16x32_bf16(Bt[n][k], At[m][k], acc[ai][bj][m][n], 0, 0, 0); __builtin_amdgcn_s_setprio(0); } while (0)
#define PG8_WAIT_V(n) asm volatile("s_waitcnt vmcnt(" #n ")" ::: "memory")
#define PG8_WAIT_L(n) asm volatile("s_waitcnt lgkmcnt(" #n ")" ::: "memory")
#define PG8_BAR __builtin_amdgcn_s_barrier()
#define PG8_SCHED __builtin_amdgcn_sched_barrier(0)
    Unit cur, nxt; int ui = 0;
    if (!S.next(0, cur)) return;
    f32x4 acc[2][2][4][2];
#pragma unroll
    for (int a = 0; a < 2; ++a)
#pragma unroll
        for (int b = 0; b < 2; ++b)
#pragma unroll
            for (int m = 0; m < 4; ++m)
#pragma unroll
                for (int n = 0; n < 2; ++n) acc[a][b][m][n] = (f32x4){0.f, 0.f, 0.f, 0.f};
    bf16x8 At[4][2], B0[2][2], B1[2][2];
    const char* cA = (const char*)g.A + (size_t)cur.pm * tstep; const char* cB = (const char*)g.Bt + (size_t)cur.pn * tstep;
    S.a_ready(cur);
    if constexpr (SP2) {
        PG8_STAGE(PG8_SB(0, 0), cB, voffB); PG8_STAGE(PG8_SB(0, 1), cB + hstep, voffB); PG8_STAGE(PG8_SA(0, 0), cA, voffA); PG8_STAGE(PG8_SA(0, 1), cA + hstep, voffA);
        if (wr == 1) PG8_BAR;
        PG8_WAIT_V(2); PG8_BAR;
        PG8_STAGE(PG8_SB(1, 0), cB + kstep, voffB); PG8_STAGE(PG8_SA(1, 0), cA + kstep, voffA); PG8_STAGE(PG8_SB(1, 1), cB + hstep + kstep, voffB);
        PG8_WAIT_V(6); PG8_BAR;
    } else {
        PG8_STAGE(PG8_SB(0, 0), cB, voffB); PG8_STAGE(PG8_SA(0, 0), cA, voffA); PG8_STAGE(PG8_SB(0, 1), cB + hstep, voffB); PG8_STAGE(PG8_SA(0, 1), cA + hstep, voffA);
        if (wr == 1) PG8_BAR;
        PG8_WAIT_V(4); PG8_BAR;
        PG8_STAGE(PG8_SB(1, 0), cB + kstep, voffB); PG8_STAGE(PG8_SA(1, 0), cA + kstep, voffA); PG8_STAGE(PG8_SB(1, 1), cB + hstep + kstep, voffB);
        PG8_WAIT_V(6); PG8_BAR;
    }
    for (;;) {
        const bool has_next = S.next(ui + 1, nxt);
        const char* nA = has_next ? (const char*)g.A + (size_t)nxt.pm * tstep : cA; const char* nB = has_next ? (const char*)g.Bt + (size_t)nxt.pn * tstep : cB;
        for (int t = 0; t < nt; t += 2) {
            const bool last = (t == nt - 2);
            const char* a1 = cA + (size_t)(t + 1) * kstep;
            const char* a2 = last ? nA : cA + (size_t)(t + 2) * kstep; const char* b2 = last ? nB : cB + (size_t)(t + 2) * kstep;
            const char* a3 = a2 + kstep; const char* b3 = b2 + kstep;
            if (last && has_next) S.a_ready(nxt);
            if constexpr (SP2) {
            PG8_LDB(B0, 0, 0); PG8_LDB(B1, 0, 1); PG8_SCHED; PG8_LDA(At, 0, 0); PG8_STAGE(PG8_SA(1, 1), a1 + hstep, voffA);
            PG8_WAIT_V(8); PG8_WAIT_L(0); PG8_BAR; PG8_MMA(0, 0, At, B0); PG8_MMA(0, 1, At, B1); PG8_BAR; PG8_SCHED;
            PG8_LDA(At, 0, 1); PG8_STAGE(PG8_SB(0, 0), b2, voffB); PG8_STAGE(PG8_SB(0, 1), b2 + hstep, voffB); PG8_STAGE(PG8_SA(0, 0), a2, voffA);
            PG8_WAIT_V(8); PG8_WAIT_L(0); PG8_BAR; PG8_MMA(1, 0, At, B0); PG8_MMA(1, 1, At, B1); PG8_BAR; PG8_SCHED;
            PG8_LDB(B0, 1, 0); PG8_LDB(B1, 1, 1); PG8_SCHED; PG8_LDA(At, 1, 0); PG8_STAGE(PG8_SA(0, 1), a2 + hstep, voffA);
            PG8_WAIT_V(8); PG8_WAIT_L(0); PG8_BAR; PG8_MMA(0, 0, At, B0); PG8_MMA(0, 1, At, B1); PG8_BAR; PG8_SCHED;
            PG8_LDA(At, 1, 1); PG8_STAGE(PG8_SB(1, 0), b3, voffB); PG8_STAGE(PG8_SB(1, 1), b3 + hstep, voffB); PG8_STAGE(PG8_SA(1, 0), a3, voffA);
            PG8_WAIT_V(8); PG8_WAIT_L(0); PG8_BAR; PG8_MMA(1, 0, At, B0); PG8_MMA(1, 1, At, B1); PG8_BAR; PG8_SCHED;
            } else {
            PG8_LDB(B0, 0, 0); PG8_SCHED; PG8_LDA(At, 0, 0); PG8_STAGE(PG8_SA(1, 1), a1 + hstep, voffA);
            PG8_WAIT_L(8); PG8_BAR; PG8_WAIT_L(0); PG8_MMA(0, 0, At, B0); PG8_BAR; PG8_SCHED;
            PG8_LDB(B1, 0, 1); PG8_STAGE(PG8_SB(0, 0), b2, voffB);
            PG8_BAR; PG8_WAIT_L(0); PG8_MMA(0, 1, At, B1); PG8_BAR;
            PG8_LDA(At, 0, 1); PG8_STAGE(PG8_SA(0, 0), a2, voffA);
            PG8_BAR; PG8_WAIT_L(0); PG8_MMA(1, 0, At, B0); PG8_BAR; PG8_SCHED;
            PG8_STAGE(PG8_SB(0, 1), b2 + hstep, voffB);
            PG8_WAIT_V(6); PG8_BAR; PG8_MMA(1, 1, At, B1); PG8_BAR;
            PG8_LDB(B0, 1, 0); PG8_SCHED; PG8_LDA(At, 1, 0); PG8_STAGE(PG8_SA(0, 1), a2 + hstep, voffA);
            PG8_WAIT_L(8); PG8_BAR; PG8_WAIT_L(0); PG8_MMA(0, 0, At, B0); PG8_BAR; PG8_SCHED;
            PG8_LDB(B1, 1, 1); PG8_STAGE(PG8_SB(1, 0), b3, voffB);
            PG8_BAR; PG8_WAIT_L(0); PG8_MMA(0, 1, At, B1); PG8_BAR;
            PG8_LDA(At, 1, 1); PG8_STAGE(PG8_SA(1, 0), a3, voffA);
            PG8_BAR; PG8_WAIT_L(0); PG8_MMA(1, 0, At, B0); PG8_BAR; PG8_SCHED;
            PG8_STAGE(PG8_SB(1, 1), b3 + hstep, voffB);
            PG8_WAIT_V(6); PG8_BAR; PG8_MMA(1, 1, At, B1); PG8_BAR;
            }
        }
        if constexpr (ALIGN_EPI) { if (wr == 0) PG8_BAR; }
        if constexpr (!Epi::AFTER_DRAIN) { E(acc, cur, wr, wc, fr, fq); S.done(cur); }
        if (!has_next) break;
#pragma unroll
        for (int a = 0; a < 2; ++a)
#pragma unroll
            for (int b = 0; b < 2; ++b)
#pragma unroll
                for (int m = 0; m < 4; ++m)
#pragma unroll
                    for (int n = 0; n < 2; ++n) acc[a][b][m][n] = (f32x4){0.f, 0.f, 0.f, 0.f};
        cur = nxt; cA = nA; cB = nB; ++ui;
        if constexpr (ALIGN_EPI) { if (wr == 1) PG8_BAR; }
    }
    PG8_WAIT_V(0);
    if constexpr (!ALIGN_EPI) { if (wr == 0) PG8_BAR; }
    PG8_BAR;
    if constexpr (Epi::AFTER_DRAIN) { E.fused(acc, cur, wr, wc, fr, fq, lds, wid, lane); S.done(cur); }
#undef PG8_SA
#undef PG8_SB
#undef PG8_STAGE
#undef PG8_LDA
#undef PG8_LDB
#undef PG8_MMA
#undef PG8_WAIT_V
#undef PG8_WAIT_L
#undef PG8_BAR
#undef PG8_SCHED
}
}
namespace fx {
using pg8::bf16_t; using pg8::bf16x8; using pg8::f32x4; using pg8::u32x4;
#define LAS __attribute__((address_space(3)))
typedef float f32x16 __attribute__((ext_vector_type(16)));
typedef unsigned u32x2 __attribute__((ext_vector_type(2)));
typedef short v4i16_t __attribute__((ext_vector_type(4)));
constexpr int D = 1024, INC = 2304, FH = 2816, NMOD = 6144, MTOT = 12288, MCTX = 8192;
constexpr float EPS = 1e-6f;
constexpr float LOG2E = 1.4426950408889634f;
constexpr float C2 = 0.125f * LOG2E;
constexpr size_t MiB = 1u << 20;
constexpr size_t WS_MOD = 0;
constexpr size_t WS_LAM = 256 * 1024;
constexpr size_t WS_GTAB = 320 * 1024;
constexpr size_t WS_BIN = 512 * 1024;
constexpr size_t WS_BGU = 768 * 1024;
constexpr size_t WS_ROPE = 1 * MiB;
constexpr size_t WS_SSQ1 = 2 * MiB;
constexpr size_t WS_SSQ2 = 3 * MiB;
constexpr size_t WS_CTL = 3840 * 1024, CTL_BYTES = 16384;
constexpr size_t WS_WT = 4 * MiB;
constexpr size_t WT_IN = 0, WT_OUT = 4718592, WT_GU = WT_OUT + 2097152, WT_DN = WT_GU + 11534336, WT_LAYER = WT_DN + 5767168;
static_assert(WT_LAYER == 23 * MiB, "weight copies per layer");
constexpr size_t WS_CACHE = WS_WT + 2 * WT_LAYER;
constexpr size_t WS_CDK = WS_CACHE, WS_CDV = WS_CACHE + 4 * MiB, WS_CGK = WS_CACHE + 8 * MiB, WS_CGV = WS_CACHE + 9 * MiB;
constexpr size_t WS_AP = WS_CACHE + 10 * MiB;
constexpr size_t WS_PQ = WS_AP + 24 * MiB;
constexpr size_t WS_O = WS_PQ + 54 * MiB;
constexpr size_t WS_HD = WS_PQ;
constexpr size_t WS_FAST_END = WS_O + 24 * MiB;
constexpr size_t O_Y = 0, O_DK = (size_t)12288 * 1024, O_DV = O_DK + (size_t)8192 * 2 * 512, O_GK = O_DV + (size_t)8192 * 2 * 512, O_GV = O_GK + (size_t)8192 * 2 * 128;
constexpr int LDS_BYTES = 147456;

__device__ __forceinline__ unsigned f2bf(float f) { unsigned u = __builtin_bit_cast(unsigned, f); return (u + 0x7fffu + ((u >> 16) & 1u)) >> 16; }
__device__ __forceinline__ unsigned pk2(float lo, float hi) { return f2bf(lo) | (f2bf(hi) << 16); }
__device__ __forceinline__ float wave_sum(float v) {
#pragma unroll
    for (int o = 1; o < 64; o <<= 1) v += __shfl_xor(v, o);
    return v;
}
__host__ __device__ __forceinline__ int col_slot(int kind, int col) {
    int pn, bj, wc, j;
    if (kind == 0) { pn = col >> 8; const int c = col & 255; wc = c >> 6; bj = (c >> 5) & 1; j = c & 31; }
    else if (kind == 1) { pn = col >> 8; const int c = col & 255; bj = c >> 7; wc = (c >> 5) & 3; j = c & 31; }
    else { bj = col >= FH ? 1 : 0; const int cc = col - FH * bj; pn = cc >> 7; wc = (cc >> 5) & 3; j = cc & 31; }
    const int fq = j >> 3, n = (j >> 2) & 1, i = j & 3;
    return 256 * pn + 128 * bj + 32 * wc + 16 * n + 4 * fq + i;
}
__host__ __device__ __forceinline__ int slot_col(int kind, int s) {
    const int pn = s >> 8, t = s & 255, bj = t >> 7, wc = (t >> 5) & 3, n = (t >> 4) & 1, fq = (t >> 2) & 3, i = t & 3;
    if (kind == 0) return 256 * pn + 64 * wc + 32 * bj + 8 * fq + 4 * n + i;
    if (kind == 1) return 256 * pn + 128 * bj + 32 * wc + 8 * fq + 4 * n + i;
    return FH * bj + 128 * pn + 32 * wc + 8 * fq + 4 * n + i;
}

struct Args { const float* in[25]; float* out; unsigned char* ws; int ph_lo, ph_hi; };

__device__ __forceinline__ void p0_transpose_pair(const float* W, int K, int N, bf16_t* WT, int kind, LAS float* scr, int itemA, int itemB, bool hasB, int lane) {
    const int nblk = N / 32;
    const int k0a = 64 * (itemA / nblk), n0a = 32 * (itemA % nblk), k0b = 64 * (itemB / nblk), n0b = 32 * (itemB % nblk);
    float va[32], vb[32];
#pragma unroll
    for (int i = 0; i < 32; ++i) va[i] = __builtin_nontemporal_load(W + (size_t)(k0a + 2 * i + (lane >> 5)) * N + n0a + (lane & 31));
    if (hasB) {
#pragma unroll
        for (int i = 0; i < 32; ++i) vb[i] = __builtin_nontemporal_load(W + (size_t)(k0b + 2 * i + (lane >> 5)) * N + n0b + (lane & 31));
    }
    const int c = lane & 7;
#pragma unroll
    for (int i = 0; i < 32; ++i) scr[(2 * i + (lane >> 5)) * 33 + (lane & 31)] = va[i];
    asm volatile("s_waitcnt lgkmcnt(0)" ::: "memory");
#pragma unroll
    for (int j = 0; j < 4; ++j) { const int n = (lane >> 3) + 8 * j; const LAS float* s = scr + (8 * c) * 33 + n;
        u32x4 o; o.x = pk2(s[0 * 33], s[1 * 33]); o.y = pk2(s[2 * 33], s[3 * 33]); o.z = pk2(s[4 * 33], s[5 * 33]); o.w = pk2(s[6 * 33], s[7 * 33]);
        __builtin_nontemporal_store(o, (u32x4*)(WT + (size_t)col_slot(kind, n0a + n) * K + k0a + 8 * c)); }
    asm volatile("s_waitcnt lgkmcnt(0)" ::: "memory");
    if (hasB) {
#pragma unroll
        for (int i = 0; i < 32; ++i) scr[(2 * i + (lane >> 5)) * 33 + (lane & 31)] = vb[i];
        asm volatile("s_waitcnt lgkmcnt(0)" ::: "memory");
#pragma unroll
        for (int j = 0; j < 4; ++j) { const int n = (lane >> 3) + 8 * j; const LAS float* s = scr + (8 * c) * 33 + n;
            u32x4 o; o.x = pk2(s[0 * 33], s[1 * 33]); o.y = pk2(s[2 * 33], s[3 * 33]); o.z = pk2(s[4 * 33], s[5 * 33]); o.w = pk2(s[6 * 33], s[7 * 33]);
            __builtin_nontemporal_store(o, (u32x4*)(WT + (size_t)col_slot(kind, n0b + n) * K + k0b + 8 * c)); }
        asm volatile("s_waitcnt lgkmcnt(0)" ::: "memory");
    }
}
__device__ __forceinline__ void cache_item(const Args& a, int item, int lane) {
    unsigned char* ws = a.ws; const float* src; bf16_t* dst; int j = item;
    if (j < 512) { src = a.in[2]; dst = (bf16_t*)(ws + WS_CDK); } else if (j < 1024) { j -= 512; src = a.in[3]; dst = (bf16_t*)(ws + WS_CDV); }
    else if (j < 1152) { j -= 1024; src = a.in[4]; dst = (bf16_t*)(ws + WS_CGK); } else { j -= 1152; src = a.in[5]; dst = (bf16_t*)(ws + WS_CGV); }
#pragma unroll
    for (int i = 0; i < 8; ++i) { const size_t e = (size_t)j * 4096 + (size_t)i * 512 + lane * 8;
        const f32x4 v0 = __builtin_nontemporal_load((const f32x4*)(src + e)), v1 = __builtin_nontemporal_load((const f32x4*)(src + e + 4));
        u32x4 o; o.x = pk2(v0[0], v0[1]); o.y = pk2(v0[2], v0[3]); o.z = pk2(v1[0], v1[1]); o.w = pk2(v1[2], v1[3]);
        *(u32x4*)(dst + e) = o; }
}
__device__ __forceinline__ void conv_mat(const Args& a, LAS float* scr, int mat, int l, int gw, int NGW, int lane) {
    unsigned char* wt = a.ws + WS_WT + (size_t)l * WT_LAYER;
    const float* W; int K, N, kind, NI; bf16_t* WT;
    if (mat == 0)      { W = a.in[11] + (size_t)l * D * INC;    K = D;  N = INC;    kind = 0; NI = 16 * 72;  WT = (bf16_t*)(wt + WT_IN); }
    else if (mat == 1) { W = a.in[21] + (size_t)l * D * D;      K = D;  N = D;      kind = 1; NI = 16 * 32;  WT = (bf16_t*)(wt + WT_OUT); }
    else if (mat == 2) { W = a.in[23] + (size_t)l * D * 2 * FH; K = D;  N = 2 * FH; kind = 2; NI = 16 * 176; WT = (bf16_t*)(wt + WT_GU); }
    else               { W = a.in[24] + (size_t)l * FH * D;     K = FH; N = D;      kind = 1; NI = 44 * 32;  WT = (bf16_t*)(wt + WT_DN); }
    for (int it = gw; it < NI; it += 2 * NGW) { const int itB = it + NGW; const bool hasB = itB < NI; p0_transpose_pair(W, K, N, WT, kind, scr, it, hasB ? itB : it, hasB, lane); }
}
__device__ __forceinline__ void phase0(const Args& a, LAS unsigned char* lds) {
    int tid_ = threadIdx.x; asm volatile("" : "+v"(tid_));
    const int tid = tid_, lane = tid & 63, wid = __builtin_amdgcn_readfirstlane(tid >> 6);
    const int G = gridDim.x, bx = blockIdx.x;
    unsigned char* ws = a.ws;
    for (int u = bx; u < 192; u += G) {
        LAS float* s = (LAS float*)lds;
        LAS float* red = (LAS float*)(lds + 20480);
        for (int i = tid; i < 5 * 1024; i += 512) { const int c = i >> 10, k = i & 1023; const float x = c < 4 ? a.in[6][c * 1024 + k] : a.in[7][k]; s[i] = x / (1.f + __expf(-x)); }
        __syncthreads();
        const int l = u / 96, n0 = (u % 96) * 64;
        const float* w = a.in[8] + (size_t)l * 1024 * NMOD + (size_t)(wid * 128) * NMOD + n0 + lane;
        float a0 = 0.f, a1 = 0.f, a2 = 0.f, a3 = 0.f, a4 = 0.f;
#pragma unroll 16
        for (int k = 0; k < 128; ++k) { const float wv = __builtin_nontemporal_load(w + (size_t)k * NMOD); const int kk = wid * 128 + k;
            a0 += s[kk] * wv; a1 += s[1024 + kk] * wv; a2 += s[2048 + kk] * wv; a3 += s[3072 + kk] * wv; a4 += s[4096 + kk] * wv; }
        red[(wid * 5 + 0) * 64 + lane] = a0; red[(wid * 5 + 1) * 64 + lane] = a1; red[(wid * 5 + 2) * 64 + lane] = a2; red[(wid * 5 + 3) * 64 + lane] = a3; red[(wid * 5 + 4) * 64 + lane] = a4;
        __syncthreads();
        if (tid < 320) { const int c = tid >> 6; float sum = 0.f;
#pragma unroll
            for (int ww = 0; ww < 8; ++ww) sum += red[(ww * 5 + c) * 64 + lane];
            ((float*)(ws + WS_MOD))[(size_t)(l * 5 + c) * NMOD + n0 + lane] = sum + a.in[9][l * NMOD + n0 + lane]; }
        __syncthreads();
    }
    if (bx == G - 1 && wid < 2) {
        const int ll = wid;
        const float s1 = wave_sum(a.in[14][ll * 64 + lane] * a.in[15][ll * 64 + lane]), s2 = wave_sum(a.in[16][ll * 64 + lane] * a.in[17][ll * 64 + lane]);
        const float li = 0.8f - 0.6f * expf(-0.3f * (float)ll);
        if (lane == 0) { float* lm = (float*)(ws + WS_LAM); lm[ll] = expf(s1) - expf(s2) + li; lm[2 + ll] = li; }
    }
    {
        LAS float* scr = (LAS float*)(lds + 32768 + wid * 8704);
        const int gw = bx * 8 + wid, NGW = G * 8;
        conv_mat(a, scr, 0, 0, gw, NGW, lane); conv_mat(a, scr, 1, 0, gw, NGW, lane);
        for (int it = gw; it < 1280; it += NGW) cache_item(a, it, lane);
    }
    {
        const size_t gt = (size_t)bx * 512 + tid, GT = (size_t)G * 512;
        float* rope = (float*)(ws + WS_ROPE);
        for (size_t i = gt; i < 32768; i += GT) { const int t = (int)(i >> 5), ii = (int)(i & 31);
            const float pos = (ii < 16) ? (float)(t >> 6) : (float)(t & 63);
            const float freq = powf(10000.0f, -(float)(2 * (ii & 15)) / 32.0f);
            const float ang = pos * freq; rope[i] = cosf(ang); rope[32768 + i] = sinf(ang); }
    }
}
__device__ __forceinline__ void bias_rows(const Args& a, LAS float* red, int l, int isgu, int gw, int NGW, int lane) {
    unsigned char* ws = a.ws; const float* mod = (const float*)(ws + WS_MOD);
    const int nrows = isgu ? 2 * FH : INC, kind = isgu ? 2 : 0;
    const bf16_t* wt = (const bf16_t*)(ws + WS_WT + (size_t)l * WT_LAYER + (isgu ? WT_GU : WT_IN));
    float* bias = (float*)(ws + (isgu ? WS_BGU : WS_BIN)) + (size_t)l * 5 * nrows;
    float sh[5][16];
#pragma unroll
    for (int c = 0; c < 5; ++c) { const float* sp = mod + (size_t)(l * 5 + c) * NMOD + (isgu ? 3072 : 0);
#pragma unroll
        for (int h = 0; h < 2; ++h) { const f32x4 v0 = *(const f32x4*)(sp + h * 512 + lane * 8), v1 = *(const f32x4*)(sp + h * 512 + lane * 8 + 4);
            sh[c][h * 8 + 0] = v0[0]; sh[c][h * 8 + 1] = v0[1]; sh[c][h * 8 + 2] = v0[2]; sh[c][h * 8 + 3] = v0[3]; sh[c][h * 8 + 4] = v1[0]; sh[c][h * 8 + 5] = v1[1]; sh[c][h * 8 + 6] = v1[2]; sh[c][h * 8 + 7] = v1[3]; } }
    for (int s0 = gw * 8; s0 < nrows; s0 += NGW * 8) {
        u32x4 w0[8], w1[8];
#pragma unroll
        for (int j = 0; j < 8; ++j) { w0[j] = *(const u32x4*)(wt + (size_t)(s0 + j) * D + lane * 8); w1[j] = *(const u32x4*)(wt + (size_t)(s0 + j) * D + 512 + lane * 8); }
#pragma unroll
        for (int j = 0; j < 8; ++j) {
            float wv[16];
#pragma unroll
            for (int q = 0; q < 4; ++q) { wv[2 * q] = __uint_as_float(w0[j][q] << 16); wv[2 * q + 1] = __uint_as_float(w0[j][q] & 0xffff0000u); wv[8 + 2 * q] = __uint_as_float(w1[j][q] << 16); wv[8 + 2 * q + 1] = __uint_as_float(w1[j][q] & 0xffff0000u); }
#pragma unroll
            for (int c = 0; c < 5; ++c) { float d = 0.f;
#pragma unroll
                for (int e = 0; e < 16; ++e) d += sh[c][e] * wv[e];
                red[(j * 5 + c) * 64 + lane] = d; }
        }
        asm volatile("s_waitcnt lgkmcnt(0)" ::: "memory");
        if (lane < 40) {
            const LAS f32x4* rp = (const LAS f32x4*)(red + lane * 64); f32x4 acc = rp[0];
#pragma unroll
            for (int q = 1; q < 16; ++q) acc += rp[q];
            const float d = (acc[0] + acc[1]) + (acc[2] + acc[3]);
            const int j = lane / 5, c = lane - 5 * j;
            bias[(size_t)c * nrows + slot_col(kind, s0 + j)] = d;
        }
        asm volatile("s_waitcnt lgkmcnt(0)" ::: "memory");
    }
}
__device__ __forceinline__ void phase1(const Args& a, LAS unsigned char* lds) {
    int tid_ = threadIdx.x; asm volatile("" : "+v"(tid_));
    const int tid = tid_, lane = tid & 63, wid = __builtin_amdgcn_readfirstlane(tid >> 6);
    const int G = gridDim.x, bx = blockIdx.x;
    unsigned char* ws = a.ws;
    const float* mod = (const float*)(ws + WS_MOD);
    const size_t gt = (size_t)bx * 512 + tid, GT = (size_t)G * 512;
    { float* gt_ = (float*)(ws + WS_GTAB);
      for (size_t i = gt; i < 2 * 2 * 5 * 1024; i += GT) { const int k = (int)(i & 1023), c = (int)((i >> 10) % 5), w = (int)((i / 5120) & 1), l = (int)(i / 10240);
          const float nw = w == 0 ? a.in[10][l * D + k] : a.in[22][l * D + k];
          gt_[i] = nw * (1.f + mod[(size_t)(l * 5 + c) * NMOD + (w == 0 ? 1024 : 4096) + k]); } }
    const int gw = bx * 8 + wid, NGW = G * 8;
    bias_rows(a, (LAS float*)(lds + wid * 10240), 0, 0, gw, NGW, lane);
    { bf16_t* AP = (bf16_t*)(ws + WS_AP); float* ssq = (float*)(ws + WS_SSQ1);
      for (int m = gw; m < MTOT; m += NGW) {
          const float* xr = m < MCTX ? a.in[0] + (size_t)m * D : a.in[1] + (size_t)(m - MCTX) * D;
          const int c = m < MCTX ? 4 : (m - MCTX) >> 10;
          const float* sc = mod + (size_t)(0 * 5 + c) * NMOD + 1024; const float* nw = a.in[10];
          float ss = 0.f;
#pragma unroll
          for (int h = 0; h < 2; ++h) { const int k = h * 512 + lane * 8;
              const f32x4 x0 = *(const f32x4*)(xr + k), x1 = *(const f32x4*)(xr + k + 4), s0 = *(const f32x4*)(sc + k), s1 = *(const f32x4*)(sc + k + 4), n0 = *(const f32x4*)(nw + k), n1 = *(const f32x4*)(nw + k + 4);
              ss += (x0[0] * x0[0] + x0[1] * x0[1]) + (x0[2] * x0[2] + x0[3] * x0[3]) + (x1[0] * x1[0] + x1[1] * x1[1]) + (x1[2] * x1[2] + x1[3] * x1[3]);
              const f32x4 y0 = x0 * (n0 * (s0 + 1.f)), y1 = x1 * (n1 * (s1 + 1.f));
              u32x4 o; o.x = pk2(y0[0], y0[1]); o.y = pk2(y0[2], y0[3]); o.z = pk2(y1[0], y1[1]); o.w = pk2(y1[2], y1[3]);
              *(u32x4*)(AP + (size_t)m * D + k) = o; }
          ss = wave_sum(ss);
          if (lane < 16) ssq[(size_t)m * 16 + lane] = lane == 0 ? ss : 0.f;
      } }
}
__device__ __forceinline__ void side_job(const Args& a, LAS unsigned char* lds, int job) {
    int tid_ = threadIdx.x; asm volatile("" : "+v"(tid_));
    const int lane = tid_ & 63, wid = __builtin_amdgcn_readfirstlane(tid_ >> 6);
    const int G = gridDim.x, bx = blockIdx.x;
    int first = (job == 0 || job == 3) ? 176 : job == 2 ? 32 : 192;
#ifdef JOB3_ALL
    if (job == 3) first = 0;
#endif
    if (G != 256) first = 0;
    if (bx < first) return;
    const int gw = (bx - first) * 8 + wid, NGW = (G - first) * 8;
    LAS float* scr = (LAS float*)(lds + wid * 10240);
    if (job == 0) conv_mat(a, scr, 2, 0, gw, NGW, lane);
    else if (job == 1) { conv_mat(a, scr, 3, 0, gw, NGW, lane); conv_mat(a, scr, 0, 1, gw, NGW, lane); bias_rows(a, (LAS float*)(lds + wid * 10240), 0, 1, gw, NGW, lane); }
    else if (job == 2) { bias_rows(a, (LAS float*)(lds + wid * 10240), 1, 0, gw, NGW, lane); conv_mat(a, scr, 1, 1, gw, NGW, lane); conv_mat(a, scr, 2, 1, gw, NGW, lane); conv_mat(a, scr, 3, 1, gw, NGW, lane); }
    else bias_rows(a, (LAS float*)(lds + wid * 10240), 1, 1, gw, NGW, lane);
}
__device__ __forceinline__ void rows_rstd(const float* ssq, int row0, int fq, float (&rstd)[4]) {
    f32x4 p[4];
#pragma unroll
    for (int mm = 0; mm < 4; ++mm) p[mm] = *(const f32x4*)(ssq + (size_t)(row0 + mm * 16) * 16 + fq * 4);
#pragma unroll
    for (int mm = 0; mm < 4; ++mm) { float s = (p[mm][0] + p[mm][1]) + (p[mm][2] + p[mm][3]); s += __shfl_xor(s, 16); s += __shfl_xor(s, 32);
        rstd[mm] = 1.0f / sqrtf(s * (1.f / D) + EPS); }
}
struct EpiIn {
    static constexpr bool PERM = false, AFTER_DRAIN = false;
    int l; bf16_t* PQ; float* out; const float* ssq; const float* bias; const float* rope; const float *qna, *kna, *qnb, *knb;
    __device__ __forceinline__ void operator()(const f32x4 (&acc)[2][2][4][2], const pg8::Unit& u, int wr, int wc, int fr, int fq) const {
        const int pm = u.pm, pn = u.pn; const bool lat = pm >= 32; const int cond = lat ? (pm - 32) >> 2 : 4;
        const int cb = 256 * pn + 64 * wc + 8 * fq;
        const float* gain = nullptr; float gsc = 1.f;
        if (pn < 2) { gain = qna; gsc = C2; } else if (pn < 4) gain = kna; else if (pn < 6) gain = nullptr; else if (pn < 8) { gain = qnb; gsc = C2; } else if (wc < 2) gain = knb;
        float* obase = nullptr; int ocol = 0, opitch = 0;
        if (!lat) {
            if (pn == 2 || pn == 3) { obase = out + O_DK; ocol = cb - 512; opitch = 512; }
            else if (pn == 4 || pn == 5) { obase = out + O_DV; ocol = cb - 1024; opitch = 512; }
            else if (pn == 8) { if (wc < 2) { obase = out + O_GK; ocol = cb - 2048; } else { obase = out + O_GV; ocol = cb - 2176; } opitch = 128; }
        }
        f32x4 bv[2][2], gv[2][2];
#pragma unroll
        for (int bj = 0; bj < 2; ++bj)
#pragma unroll
            for (int n = 0; n < 2; ++n) { bv[bj][n] = *(const f32x4*)(bias + (size_t)cond * INC + cb + 32 * bj + 4 * n);
                gv[bj][n] = gain ? *(const f32x4*)(gain + 32 * bj + 8 * fq + 4 * n) * gsc : (f32x4){1.f, 1.f, 1.f, 1.f}; }
#pragma unroll
        for (int ai = 0; ai < 2; ++ai) {
            float rstd_[4]; rows_rstd(ssq, pm * 256 + ai * 128 + wr * 64 + fr, fq, rstd_);
#pragma unroll
            for (int m = 0; m < 4; ++m) {
                const int row = pm * 256 + ai * 128 + wr * 64 + m * 16 + fr;
                const float rstd = rstd_[m];
                f32x4 v[2][2];
#pragma unroll
                for (int bj = 0; bj < 2; ++bj)
#pragma unroll
                    for (int n = 0; n < 2; ++n) v[bj][n] = acc[ai][bj][m][n] * rstd + bv[bj][n];
                if (obase && pn != 2 && pn != 3 && !(pn == 8 && wc < 2)) {
                    float* op = obase + ((size_t)(pm * 2 + l) * 256 + (row & 255)) * opitch + ocol;
#pragma unroll
                    for (int bj = 0; bj < 2; ++bj) { __builtin_nontemporal_store(v[bj][0], (f32x4*)(op + 32 * bj)); __builtin_nontemporal_store(v[bj][1], (f32x4*)(op + 32 * bj + 4)); }
                }
                if (gain) {
                    float q = 0.f;
#pragma unroll
                    for (int bj = 0; bj < 2; ++bj)
#pragma unroll
                        for (int n = 0; n < 2; ++n) q += (v[bj][n][0] * v[bj][n][0] + v[bj][n][1] * v[bj][n][1]) + (v[bj][n][2] * v[bj][n][2] + v[bj][n][3] * v[bj][n][3]);
                    q += __shfl_xor(q, 16); q += __shfl_xor(q, 32);
                    const float rn = 1.0f / sqrtf(q * (1.f / 64.f) + EPS);
                    if (obase) {
                        float* op = obase + ((size_t)(pm * 2 + l) * 256 + (row & 255)) * opitch + ocol;
#pragma unroll
                        for (int bj = 0; bj < 2; ++bj) { __builtin_nontemporal_store(v[bj][0] * rn * gv[bj][0], (f32x4*)(op + 32 * bj)); __builtin_nontemporal_store(v[bj][1] * rn * gv[bj][1], (f32x4*)(op + 32 * bj + 4)); }
                    }
#pragma unroll
                    for (int bj = 0; bj < 2; ++bj)
#pragma unroll
                        for (int n = 0; n < 2; ++n) v[bj][n] = v[bj][n] * rn * gv[bj][n];
                    if (lat) {
                        const int t = (row - MCTX) & 1023;
#pragma unroll
                        for (int n = 0; n < 2; ++n) { const f32x4 cs = *(const f32x4*)(rope + (size_t)t * 32 + 8 * fq + 4 * n), sn = *(const f32x4*)(rope + 32768 + (size_t)t * 32 + 8 * fq + 4 * n);
                            const f32x4 x1 = v[0][n], x2 = v[1][n]; v[0][n] = x1 * cs - x2 * sn; v[1][n] = x2 * cs + x1 * sn; }
                    }
                }
                bf16_t* pp = PQ + (size_t)row * INC + cb;
#pragma unroll
                for (int bj = 0; bj < 2; ++bj) { u32x4 w; w.x = pg8::cvt_pk_bf16(v[bj][0][0], v[bj][0][1]); w.y = pg8::cvt_pk_bf16(v[bj][0][2], v[bj][0][3]); w.z = pg8::cvt_pk_bf16(v[bj][1][0], v[bj][1][1]); w.w = pg8::cvt_pk_bf16(v[bj][1][2], v[bj][1][3]);
                    *(u32x4*)(pp + 32 * bj) = w; }
            }
        }
    }
};
struct EpiRes {
    static constexpr bool PERM = false, AFTER_DRAIN = false;
    const float* xin_ctx; const float* xin_lat; float* xout; const float* gate; const float* gtab; bf16_t* AP; float* ssq; int nt_in; int nt_out;
    __device__ __forceinline__ void operator()(const f32x4 (&acc)[2][2][4][2], const pg8::Unit& u, int wr, int wc, int fr, int fq) const {
        const int pm = u.pm, pn = u.pn; const bool lat = pm >= 32; const int cond = lat ? (pm - 32) >> 2 : 4;
        const int cb = 256 * pn + 32 * wc + 8 * fq;
        const float* xin = lat ? xin_lat : xin_ctx;
        f32x4 gv[2][2], Gv[2][2];
#pragma unroll
        for (int bj = 0; bj < 2; ++bj)
#pragma unroll
            for (int n = 0; n < 2; ++n) { gv[bj][n] = *(const f32x4*)(gate + (size_t)cond * NMOD + cb + 128 * bj + 4 * n);
                Gv[bj][n] = gtab ? *(const f32x4*)(gtab + (size_t)cond * D + cb + 128 * bj + 4 * n) : (f32x4){0.f, 0.f, 0.f, 0.f}; }
#pragma unroll
        for (int ai = 0; ai < 2; ++ai)
#pragma unroll
            for (int m = 0; m < 4; ++m) {
                const int row = pm * 256 + ai * 128 + wr * 64 + m * 16 + fr;
                const size_t ro = (size_t)row * D + cb;
                float ss = 0.f;
#pragma unroll
                for (int bj = 0; bj < 2; ++bj) { f32x4 xn[2];
#pragma unroll
                    for (int n = 0; n < 2; ++n) { const f32x4 xo = nt_in ? __builtin_nontemporal_load((const f32x4*)(xin + ro + 128 * bj + 4 * n)) : *(const f32x4*)(xin + ro + 128 * bj + 4 * n); xn[n] = xo + gv[bj][n] * acc[ai][bj][m][n];
                        if (nt_out) __builtin_nontemporal_store(xn[n], (f32x4*)(xout + ro + 128 * bj + 4 * n)); else *(f32x4*)(xout + ro + 128 * bj + 4 * n) = xn[n];
                        ss += (xn[n][0] * xn[n][0] + xn[n][1] * xn[n][1]) + (xn[n][2] * xn[n][2] + xn[n][3] * xn[n][3]); }
                    if (gtab) { const f32x4 y0 = xn[0] * Gv[bj][0], y1 = xn[1] * Gv[bj][1];
                        u32x4 w; w.x = pg8::cvt_pk_bf16(y0[0], y0[1]); w.y = pg8::cvt_pk_bf16(y0[2], y0[3]); w.z = pg8::cvt_pk_bf16(y1[0], y1[1]); w.w = pg8::cvt_pk_bf16(y1[2], y1[3]);
                        *(u32x4*)(AP + ro + 128 * bj) = w; } }
                if (gtab) { ss += __shfl_xor(ss, 16); ss += __shfl_xor(ss, 32); if (fq == 0) ssq[(size_t)row * 16 + 4 * pn + wc] = ss; }
            }
    }
};
struct EpiGU {
    static constexpr bool PERM = false, AFTER_DRAIN = false;
    bf16_t* HD; const float* ssq; const float* bias;
    __device__ __forceinline__ void operator()(const f32x4 (&acc)[2][2][4][2], const pg8::Unit& u, int wr, int wc, int fr, int fq) const {
        const int pm = u.pm, pn = u.pn; const bool lat = pm >= 32; const int cond = lat ? (pm - 32) >> 2 : 4;
        const int cbh = 128 * pn + 32 * wc + 8 * fq;
        f32x4 bg[2], bu[2];
#pragma unroll
        for (int n = 0; n < 2; ++n) { bg[n] = *(const f32x4*)(bias + (size_t)cond * 2 * FH + cbh + 4 * n); bu[n] = *(const f32x4*)(bias + (size_t)cond * 2 * FH + FH + cbh + 4 * n); }
#pragma unroll
        for (int ai = 0; ai < 2; ++ai) {
            float rstd_[4]; rows_rstd(ssq, pm * 256 + ai * 128 + wr * 64 + fr, fq, rstd_);
#pragma unroll
            for (int m = 0; m < 4; ++m) {
                const int row = pm * 256 + ai * 128 + wr * 64 + m * 16 + fr;
                const float rstd = rstd_[m];
                float h[8];
#pragma unroll
                for (int n = 0; n < 2; ++n) { const f32x4 g = acc[ai][0][m][n] * rstd + bg[n], uu = acc[ai][1][m][n] * rstd + bu[n];
#pragma unroll
                    for (int i = 0; i < 4; ++i) h[4 * n + i] = g[i] * __builtin_amdgcn_rcpf(1.f + __builtin_amdgcn_exp2f(-g[i] * LOG2E)) * uu[i]; }
                u32x4 w; w.x = pg8::cvt_pk_bf16(h[0], h[1]); w.y = pg8::cvt_pk_bf16(h[2], h[3]); w.z = pg8::cvt_pk_bf16(h[4], h[5]); w.w = pg8::cvt_pk_bf16(h[6], h[7]);
                *(u32x4*)(HD + (size_t)row * FH + cbh) = w;
            }
        }
    }
};
namespace at {
constexpr int STAGE = 32768, SLOT_K = 0, SLOT_V = 16384;
struct UnitDesc { int diff; int lat; int b; int head; int qb; };
__device__ __forceinline__ v4i16_t vtr(const LAS unsigned char* p) { return __builtin_amdgcn_ds_read_tr16_b64_v4i16((LAS v4i16_t*)p); }
__device__ __forceinline__ float swap_max(float v) { auto rr = __builtin_amdgcn_permlane32_swap(__float_as_uint(v), __float_as_uint(v), false, false); return fmaxf(__uint_as_float(rr[0]), __uint_as_float(rr[1])); }
__device__ __forceinline__ float swap_sum(float v) { auto rr = __builtin_amdgcn_permlane32_swap(__float_as_uint(v), __float_as_uint(v), false, false); return __uint_as_float(rr[0]) + __uint_as_float(rr[1]); }

struct Strm { const bf16_t* Q; const bf16_t* Kown; const bf16_t* Vown; const bf16_t* Kc; const bf16_t* Vc; int cpitch; int NOWN; int NT; int diff; };
__device__ __forceinline__ Strm mk_strm(const UnitDesc U, int l, const bf16_t* PQ, const unsigned char* ws, int wid) {
    Strm s; const int comp = U.diff ? (wid >> 2) : 0, g = U.head >> 2;
    const int rowbase = U.lat ? MCTX + U.b * 1024 : U.b * 256;
    const int qrow0 = rowbase + (U.diff ? U.qb * 128 + (wid & 3) * 32 : U.qb * 256 + wid * 32);
    const int qcol = U.diff ? U.head * 128 + comp * 64 : 1536 + U.head * 64;
    const int kcol = U.diff ? 512 + U.head * 128 : 2048 + g * 64, vcol = U.diff ? 1024 + U.head * 128 : 2176 + g * 64;
    s.Q = PQ + (size_t)qrow0 * INC + qcol;
    s.Kown = PQ + (size_t)rowbase * INC + kcol; s.Vown = PQ + (size_t)rowbase * INC + vcol;
    s.Kc = U.diff ? (const bf16_t*)(ws + WS_CDK) + (size_t)(U.b * 2 + l) * 512 * 512 + U.head * 128 : (const bf16_t*)(ws + WS_CGK) + (size_t)(U.b * 2 + l) * 512 * 128 + g * 64;
    s.Vc = U.diff ? (const bf16_t*)(ws + WS_CDV) + (size_t)(U.b * 2 + l) * 512 * 512 + U.head * 128 : (const bf16_t*)(ws + WS_CGV) + (size_t)(U.b * 2 + l) * 512 * 128 + g * 64;
    s.cpitch = U.diff ? 512 : 128; s.NOWN = U.lat ? 16 : 4; s.NT = U.lat ? 24 : 4; s.diff = U.diff;
    return s;
}
constexpr int KRING = 0, VRING = 32768, SLOT = 16384, XCH = 65536, QPARK = 98304;
__device__ __forceinline__ void dma_k(LAS unsigned char* lds, const Strm s, int t, int lane, int wid) {
    const bool own = t < s.NOWN; const int tt = own ? t : t - s.NOWN; const int pitch = own ? INC : s.cpitch;
    const bf16_t* kb = (own ? s.Kown : s.Kc) + (size_t)tt * 64 * pitch; LAS unsigned char* st = lds + KRING + (t & 1) * SLOT;
    __builtin_amdgcn_global_load_lds((const unsigned*)(kb + (size_t)lane * pitch + wid * 8), (LAS unsigned*)(st + wid * 1024), 16, 0, 0);
    if (s.diff) __builtin_amdgcn_global_load_lds((const unsigned*)(kb + 64 + (size_t)lane * pitch + wid * 8), (LAS unsigned*)(st + 8192 + wid * 1024), 16, 0, 0);
}
__device__ __forceinline__ void dma_v(LAS unsigned char* lds, const Strm s, int t, int lane, int wid) {
    const bool own = t < s.NOWN; const int tt = own ? t : t - s.NOWN; const int pitch = own ? INC : s.cpitch;
    const bf16_t* vb = (own ? s.Vown : s.Vc) + (size_t)tt * 64 * pitch; LAS unsigned char* st = lds + VRING + (t & 1) * SLOT;
    { const int p = wid; __builtin_amdgcn_global_load_lds((const unsigned*)(vb + (size_t)(16 * (p & 3) + (lane >> 2)) * pitch + (p >> 2) * 32 + (lane & 3) * 8), (LAS unsigned*)(st + p * 1024), 16, 0, 0); }
    if (s.diff) { const int p = wid + 8; __builtin_amdgcn_global_load_lds((const unsigned*)(vb + (size_t)(16 * (p & 3) + (lane >> 2)) * pitch + (p >> 2) * 32 + (lane & 3) * 8), (LAS unsigned*)(st + p * 1024), 16, 0, 0); }
}
__device__ __forceinline__ void prologue_dma(LAS unsigned char* lds, const Strm s, int lane, int wid) {
    dma_k(lds, s, 0, lane, wid); dma_v(lds, s, 0, lane, wid); dma_k(lds, s, 1, lane, wid);
    const bf16_t* qb = s.Q + (size_t)(lane & 31) * INC + (lane >> 5) * 8;
#pragma unroll
    for (int d0 = 0; d0 < 4; ++d0) __builtin_amdgcn_global_load_lds((const unsigned*)(qb + d0 * 16), (LAS unsigned*)(lds + QPARK + wid * 4096 + d0 * 1024), 16, 0, 0);
}
#define AT_WAITBAR() do { asm volatile("s_waitcnt vmcnt(0) lgkmcnt(0)" ::: "memory"); __builtin_amdgcn_s_barrier(); asm volatile("" ::: "memory"); } while (0)
template <bool DIFF, int VAR>
__device__ __forceinline__ void attn_unit(LAS unsigned char* lds, const UnitDesc U, const Strm S, const bool has_nxt, const Strm nxt, int l, const unsigned char* ws, bf16_t* O, const float* subln_l) {
    constexpr int ND0 = DIFF ? 4 : 2;
    int tid_ = threadIdx.x; asm volatile("" : "+v"(tid_));
    const int tid = tid_, lane = tid & 63, r32 = lane & 31, hi = lane >> 5, wid = __builtin_amdgcn_readfirstlane(tid >> 6);
    const int comp = DIFF ? (wid >> 2) : 0;
    const int rowbase = U.lat ? MCTX + U.b * 1024 : U.b * 256;
    const int qrow0 = rowbase + (DIFF ? U.qb * 128 + (wid & 3) * 32 : U.qb * 256 + wid * 32);
    const int NT = (VAR == 5) ? 2 : S.NT;
    const LAS unsigned char* qpark = lds + QPARK + wid * 4096 + lane * 16;
#define AT_QK(P0, P1, t) do { const LAS unsigned char* kp_ = lds + KRING + ((t) & 1) * SLOT + comp * 8192 + hi * 1024 + r32 * 16; P0 = f32x16{}; P1 = f32x16{}; \
        _Pragma("unroll") for (int d0 = 0; d0 < 4; ++d0) { const bf16x8 b0_ = *(const LAS bf16x8*)(kp_ + d0 * 2048), b1_ = *(const LAS bf16x8*)(kp_ + d0 * 2048 + 512); \
            const bf16x8 q_ = *(const LAS bf16x8*)(qpark + d0 * 1024); P0 = __builtin_amdgcn_mfma_f32_32x32x16_bf16(b0_, q_, P0, 0, 0, 0); P1 = __builtin_amdgcn_mfma_f32_32x32x16_bf16(b1_, q_, P1, 0, 0, 0); } } while (0)
    f32x16 o[ND0];
#pragma unroll
    for (int d0 = 0; d0 < ND0; ++d0) o[d0] = f32x16{};
    float mrun = -1e30f, lrun = 0.f;
    f32x16 c0, c1, n0, n1;
    AT_WAITBAR();
    AT_QK(c0, c1, 0);
    for (int t = 0; t < NT; ++t) {
        AT_WAITBAR();
        if (t + 2 < NT) dma_k(lds, S, t + 2, lane, wid);
        if (t + 1 < NT) dma_v(lds, S, t + 1, lane, wid);
        if (t + 1 < NT) AT_QK(n0, n1, t + 1);
        else if (has_nxt) prologue_dma(lds, nxt, lane, wid);
        float rm = fmaxf(c0[0], c1[0]);
#pragma unroll
        for (int r = 1; r < 16; ++r) rm = fmaxf(rm, fmaxf(c0[r], c1[r]));
        rm = swap_max(rm);
        if (__any(rm > mrun + 8.0f)) {
            const float mn = fmaxf(mrun, rm), f = __builtin_amdgcn_exp2f(mrun - mn);
            mrun = mn; lrun *= f;
#pragma unroll
            for (int d0 = 0; d0 < ND0; ++d0)
#pragma unroll
                for (int r = 0; r < 16; ++r) o[d0][r] *= f;
        }
        float ls = 0.f;
#pragma unroll
        for (int r = 0; r < 16; ++r) { c0[r] = __builtin_amdgcn_exp2f(c0[r] - mrun); c1[r] = __builtin_amdgcn_exp2f(c1[r] - mrun); ls += c0[r] + c1[r]; }
        lrun += ls;
        u32x4 pw[4];
#pragma unroll
        for (int q = 0; q < 4; ++q) { pw[0][q] = pg8::cvt_pk_bf16(c0[2 * q], c0[2 * q + 1]); pw[1][q] = pg8::cvt_pk_bf16(c0[8 + 2 * q], c0[8 + 2 * q + 1]);
                                      pw[2][q] = pg8::cvt_pk_bf16(c1[2 * q], c1[2 * q + 1]); pw[3][q] = pg8::cvt_pk_bf16(c1[8 + 2 * q], c1[8 + 2 * q + 1]); }
        const LAS unsigned char* vp = lds + VRING + (t & 1) * SLOT + ((lane >> 4) & 1) * 32 + (lane & 3) * 8 + (4 * hi + ((lane & 15) >> 2)) * 64;
#pragma unroll
        for (int ks = 0; ks < 4; ++ks)
#pragma unroll
            for (int d0 = 0; d0 < ND0; ++d0) {
                const v4i16_t lo = vtr(vp + d0 * 4096 + ks * 1024), hh = vtr(vp + d0 * 4096 + ks * 1024 + 512);
                const bf16x8 vf = (bf16x8){lo[0], lo[1], lo[2], lo[3], hh[0], hh[1], hh[2], hh[3]};
                o[d0] = __builtin_amdgcn_mfma_f32_32x32x16_bf16(vf, __builtin_bit_cast(bf16x8, pw[ks]), o[d0], 0, 0, 0);
            }
        c0 = n0; c1 = n1;
    }
#undef AT_QK
    lrun = swap_sum(lrun);
    const float inv = 1.0f / lrun;
#pragma unroll
    for (int d0 = 0; d0 < ND0; ++d0)
#pragma unroll
        for (int r = 0; r < 16; ++r) o[d0][r] *= inv;
    const int orow = qrow0 + r32;
    if (DIFF) {
        const float lam = ((const float*)(ws + WS_LAM))[l], li = ((const float*)(ws + WS_LAM))[2 + l];
        LAS float* xch = (LAS float*)(lds + XCH + (wid & 3) * 8192);
        float ss = 0.f;
#pragma unroll
        for (int half = 0; half < 2; ++half) {
            if (comp == 1) {
#pragma unroll
                for (int d = 0; d < 2; ++d)
#pragma unroll
                    for (int r = 0; r < 16; ++r) xch[(d * 16 + r) * 64 + lane] = o[2 * half + d][r];
            }
            asm volatile("s_waitcnt lgkmcnt(0)" ::: "memory"); __builtin_amdgcn_s_barrier(); asm volatile("" ::: "memory");
            if (comp == 0) {
#pragma unroll
                for (int d = 0; d < 2; ++d)
#pragma unroll
                    for (int r = 0; r < 16; ++r) { o[2 * half + d][r] -= lam * xch[(d * 16 + r) * 64 + lane]; ss += o[2 * half + d][r] * o[2 * half + d][r]; }
            }
            asm volatile("s_waitcnt lgkmcnt(0)" ::: "memory"); __builtin_amdgcn_s_barrier(); asm volatile("" ::: "memory");
        }
        if (comp == 0) {
            ss = swap_sum(ss);
            const float rs = (1.0f / sqrtf(ss * (1.f / 128.f) + EPS)) * (1.f - li);
            bf16_t* op = O + (size_t)orow * D + U.head * 128;
#pragma unroll
            for (int d0 = 0; d0 < ND0; ++d0)
#pragma unroll
                for (int q = 0; q < 4; ++q) { const int dv0 = 32 * d0 + 8 * q + 4 * hi; const f32x4 sw = *(const f32x4*)(subln_l + dv0);
                    u32x2 w; w.x = pg8::cvt_pk_bf16(o[d0][4 * q] * rs * sw[0], o[d0][4 * q + 1] * rs * sw[1]); w.y = pg8::cvt_pk_bf16(o[d0][4 * q + 2] * rs * sw[2], o[d0][4 * q + 3] * rs * sw[3]);
                    *(u32x2*)(op + dv0) = w; }
        }
    } else {
        bf16_t* op = O + (size_t)orow * D + 512 + U.head * 64;
#pragma unroll
        for (int d0 = 0; d0 < ND0; ++d0)
#pragma unroll
            for (int q = 0; q < 4; ++q) { const int dv0 = 32 * d0 + 8 * q + 4 * hi;
                u32x2 w; w.x = pg8::cvt_pk_bf16(o[d0][4 * q], o[d0][4 * q + 1]); w.y = pg8::cvt_pk_bf16(o[d0][4 * q + 2], o[d0][4 * q + 3]);
                *(u32x2*)(op + dv0) = w; }
    }
}
__device__ __forceinline__ UnitDesc mk_ld(int i) { UnitDesc u; u.diff = 1; u.lat = 1; u.b = i >> 5; u.head = (i >> 3) & 3; u.qb = i & 7; return u; }
__device__ __forceinline__ UnitDesc mk_lg(int i) { UnitDesc u; u.diff = 0; u.lat = 1; u.b = i >> 5; u.head = (i >> 2) & 7; u.qb = i & 3; return u; }
__device__ __forceinline__ UnitDesc mk_cd(int i) { UnitDesc u; u.diff = 1; u.lat = 0; u.b = i >> 3; u.head = (i >> 1) & 3; u.qb = i & 1; return u; }
__device__ __forceinline__ UnitDesc mk_cg(int i) { UnitDesc u; u.diff = 0; u.lat = 0; u.b = i >> 3; u.head = i & 7; u.qb = 0; return u; }
__device__ __forceinline__ bool get_unit(int G, int j, int idx, UnitDesc& u) {
    if (G == 256) {
        if (j < 128) { if (idx == 0) { u = mk_ld(j); return true; } if (idx == 1) { u = mk_cg(2 * j); return true; } if (idx == 2) { u = mk_cg(2 * j + 1); return true; } return false; }
        const int k = j - 128;
        if (idx == 0) { u = mk_lg(k); return true; } if (idx == 1) { u = mk_cd(2 * k); return true; } if (idx == 2) { u = mk_cd(2 * k + 1); return true; }
        return false;
    }
    const int i = j + idx * G; if (i >= 768) return false;
    if (i < 128) u = mk_ld(i); else if (i < 256) u = mk_lg(i - 128); else if (i < 512) u = mk_cd(i - 256); else u = mk_cg(i - 512);
    return true;
}
template <int VAR> __device__ __forceinline__ void attn_phase(LAS unsigned char* lds, int l, const bf16_t* PQ, const unsigned char* ws, bf16_t* O, const float* subln_l) {
    const int G = gridDim.x; const int bx = blockIdx.x;
    const int j = (G % 8 == 0) ? (bx % 8) * (G / 8) + bx / 8 : bx;
    int tid_ = threadIdx.x; asm volatile("" : "+v"(tid_));
    const int lane = tid_ & 63, wid = __builtin_amdgcn_readfirstlane(tid_ >> 6);
    UnitDesc U, Un;
    if (VAR == 7 || VAR == 8) {
        for (int idx = 0; get_unit(G, j, idx, U); ++idx) { if ((VAR == 7) != (U.lat != 0)) continue; Strm S1 = mk_strm(U, l, PQ, ws, wid); prologue_dma(lds, S1, lane, wid);
            if (U.diff) attn_unit<true, 0>(lds, U, S1, false, S1, l, ws, O, subln_l); else attn_unit<false, 0>(lds, U, S1, false, S1, l, ws, O, subln_l); AT_WAITBAR(); }
        return; }
    if (!get_unit(G, j, 0, U)) return;
    Strm S = mk_strm(U, l, PQ, ws, wid);
    prologue_dma(lds, S, lane, wid);
    for (int idx = 0;; ++idx) {
        const bool hn = get_unit(G, j, idx + 1, Un);
        Strm Sn = S; if (hn) Sn = mk_strm(Un, l, PQ, ws, wid);
        if (U.diff) attn_unit<true, VAR>(lds, U, S, hn, Sn, l, ws, O, subln_l); else attn_unit<false, VAR>(lds, U, S, hn, Sn, l, ws, O, subln_l);
        if (!hn) break;
        U = Un; S = Sn;
    }
    AT_WAITBAR();
}
#undef AT_WAITBAR
}
#define RLX_AGENT __ATOMIC_RELAXED, __HIP_MEMORY_SCOPE_AGENT
#define XB_TMO      128
#define XB_XCNT(j)  (256  + 64 * (j))
#define XB_XSUB(j)  (1280 + 64 * (j))
#define XB_XGEN(j)  (2304 + 64 * (j))
#define XB_TOP      3328
#define XB_TOPGEN   3392
#define XCD_BAR_WORDS 3456
#define XB_SPIN_CAP (1u << 18)

__device__ __forceinline__ unsigned xb_ld(unsigned* p)              { return __hip_atomic_load(p, __ATOMIC_RELAXED, __HIP_MEMORY_SCOPE_AGENT); }
__device__ __forceinline__ unsigned xb_add(unsigned* p, unsigned v) { return __hip_atomic_fetch_add(p, v, __ATOMIC_RELAXED, __HIP_MEMORY_SCOPE_AGENT); }
__device__ __forceinline__ unsigned xb_xcc_id() { return (unsigned)__builtin_amdgcn_s_getreg((3 << 11) | 20) & 0xFu; }
#define XB_SPIN(cond, bar) do { unsigned _sp = 0; while (cond) { __builtin_amdgcn_s_sleep(1); \
    if ((++_sp & 255u) == 0u) { if (xb_ld(&(bar)[XB_TMO])) break; if (_sp > XB_SPIN_CAP) { atomicAdd(&(bar)[XB_TMO], 1u); break; } } } } while (0)

struct XcdBarrier {
    unsigned* bar; unsigned x;
    volatile LAS unsigned* st;
};

__device__ __forceinline__ XcdBarrier xcd_barrier_post(unsigned* bar, volatile LAS unsigned* st) {
    XcdBarrier b; b.bar = bar; b.x = xb_xcc_id(); b.st = st;
    if (threadIdx.x == 0) (void)xb_add(&bar[XB_XCNT(b.x)], 1u);
    return b;
}
__device__ __forceinline__ void xcd_barrier_complete(unsigned* bar, unsigned x, unsigned& nloc, unsigned& nx) {
    const unsigned G = gridDim.x * gridDim.y * gridDim.z;
    unsigned sum, cnt, mine, sp = 0u;
    for (;;) {
        sum = 0u; cnt = 0u; mine = 0u;
#pragma unroll
        for (unsigned j = 0; j < 16; ++j) { const unsigned c = xb_ld(&bar[XB_XCNT(j)]); sum += c; cnt += (c > 0u) ? 1u : 0u; mine = (j == x) ? c : mine; }
        if (sum == G) break;
        __builtin_amdgcn_s_sleep(1);
        if ((++sp & 255u) == 0u) { if (xb_ld(&bar[XB_TMO])) break; if (sp > XB_SPIN_CAP) { atomicAdd(&bar[XB_TMO], 1u); break; } }
    }
    nloc = mine > 0u ? mine : 1u; nx = cnt > 0u ? cnt : 1u;
}

__device__ __forceinline__ void xcd_barrier(const XcdBarrier& b) {
    asm volatile("s_waitcnt vmcnt(0)" ::: "memory");
    __syncthreads();
    if (threadIdx.x == 0) {
        unsigned* bar = b.bar;
        __builtin_amdgcn_s_waitcnt(0);
        unsigned nloc = b.st[0], nx = b.st[1];
        if (nloc == 0u) { xcd_barrier_complete(bar, b.x, nloc, nx); b.st[0] = nloc; b.st[1] = nx; }
        const unsigned old = xb_add(&bar[XB_XSUB(b.x)], 1u);
        const unsigned gen = old / nloc;
        if (old + 1u == (gen + 1u) * nloc) {
            __builtin_amdgcn_fence(__ATOMIC_RELEASE, "agent");
            asm volatile("s_waitcnt vmcnt(0)" ::: "memory");
            const unsigned og = xb_add(&bar[XB_TOP], 1u);
            const unsigned tg = og / nx;
            if (og + 1u == (tg + 1u) * nx) xb_add(&bar[XB_TOPGEN], 1u);
            else XB_SPIN(xb_ld(&bar[XB_TOPGEN]) == tg, bar);
            __builtin_amdgcn_fence(__ATOMIC_ACQUIRE, "agent");
            xb_add(&bar[XB_XGEN(b.x)], 1u);
            asm volatile("s_waitcnt vmcnt(0)" ::: "memory");
        } else {
            XB_SPIN(xb_ld(&bar[XB_XGEN(b.x)]) == gen, bar);
            __builtin_amdgcn_fence(__ATOMIC_ACQUIRE, "agent");
            asm volatile("s_waitcnt vmcnt(0)" ::: "memory");
        }
    }
    __syncthreads();
}

#ifndef PHMASK
#define PHMASK 127
#endif
#ifndef DOWN1_AP
#define DOWN1_AP 0
#endif
#ifndef SJ_MODE
#define SJ_MODE 1
#endif
__global__ void __launch_bounds__(512, 2) fwd(Args a) {
    extern __shared__ __attribute__((aligned(16))) unsigned char lds_raw[];
    LAS unsigned char* lds = (LAS unsigned char*)lds_raw;
    cg::grid_group grid = cg::this_grid();
    unsigned char* ws = a.ws;
    const int G = gridDim.x;
    volatile LAS unsigned* bst = (volatile LAS unsigned*)(lds + 131072 + 1024);
    if (threadIdx.x < 2) bst[threadIdx.x] = 0u;
    __syncthreads();
    XcdBarrier bar = xcd_barrier_post((unsigned*)(ws + WS_CTL), bst);
    if (a.ph_lo < -5) grid.sync();
#ifdef PROBE_PHASE
    unsigned long long pr_dt = 0ull;
#endif
    for (int ph = a.ph_lo; ph < a.ph_hi; ++ph) {
#ifdef PROBE_PHASE
      const unsigned long long pr_t0 = __builtin_amdgcn_s_memrealtime();
#endif
#ifdef REPEAT_KIND
      for (int rep_ = 0; rep_ < ((ph >= 2 && (ph - 2) % 5 == REPEAT_KIND) || (REPEAT_KIND >= 10 && ph == REPEAT_KIND - 10) || (REPEAT_KIND <= -100 && ph == -REPEAT_KIND - 100) ? 2 : 1); ++rep_) {
#else
      {
#endif
        if (ph == 0) { if (PHMASK & 1) phase0(a, lds); }
        else if (ph == 1) { if (PHMASK & 2) phase1(a, lds); }
        else {
            const int l = (ph - 2) / 5, k = (ph - 2) % 5;
            const unsigned char* wt = ws + WS_WT + (size_t)l * WT_LAYER;
            const float* mod_l = (const float*)(ws + WS_MOD) + (size_t)l * 5 * NMOD;
            if (k == 0) { if (PHMASK & 4) {
                pg8::Gemm g{(const bf16_t*)(ws + WS_AP), (const bf16_t*)(wt + WT_IN), MTOT, INC, D}; pg8::StaticOrder S; S.init(MTOT, INC, G, (int)blockIdx.x);
                EpiIn E{l, (bf16_t*)(ws + WS_PQ), a.out, (const float*)(ws + WS_SSQ1), (const float*)(ws + WS_BIN) + (size_t)l * 5 * INC, (const float*)(ws + WS_ROPE),
                        a.in[12] + l * 64, a.in[13] + l * 64, a.in[19] + l * 64, a.in[20] + l * 64};
                pg8::gemm_phase<EpiIn, pg8::StaticOrder, true, true>(lds, g, S, E);
                side_job(a, lds, l == 0 ? 0 : 3); }
            } else if (k == 1) {
                if (PHMASK & 8) at::attn_phase<0>(lds, l, (const bf16_t*)(ws + WS_PQ), ws, (bf16_t*)(ws + WS_O), a.in[18] + l * 128);
#ifdef ATT_EXTRA
                at::attn_phase<ATT_EXTRA>(lds, l, (const bf16_t*)(ws + WS_PQ), ws, (bf16_t*)(ws + WS_AP), a.in[18] + l * 128);
#endif
            } else if (k == 2) { if (PHMASK & 16) {
                pg8::Gemm g{(const bf16_t*)(ws + WS_O), (const bf16_t*)(wt + WT_OUT), MTOT, D, D}; pg8::StaticOrder S; S.init(MTOT, D, G, (int)blockIdx.x);
                EpiRes E{l == 0 ? a.in[0] : a.out, l == 0 ? a.in[1] - (size_t)MCTX * D : a.out, a.out, mod_l + 2048, (const float*)(ws + WS_GTAB) + (size_t)(l * 2 + 1) * 5 * D, (bf16_t*)(ws + WS_AP), (float*)(ws + WS_SSQ2), l == 0 ? 1 : 0, 0};
                pg8::gemm_phase<EpiRes, pg8::StaticOrder, true, true>(lds, g, S, E);
                if (l == 0) side_job(a, lds, 1); }
            } else if (k == 3) { if (PHMASK & 32) {
                pg8::Gemm g{(const bf16_t*)(ws + WS_AP), (const bf16_t*)(wt + WT_GU), MTOT, 2 * FH, D}; pg8::StaticOrder S; S.init(MTOT, 2 * FH, G, (int)blockIdx.x);
                EpiGU E{(bf16_t*)(ws + WS_HD), (const float*)(ws + WS_SSQ2), (const float*)(ws + WS_BGU) + (size_t)l * 5 * 2 * FH};
                pg8::gemm_phase<EpiGU, pg8::StaticOrder, true, true>(lds, g, S, E);
                if (l == 0) side_job(a, lds, 2); }
            } else { if (PHMASK & 64) {
                pg8::Gemm g{(const bf16_t*)(ws + WS_HD), (const bf16_t*)(wt + WT_DN), MTOT, D, FH}; pg8::StaticOrder S; S.init(MTOT, D, G, (int)blockIdx.x);
                EpiRes E{a.out, a.out, a.out, mod_l + 5120, (l == 0 || DOWN1_AP) ? (const float*)(ws + WS_GTAB) + (size_t)(1 * 2 + 0) * 5 * D : nullptr, (bf16_t*)(ws + WS_AP), (float*)(ws + WS_SSQ1), 0, l == 1 ? 1 : 0};
                pg8::gemm_phase<EpiRes, pg8::StaticOrder, true, true>(lds, g, S, E); }
            }
        }
      }
        if (ph + 1 < a.ph_hi) xcd_barrier(bar);
#ifdef EXTRA_SYNC
        if (ph + 1 < a.ph_hi) xcd_barrier(bar);
#endif
#ifdef PROBE_PHASE
        if (ph == PROBE_PHASE) pr_dt = __builtin_amdgcn_s_memrealtime() - pr_t0;
#endif
    }
#ifdef PROBE_PHASE
    if (blockIdx.x == 0) { const unsigned long long te = __builtin_amdgcn_s_memrealtime(); while (__builtin_amdgcn_s_memrealtime() - te < 4ull * pr_dt) __builtin_amdgcn_s_sleep(4); }
#endif
}
constexpr int N_PHASES = 12;
static int g_grid = 0;
static int fast_grid() {
    if (g_grid == 0) {
        int dev = 0, cus = 0, per_cu = 0;
        if (hipGetDevice(&dev) != hipSuccess || hipDeviceGetAttribute(&cus, hipDeviceAttributeMultiprocessorCount, dev) != hipSuccess) { fprintf(stderr, "device query failed\n"); g_grid = -1; return g_grid; }
        if (hipFuncSetAttribute((const void*)fwd, hipFuncAttributeMaxDynamicSharedMemorySize, LDS_BYTES) != hipSuccess) { fprintf(stderr, "hipFuncSetAttribute failed\n"); g_grid = -1; return g_grid; }
        if (hipOccupancyMaxActiveBlocksPerMultiprocessor(&per_cu, (const void*)fwd, 512, LDS_BYTES) != hipSuccess || per_cu < 1) { fprintf(stderr, "occupancy query: %d blocks per CU\n", per_cu); (void)hipGetLastError(); per_cu = 1; }
        g_grid = cus;
    }
    return g_grid;
}
static Args make_args(void* const* d_in, void* d_out, void* d_ws) { Args a{}; for (int i = 0; i < 25; ++i) a.in[i] = (const float*)d_in[i]; a.out = (float*)d_out; a.ws = (unsigned char*)d_ws; return a; }
static void launch_phases(void* const* d_in, void* d_out, void* d_ws, int lo, int hi, hipStream_t stream) {
    const int grid = fast_grid(); if (grid <= 0) return;
    Args a = make_args(d_in, d_out, d_ws); a.ph_lo = lo; a.ph_hi = hi;
    if ((lo == 0) && hipMemsetAsync((unsigned char*)d_ws + WS_CTL, 0, CTL_BYTES, stream) != hipSuccess) { fprintf(stderr, "memset of the barrier words failed\n"); return; }
    void* args[] = {&a};
    hipError_t e = hipLaunchCooperativeKernel((const void*)fwd, dim3(grid), dim3(512), args, LDS_BYTES, stream);
    if (e != hipSuccess) fprintf(stderr, "cooperative launch failed: %s (grid %d)\n", hipGetErrorString(e), grid);
}
#undef LAS
}
extern "C" void kernel_launch(void* const* d_in, const int* in_sizes, int n_in, void* d_out, int out_size, void* d_ws, size_t ws_size, hipStream_t stream) {
    (void)in_sizes; (void)n_in; (void)out_size; (void)ws_size;
    fx::launch_phases(d_in, d_out, d_ws, 0, fx::N_PHASES, stream);
}
```

```cpp
#include <hip/hip_runtime.h>
#include <hip/hip_cooperative_groups.h>
#include <hip/hip_bf16.h>
#include <cstdio>
#include <cstdint>
#include <cmath>
namespace cg = cooperative_groups;

namespace pg8 {
#define PG8_LAS __attribute__((address_space(3)))
typedef unsigned short bf16_t;
typedef short bf16x8 __attribute__((ext_vector_type(8)));
typedef float f32x4 __attribute__((ext_vector_type(4)));
typedef unsigned u32x4 __attribute__((ext_vector_type(4)));
constexpr int BM = 256, BK = 64, HALF = 128, HTB = HALF * BK * 2  , STAGE_BYTES = 8 * HTB, NXCD = 8, WGM = 8;

__host__ __device__ __forceinline__ int lds_byte(int r, int c) { const int st = (r >> 4) * 2 + (c >> 5), rr = r & 15, cc = c & 31, ob = rr * 64 + cc * 2; return st * 1024 + (ob ^ (((ob >> 9) & 1) << 5)); }
__host__ __device__ __forceinline__ void stage_rc(int b, int& R, int& C) { const int st = b / 1024, sb = b % 1024, swz = sb ^ (((sb >> 9) & 1) << 5); R = (st >> 1) * 16 + swz / 64; C = (st & 1) * 32 + (swz % 64) / 2; }
__host__ __device__ __forceinline__ int perm32(int rho) { const int n = rho >> 4, i = rho & 15; return 8 * (i >> 2) + 4 * n + (i & 3); }

struct Unit { int pm, pn; };
struct Gemm { const bf16_t* A; const bf16_t* Bt; int M, N, K; };

struct StaticOrder {
    int nM, nN, nwg, G, c;
    __host__ __device__ void init(int M, int N, int G_, int c_) { nM = M / BM; nN = N / BM; nwg = nM * nN; G = G_; c = c_; }
    __host__ __device__ bool next(int i, Unit& u) const {
        const long L = (long)i * G + c; if (L >= nwg) return false;
        int wgid = (int)L; { const int q = nwg / NXCD, r = nwg % NXCD, xcd = wgid % NXCD, off = wgid / NXCD; wgid = (xcd < r ? xcd * (q + 1) : r * (q + 1) + (xcd - r) * q) + off; }
        const int nig = WGM * nN, gid = wgid / nig, fm = gid * WGM, gsz = (nM - fm) < WGM ? (nM - fm) : WGM;
        u.pm = fm + ((wgid % nig) % gsz); u.pn = (wgid % nig) / gsz; return true;
    }
    __device__ __forceinline__ void a_ready(const Unit&) const {}
    __device__ __forceinline__ void done(const Unit&) const {}
};

__device__ __forceinline__ unsigned cvt_pk_bf16(float lo, float hi) { unsigned r; asm volatile("v_cvt_pk_bf16_f32 %0, %1, %2" : "=v"(r) : "v"(lo), "v"(hi)); return r; }
template <class Epi, class Sched, bool ALIGN_EPI = false, bool SP2 = false>
__device__ __forceinline__ void gemm_phase(PG8_LAS unsigned char* lds, const Gemm g, const Sched& S, const Epi& E) {
    int tid_ = threadIdx.x; asm volatile("" : "+v"(tid_));
    const int tid = tid_, wid = __builtin_amdgcn_readfirstlane(tid >> 6), lane = tid & 63, wr = wid >> 2, wc = wid & 3, fr = lane & 15, fq = lane >> 4;
    const int K = g.K, nt = K / BK;
    unsigned voffA[2], voffB[2];
#pragma unroll
    for (int i = 0; i < 2; ++i) { int R, C; stage_rc(tid * 16 + i * 8192, R, C); const int Rb = Epi::PERM ? ((R & ~31) + perm32(R & 31)) : R;
        voffA[i] = (unsigned)(R * K + C) * 2u; voffB[i] = (unsigned)(Rb * K + C) * 2u; }
    const size_t kstep = (size_t)(BK * 2);
    const size_t hstep = (size_t)HALF * K * 2;
    const size_t tstep = 2 * hstep;
    const unsigned ldsw = (unsigned)wid * 1024u;
    const int aoff = lds_byte(wr * 64 + fr, fq * 8), boff = lds_byte(wc * 32 + fr, fq * 8);
#define PG8_SA(b, h) (((b) * 2 + (h)) * HTB)
#define PG8_SB(b, h) ((4 + (b) * 2 + (h)) * HTB)
#define PG8_STAGE(bufoff, gbase, voff) do { _Pragma("unroll") for (int _i = 0; _i < 2; ++_i) \
        __builtin_amdgcn_global_load_lds((const unsigned*)((const char*)(gbase) + (voff)[_i]), (PG8_LAS unsigned*)(lds + (bufoff) + ldsw + _i * 8192), 16, 0, 0); } while (0)
#define PG8_LDA(dst, b, h) do { _Pragma("unroll") for (int m = 0; m < 4; ++m) _Pragma("unroll") for (int k = 0; k < 2; ++k) dst[m][k] = *(const PG8_LAS bf16x8*)(lds + PG8_SA(b, h) + aoff + m * 2048 + k * 1024); } while (0)
#define PG8_LDB(dst, b, h) do { _Pragma("unroll") for (int n = 0; n < 2; ++n) _Pragma("unroll") for (int k = 0; k < 2; ++k) dst[n][k] = *(const PG8_LAS bf16x8*)(lds + PG8_SB(b, h) + boff + n * 2048 + k * 1024); } while (0)
#define PG8_MMA(ai, bj, At, Bt) do { __builtin_amdgcn_s_setprio(1); _Pragma("unroll") for (int m = 0; m < 4; ++m) _Pragma("unroll") for (int n = 0; n < 2; ++n) _Pragma("unroll") for (int k = 0; k < 2; ++k) \
        acc[ai][bj][m][n] = __builtin_amdgcn_mfma_f32_16x16x32_bf16(Bt[n][k], At[m][k], acc[ai][bj][m][n], 0, 0, 0); __builtin_amdgcn_s_setprio(0); } while (0)
#define PG8_WAIT_V(n) asm volatile("s_waitcnt vmcnt(" #n ")" ::: "memory")
#define PG8_WAIT_L(n) asm volatile("s_waitcnt lgkmcnt(" #n ")" ::: "memory")
#define PG8_BAR __builtin_amdgcn_s_barrier()
#define PG8_SCHED __builtin_amdgcn_sched_barrier(0)
    Unit cur, nxt; int ui = 0;
    if (!S.next(0, cur)) return;
    f32x4 acc[2][2][4][2];
#pragma unroll
    for (int a = 0; a < 2; ++a)
#pragma unroll
        for (int b = 0; b < 2; ++b)
#pragma unroll
            for (int m = 0; m < 4; ++m)
#pragma unroll
                for (int n = 0; n < 2; ++n) acc[a][b][m][n] = (f32x4){0.f, 0.f, 0.f, 0.f};
    bf16x8 At[4][2], B0[2][2], B1[2][2];
    const char* cA = (const char*)g.A + (size_t)cur.pm * tstep; const char* cB = (const char*)g.Bt + (size_t)cur.pn * tstep;
    S.a_ready(cur);
    if constexpr (SP2) {
        PG8_STAGE(PG8_SB(0, 0), cB, voffB); PG8_STAGE(PG8_SB(0, 1), cB + hstep, voffB); PG8_STAGE(PG8_SA(0, 0), cA, voffA); PG8_STAGE(PG8_SA(0, 1), cA + hstep, voffA);
        if (wr == 1) PG8_BAR;
        PG8_WAIT_V(2); PG8_BAR;
        PG8_STAGE(PG8_SB(1, 0), cB + kstep, voffB); PG8_STAGE(PG8_SA(1, 0), cA + kstep, voffA); PG8_STAGE(PG8_SB(1, 1), cB + hstep + kstep, voffB);
        PG8_WAIT_V(6); PG8_BAR;
    } else {
        PG8_STAGE(PG8_SB(0, 0), cB, voffB); PG8_STAGE(PG8_SA(0, 0), cA, voffA); PG8_STAGE(PG8_SB(0, 1), cB + hstep, voffB); PG8_STAGE(PG8_SA(0, 1), cA + hstep, voffA);
        if (wr == 1) PG8_BAR;
        PG8_WAIT_V(4); PG8_BAR;
        PG8_STAGE(PG8_SB(1, 0), cB + kstep, voffB); PG8_STAGE(PG8_SA(1, 0), cA + kstep, voffA); PG8_STAGE(PG8_SB(1, 1), cB + hstep + kstep, voffB);
        PG8_WAIT_V(6); PG8_BAR;
    }
    for (;;) {
        const bool has_next = S.next(ui + 1, nxt);
        const char* nA = has_next ? (const char*)g.A + (size_t)nxt.pm * tstep : cA; const char* nB = has_next ? (const char*)g.Bt + (size_t)nxt.pn * tstep : cB;
        for (int t = 0; t < nt; t += 2) {
            const bool last = (t == nt - 2);
            const char* a1 = cA + (size_t)(t + 1) * kstep;
            const char* a2 = last ? nA : cA + (size_t)(t + 2) * kstep; const char* b2 = last ? nB : cB + (size_t)(t + 2) * kstep;
            const char* a3 = a2 + kstep; const char* b3 = b2 + kstep;
            if (last && has_next) S.a_ready(nxt);
            if constexpr (SP2) {
            PG8_LDB(B0, 0, 0); PG8_LDB(B1, 0, 1); PG8_SCHED; PG8_LDA(At, 0, 0); PG8_STAGE(PG8_SA(1, 1), a1 + hstep, voffA);
            PG8_WAIT_V(8); PG8_WAIT_L(0); PG8_BAR; PG8_MMA(0, 0, At, B0); PG8_MMA(0, 1, At, B1); PG8_BAR; PG8_SCHED;
            PG8_LDA(At, 0, 1); PG8_STAGE(PG8_SB(0, 0), b2, voffB); PG8_STAGE(PG8_SB(0, 1), b2 + hstep, voffB); PG8_STAGE(PG8_SA(0, 0), a2, voffA);
            PG8_WAIT_V(8); PG8_WAIT_L(0); PG8_BAR; PG8_MMA(1, 0, At, B0); PG8_MMA(1, 1, At, B1); PG8_BAR; PG8_SCHED;
            PG8_LDB(B0, 1, 0); PG8_LDB(B1, 1, 1); PG8_SCHED; PG8_LDA(At, 1, 0); PG8_STAGE(PG8_SA(0, 1), a2 + hstep, voffA);
            PG8_WAIT_V(8); PG8_WAIT_L(0); PG8_BAR; PG8_MMA(0, 0, At, B0); PG8_MMA(0, 1, At, B1); PG8_BAR; PG8_SCHED;
            PG8_LDA(At, 1, 1); PG8_STAGE(PG8_SB(1, 0), b3, voffB); PG8_STAGE(PG8_SB(1, 1), b3 + hstep, voffB); PG8_STAGE(PG8_SA(1, 0), a3, voffA);
            PG8_WAIT_V(8); PG8_WAIT_L(0); PG8_BAR; PG8_MMA(1, 0, At, B0); PG8_MMA(1, 1, At, B1); PG8_BAR; PG8_SCHED;
            } else {
            PG8_LDB(B0, 0, 0); PG8_SCHED; PG8_LDA(At, 0, 0); PG8_STAGE(PG8_SA(1, 1), a1 + hstep, voffA);
            PG8_WAIT_L(8); PG8_BAR; PG8_WAIT_L(0); PG8_MMA(0, 0, At, B0); PG8_BAR; PG8_SCHED;
            PG8_LDB(B1, 0, 1); PG8_STAGE(PG8_SB(0, 0), b2, voffB);
            PG8_BAR; PG8_WAIT_L(0); PG8_MMA(0, 1, At, B1); PG8_BAR;
            PG8_LDA(At, 0, 1); PG8_STAGE(PG8_SA(0, 0), a2, voffA);
            PG8_BAR; PG8_WAIT_L(0); PG8_MMA(1, 0, At, B0); PG8_BAR; PG8_SCHED;
            PG8_STAGE(PG8_SB(0, 1), b2 + hstep, voffB);
            PG8_WAIT_V(6); PG8_BAR; PG8_MMA(1, 1, At, B1); PG8_BAR;
            PG8_LDB(B0, 1, 0); PG8_SCHED; PG8_LDA(At, 1, 0); PG8_STAGE(PG8_SA(0, 1), a2 + hstep, voffA);
            PG8_WAIT_L(8); PG8_BAR; PG8_WAIT_L(0); PG8_MMA(0, 0, At, B0); PG8_BAR; PG8_SCHED;
            PG8_LDB(B1, 1, 1); PG8_STAGE(PG8_SB(1, 0), b3, voffB);
            PG8_BAR; PG8_WAIT_L(0); PG8_MMA(0, 1, At, B1); PG8_BAR;
            PG8_LDA(At, 1, 1); PG8_STAGE(PG8_SA(1, 0), a3, voffA);
            PG8_BAR; PG8_WAIT_L(0); PG8_MMA(1, 0, At, B0); PG8_BAR; PG8_SCHED;
            PG8_STAGE(PG8_SB(1, 1), b3 + hstep, voffB);
            PG8_WAIT_V(6); PG8_BAR; PG8_MMA(1, 1, At, B1); PG8_BAR;
            }
        }
        if constexpr (ALIGN_EPI) { if (wr == 0) PG8_BAR; }
        if constexpr (!Epi::AFTER_DRAIN) { E(acc, cur, wr, wc, fr, fq); S.done(cur); }
        if (!has_next) break;
#pragma unroll
        for (int a = 0; a < 2; ++a)
#pragma unroll
            for (int b = 0; b < 2; ++b)
#pragma unroll
                for (int m = 0; m < 4; ++m)
#pragma unroll
                    for (int n = 0; n < 2; ++n) acc[a][b][m][n] = (f32x4){0.f, 0.f, 0.f, 0.f};
        cur = nxt; cA = nA; cB = nB; ++ui;
        if constexpr (ALIGN_EPI) { if (wr == 1) PG8_BAR; }
    }
    PG8_WAIT_V(0);
    if constexpr (!ALIGN_EPI) { if (wr == 0) PG8_BAR; }
    PG8_BAR;
    if constexpr (Epi::AFTER_DRAIN) { E.fused(acc, cur, wr, wc, fr, fq, lds, wid, lane); S.done(cur); }
#undef PG8_SA
#undef PG8_SB
#undef PG8_STAGE
#undef PG8_LDA
#undef PG8_LDB
#undef PG8_MMA
#undef PG8_WAIT_V
#undef PG8_WAIT_L
#undef PG8_BAR
#undef PG8_SCHED
}
}
namespace fx {
using pg8::bf16_t; using pg8::bf16x8; using pg8::f32x4; using pg8::u32x4;
#define LAS __attribute__((address_space(3)))
typedef float f32x16 __attribute__((ext_vector_type(16)));
typedef unsigned u32x2 __attribute__((ext_vector_type(2)));
typedef short v4i16_t __attribute__((ext_vector_type(4)));
constexpr int D = 1024, INC = 2304, FH = 2816, NMOD = 6144, MTOT = 12288, MCTX = 8192;
constexpr float EPS = 1e-6f;
constexpr float LOG2E = 1.4426950408889634f;
constexpr float C2 = 0.125f * LOG2E;
constexpr size_t MiB = 1u << 20;
constexpr size_t WS_MOD = 0;
constexpr size_t WS_LAM = 256 * 1024;
constexpr size_t WS_GTAB = 320 * 1024;
constexpr size_t WS_BIN = 512 * 1024;
constexpr size_t WS_BGU = 768 * 1024;
constexpr size_t WS_ROPE = 1 * MiB;
constexpr size_t WS_SSQ1 = 2 * MiB;
constexpr size_t WS_SSQ2 = 3 * MiB;
constexpr size_t WS_CTL = 3840 * 1024, CTL_BYTES = 16384;
constexpr size_t WS_WT = 4 * MiB;
constexpr size_t WT_IN = 0, WT_OUT = 4718592, WT_GU = WT_OUT + 2097152, WT_DN = WT_GU + 11534336, WT_LAYER = WT_DN + 5767168;
static_assert(WT_LAYER == 23 * MiB, "weight copies per layer");
constexpr size_t WS_CACHE = WS_WT + 2 * WT_LAYER;
constexpr size_t WS_CDK = WS_CACHE, WS_CDV = WS_CACHE + 4 * MiB, WS_CGK = WS_CACHE + 8 * MiB, WS_CGV = WS_CACHE + 9 * MiB;
constexpr size_t WS_AP = WS_CACHE + 10 * MiB;
constexpr size_t WS_PQ = WS_AP + 24 * MiB;
constexpr size_t WS_O = WS_PQ + 54 * MiB;
constexpr size_t WS_HD = WS_PQ;
constexpr size_t WS_FAST_END = WS_O + 24 * MiB;
constexpr size_t O_Y = 0, O_DK = (size_t)12288 * 1024, O_DV = O_DK + (size_t)8192 * 2 * 512, O_GK = O_DV + (size_t)8192 * 2 * 512, O_GV = O_GK + (size_t)8192 * 2 * 128;
constexpr int LDS_BYTES = 147456;

__device__ __forceinline__ unsigned f2bf(float f) { unsigned u = __builtin_bit_cast(unsigned, f); return (u + 0x7fffu + ((u >> 16) & 1u)) >> 16; }
__device__ __forceinline__ unsigned pk2(float lo, float hi) { return f2bf(lo) | (f2bf(hi) << 16); }
__device__ __forceinline__ float wave_sum(float v) {
#pragma unroll
    for (int o = 1; o < 64; o <<= 1) v += __shfl_xor(v, o);
    return v;
}
__host__ __device__ __forceinline__ int col_slot(int kind, int col) {
    int pn, bj, wc, j;
    if (kind == 0) { pn = col >> 8; const int c = col & 255; wc = c >> 6; bj = (c >> 5) & 1; j = c & 31; }
    else if (kind == 1) { pn = col >> 8; const int c = col & 255; bj = c >> 7; wc = (c >> 5) & 3; j = c & 31; }
    else { bj = col >= FH ? 1 : 0; const int cc = col - FH * bj; pn = cc >> 7; wc = (cc >> 5) & 3; j = cc & 31; }
    const int fq = j >> 3, n = (j >> 2) & 1, i = j & 3;
    return 256 * pn + 128 * bj + 32 * wc + 16 * n + 4 * fq + i;
}
__host__ __device__ __forceinline__ int slot_col(int kind, int s) {
    const int pn = s >> 8, t = s & 255, bj = t >> 7, wc = (t >> 5) & 3, n = (t >> 4) & 1, fq = (t >> 2) & 3, i = t & 3;
    if (kind == 0) return 256 * pn + 64 * wc + 32 * bj + 8 * fq + 4 * n + i;
    if (kind == 1) return 256 * pn + 128 * bj + 32 * wc + 8 * fq + 4 * n + i;
    return FH * bj + 128 * pn + 32 * wc + 8 * fq + 4 * n + i;
}

struct Args { const float* in[25]; float* out; unsigned char* ws; int ph_lo, ph_hi; };

__device__ __forceinline__ void p0_transpose_pair(const float* W, int K, int N, bf16_t* WT, int kind, LAS float* scr, int itemA, int itemB, bool hasB, int lane) {
    const int nblk = N / 32;
    const int k0a = 64 * (itemA / nblk), n0a = 32 * (itemA % nblk), k0b = 64 * (itemB / nblk), n0b = 32 * (itemB % nblk);
    float va[32], vb[32];
#pragma unroll
    for (int i = 0; i < 32; ++i) va[i] = __builtin_nontemporal_load(W + (size_t)(k0a + 2 * i + (lane >> 5)) * N + n0a + (lane & 31));
    if (hasB) {
#pragma unroll
        for (int i = 0; i < 32; ++i) vb[i] = __builtin_nontemporal_load(W + (size_t)(k0b + 2 * i + (lane >> 5)) * N + n0b + (lane & 31));
    }
    const int c = lane & 7;
#pragma unroll
    for (int i = 0; i < 32; ++i) scr[(2 * i + (lane >> 5)) * 33 + (lane & 31)] = va[i];
    asm volatile("s_waitcnt lgkmcnt(0)" ::: "memory");
#pragma unroll
    for (int j = 0; j < 4; ++j) { const int n = (lane >> 3) + 8 * j; const LAS float* s = scr + (8 * c) * 33 + n;
        u32x4 o; o.x = pk2(s[0 * 33], s[1 * 33]); o.y = pk2(s[2 * 33], s[3 * 33]); o.z = pk2(s[4 * 33], s[5 * 33]); o.w = pk2(s[6 * 33], s[7 * 33]);
        __builtin_nontemporal_store(o, (u32x4*)(WT + (size_t)col_slot(kind, n0a + n) * K + k0a + 8 * c)); }
    asm volatile("s_waitcnt lgkmcnt(0)" ::: "memory");
    if (hasB) {
#pragma unroll
        for (int i = 0; i < 32; ++i) scr[(2 * i + (lane >> 5)) * 33 + (lane & 31)] = vb[i];
        asm volatile("s_waitcnt lgkmcnt(0)" ::: "memory");
#pragma unroll
        for (int j = 0; j < 4; ++j) { const int n = (lane >> 3) + 8 * j; const LAS float* s = scr + (8 * c) * 33 + n;
            u32x4 o; o.x = pk2(s[0 * 33], s[1 * 33]); o.y = pk2(s[2 * 33], s[3 * 33]); o.z = pk2(s[4 * 33], s[5 * 33]); o.w = pk2(s[6 * 33], s[7 * 33]);
            __builtin_nontemporal_store(o, (u32x4*)(WT + (size_t)col_slot(kind, n0b + n) * K + k0b + 8 * c)); }
        asm volatile("s_waitcnt lgkmcnt(0)" ::: "memory");
    }
}
__device__ __forceinline__ void cache_item(const Args& a, int item, int lane) {
    unsigned char* ws = a.ws; const float* src; bf16_t* dst; int j = item;
    if (j < 512) { src = a.in[2]; dst = (bf16_t*)(ws + WS_CDK); } else if (j < 1024) { j -= 512; src = a.in[3]; dst = (bf16_t*)(ws + WS_CDV); }
    else if (j < 1152) { j -= 1024; src = a.in[4]; dst = (bf16_t*)(ws + WS_CGK); } else { j -= 1152; src = a.in[5]; dst = (bf16_t*)(ws + WS_CGV); }
#pragma unroll
    for (int i = 0; i < 8; ++i) { const size_t e = (size_t)j * 4096 + (size_t)i * 512 + lane * 8;
        const f32x4 v0 = __builtin_nontemporal_load((const f32x4*)(src + e)), v1 = __builtin_nontemporal_load((const f32x4*)(src + e + 4));
        u32x4 o; o.x = pk2(v0[0], v0[1]); o.y = pk2(v0[2], v0[3]); o.z = pk2(v1[0], v1[1]); o.w = pk2(v1[2], v1[3]);
        *(u32x4*)(dst + e) = o; }
}
__device__ __forceinline__ void conv_mat(const Args& a, LAS float* scr, int mat, int l, int gw, int NGW, int lane) {
    unsigned char* wt = a.ws + WS_WT + (size_t)l * WT_LAYER;
    const float* W; int K, N, kind, NI; bf16_t* WT;
    if (mat == 0)      { W = a.in[11] + (size_t)l * D * INC;    K = D;  N = INC;    kind = 0; NI = 16 * 72;  WT = (bf16_t*)(wt + WT_IN); }
    else if (mat == 1) { W = a.in[21] + (size_t)l * D * D;      K = D;  N = D;      kind = 1; NI = 16 * 32;  WT = (bf16_t*)(wt + WT_OUT); }
    else if (mat == 2) { W = a.in[23] + (size_t)l * D * 2 * FH; K = D;  N = 2 * FH; kind = 2; NI = 16 * 176; WT = (bf16_t*)(wt + WT_GU); }
    else               { W = a.in[24] + (size_t)l * FH * D;     K = FH; N = D;      kind = 1; NI = 44 * 32;  WT = (bf16_t*)(wt + WT_DN); }
    for (int it = gw; it < NI; it += 2 * NGW) { const int itB = it + NGW; const bool hasB = itB < NI; p0_transpose_pair(W, K, N, WT, kind, scr, it, hasB ? itB : it, hasB, lane); }
}
__device__ __forceinline__ void phase0(const Args& a, LAS unsigned char* lds) {
    int tid_ = threadIdx.x; asm volatile("" : "+v"(tid_));
    const int tid = tid_, lane = tid & 63, wid = __builtin_amdgcn_readfirstlane(tid >> 6);
    const int G = gridDim.x, bx = blockIdx.x;
    unsigned char* ws = a.ws;
    for (int u = bx; u < 192; u += G) {
        LAS float* s = (LAS float*)lds;
        LAS float* red = (LAS float*)(lds + 20480);
        for (int i = tid; i < 5 * 1024; i += 512) { const int c = i >> 10, k = i & 1023; const float x = c < 4 ? a.in[6][c * 1024 + k] : a.in[7][k]; s[i] = x / (1.f + __expf(-x)); }
        __syncthreads();
        const int l = u / 96, n0 = (u % 96) * 64;
        const float* w = a.in[8] + (size_t)l * 1024 * NMOD + (size_t)(wid * 128) * NMOD + n0 + lane;
        float a0 = 0.f, a1 = 0.f, a2 = 0.f, a3 = 0.f, a4 = 0.f;
#pragma unroll 32
        for (int k = 0; k < 128; ++k) { const float wv = __builtin_nontemporal_load(w + (size_t)k * NMOD); const int kk = wid * 128 + k;
            a0 += s[kk] * wv; a1 += s[1024 + kk] * wv; a2 += s[2048 + kk] * wv; a3 += s[3072 + kk] * wv; a4 += s[4096 + kk] * wv; }
        red[(wid * 5 + 0) * 64 + lane] = a0; red[(wid * 5 + 1) * 64 + lane] = a1; red[(wid * 5 + 2) * 64 + lane] = a2; red[(wid * 5 + 3) * 64 + lane] = a3; red[(wid * 5 + 4) * 64 + lane] = a4;
        __syncthreads();
        if (tid < 320) { const int c = tid >> 6; float sum = 0.f;
#pragma unroll
            for (int ww = 0; ww < 8; ++ww) sum += red[(ww * 5 + c) * 64 + lane];
            ((float*)(ws + WS_MOD))[(size_t)(l * 5 + c) * NMOD + n0 + lane] = sum + a.in[9][l * NMOD + n0 + lane]; }
        __syncthreads();
    }
    if (bx == G - 1 && wid < 2) {
        const int ll = wid;
        const float s1 = wave_sum(a.in[14][ll * 64 + lane] * a.in[15][ll * 64 + lane]), s2 = wave_sum(a.in[16][ll * 64 + lane] * a.in[17][ll * 64 + lane]);
        const float li = 0.8f - 0.6f * expf(-0.3f * (float)ll);
        if (lane == 0) { float* lm = (float*)(ws + WS_LAM); lm[ll] = expf(s1) - expf(s2) + li; lm[2 + ll] = li; }
    }
    {
        LAS float* scr = (LAS float*)(lds + 32768 + wid * 8704);
        const int gw = bx * 8 + wid, NGW = G * 8;
        conv_mat(a, scr, 0, 0, gw, NGW, lane); conv_mat(a, scr, 1, 0, gw, NGW, lane);
        for (int it = gw; it < 1280; it += NGW) cache_item(a, it, lane);
    }
    {
        const size_t gt = (size_t)bx * 512 + tid, GT = (size_t)G * 512;
        float* rope = (float*)(ws + WS_ROPE);
        for (size_t i = gt; i < 32768; i += GT) { const int t = (int)(i >> 5), ii = (int)(i & 31);
            const float pos = (ii < 16) ? (float)(t >> 6) : (float)(t & 63);
            const float freq = powf(10000.0f, -(float)(2 * (ii & 15)) / 32.0f);
            const float ang = pos * freq; rope[i] = cosf(ang); rope[32768 + i] = sinf(ang); }
    }
}
__device__ __forceinline__ void bias_rows(const Args& a, LAS float* red, int l, int isgu, int gw, int NGW, int lane) {
    unsigned char* ws = a.ws; const float* mod = (const float*)(ws + WS_MOD);
    const int nrows = isgu ? 2 * FH : INC, kind = isgu ? 2 : 0;
    const bf16_t* wt = (const bf16_t*)(ws + WS_WT + (size_t)l * WT_LAYER + (isgu ? WT_GU : WT_IN));
    float* bias = (float*)(ws + (isgu ? WS_BGU : WS_BIN)) + (size_t)l * 5 * nrows;
    float sh[5][16];
#pragma unroll
    for (int c = 0; c < 5; ++c) { const float* sp = mod + (size_t)(l * 5 + c) * NMOD + (isgu ? 3072 : 0);
#pragma unroll
        for (int h = 0; h < 2; ++h) { const f32x4 v0 = *(const f32x4*)(sp + h * 512 + lane * 8), v1 = *(const f32x4*)(sp + h * 512 + lane * 8 + 4);
            sh[c][h * 8 + 0] = v0[0]; sh[c][h * 8 + 1] = v0[1]; sh[c][h * 8 + 2] = v0[2]; sh[c][h * 8 + 3] = v0[3]; sh[c][h * 8 + 4] = v1[0]; sh[c][h * 8 + 5] = v1[1]; sh[c][h * 8 + 6] = v1[2]; sh[c][h * 8 + 7] = v1[3]; } }
    for (int s0 = gw * 8; s0 < nrows; s0 += NGW * 8) {
        u32x4 w0[8], w1[8];
#pragma unroll
        for (int j = 0; j < 8; ++j) { w0[j] = *(const u32x4*)(wt + (size_t)(s0 + j) * D + lane * 8); w1[j] = *(const u32x4*)(wt + (size_t)(s0 + j) * D + 512 + lane * 8); }
#pragma unroll
        for (int j = 0; j < 8; ++j) {
            float wv[16];
#pragma unroll
            for (int q = 0; q < 4; ++q) { wv[2 * q] = __uint_as_float(w0[j][q] << 16); wv[2 * q + 1] = __uint_as_float(w0[j][q] & 0xffff0000u); wv[8 + 2 * q] = __uint_as_float(w1[j][q] << 16); wv[8 + 2 * q + 1] = __uint_as_float(w1[j][q] & 0xffff0000u); }
#pragma unroll
            for (int c = 0; c < 5; ++c) { float d = 0.f;
#pragma unroll
                for (int e = 0; e < 16; ++e) d += sh[c][e] * wv[e];
                red[(j * 5 + c) * 64 + lane] = d; }
        }
        asm volatile("s_waitcnt lgkmcnt(0)" ::: "memory");
        if (lane < 40) {
            const LAS f32x4* rp = (const LAS f32x4*)(red + lane * 64); f32x4 acc = rp[0];
#pragma unroll
            for (int q = 1; q < 16; ++q) acc += rp[q];
            const float d = (acc[0] + acc[1]) + (acc[2] + acc[3]);
            const int j = lane / 5, c = lane - 5 * j;
            bias[(size_t)c * nrows + slot_col(kind, s0 + j)] = d;
        }
        asm volatile("s_waitcnt lgkmcnt(0)" ::: "memory");
    }
}
__device__ __forceinline__ void phase1(const Args& a, LAS unsigned char* lds) {
    int tid_ = threadIdx.x; asm volatile("" : "+v"(tid_));
    const int tid = tid_, lane = tid & 63, wid = __builtin_amdgcn_readfirstlane(tid >> 6);
    const int G = gridDim.x, bx = blockIdx.x;
    unsigned char* ws = a.ws;
    const float* mod = (const float*)(ws + WS_MOD);
    const size_t gt = (size_t)bx * 512 + tid, GT = (size_t)G * 512;
    { float* gt_ = (float*)(ws + WS_GTAB);
      for (size_t i = gt; i < 2 * 2 * 5 * 1024; i += GT) { const int k = (int)(i & 1023), c = (int)((i >> 10) % 5), w = (int)((i / 5120) & 1), l = (int)(i / 10240);
          const float nw = w == 0 ? a.in[10][l * D + k] : a.in[22][l * D + k];
          gt_[i] = nw * (1.f + mod[(size_t)(l * 5 + c) * NMOD + (w == 0 ? 1024 : 4096) + k]); } }
    const int gw = bx * 8 + wid, NGW = G * 8;
    bias_rows(a, (LAS float*)(lds + wid * 10240), 0, 0, gw, NGW, lane);
    { bf16_t* AP = (bf16_t*)(ws + WS_AP); float* ssq = (float*)(ws + WS_SSQ1);
      for (int m = gw; m < MTOT; m += NGW) {
          const float* xr = m < MCTX ? a.in[0] + (size_t)m * D : a.in[1] + (size_t)(m - MCTX) * D;
          const int c = m < MCTX ? 4 : (m - MCTX) >> 10;
          const float* sc = mod + (size_t)(0 * 5 + c) * NMOD + 1024; const float* nw = a.in[10];
          float ss = 0.f;
#pragma unroll
          for (int h = 0; h < 2; ++h) { const int k = h * 512 + lane * 8;
              const f32x4 x0 = *(const f32x4*)(xr + k), x1 = *(const f32x4*)(xr + k + 4), s0 = *(const f32x4*)(sc + k), s1 = *(const f32x4*)(sc + k + 4), n0 = *(const f32x4*)(nw + k), n1 = *(const f32x4*)(nw + k + 4);
              ss += (x0[0] * x0[0] + x0[1] * x0[1]) + (x0[2] * x0[2] + x0[3] * x0[3]) + (x1[0] * x1[0] + x1[1] * x1[1]) + (x1[2] * x1[2] + x1[3] * x1[3]);
              const f32x4 y0 = x0 * (n0 * (s0 + 1.f)), y1 = x1 * (n1 * (s1 + 1.f));
              u32x4 o; o.x = pk2(y0[0], y0[1]); o.y = pk2(y0[2], y0[3]); o.z = pk2(y1[0], y1[1]); o.w = pk2(y1[2], y1[3]);
              *(u32x4*)(AP + (size_t)m * D + k) = o; }
          ss = wave_sum(ss);
          if (lane < 16) ssq[(size_t)m * 16 + lane] = lane == 0 ? ss : 0.f;
      } }
}
__device__ __forceinline__ void side_job(const Args& a, LAS unsigned char* lds, int job) {
    int tid_ = threadIdx.x; asm volatile("" : "+v"(tid_));
    const int lane = tid_ & 63, wid = __builtin_amdgcn_readfirstlane(tid_ >> 6);
    const int G = gridDim.x, bx = blockIdx.x;
    int first = (job == 0 || job == 3) ? 176 : job == 2 ? 32 : 192;
#ifdef JOB3_ALL
    if (job == 3) first = 0;
#endif
    if (G != 256) first = 0;
    if (bx < first) return;
    const int gw = (bx - first) * 8 + wid, NGW = (G - first) * 8;
    LAS float* scr = (LAS float*)(lds + wid * 10240);
    if (job == 0) conv_mat(a, scr, 2, 0, gw, NGW, lane);
    else if (job == 1) { conv_mat(a, scr, 3, 0, gw, NGW, lane); conv_mat(a, scr, 0, 1, gw, NGW, lane); bias_rows(a, (LAS float*)(lds + wid * 10240), 0, 1, gw, NGW, lane); }
    else if (job == 2) { bias_rows(a, (LAS float*)(lds + wid * 10240), 1, 0, gw, NGW, lane); conv_mat(a, scr, 1, 1, gw, NGW, lane); conv_mat(a, scr, 2, 1, gw, NGW, lane); conv_mat(a, scr, 3, 1, gw, NGW, lane); }
    else bias_rows(a, (LAS float*)(lds + wid * 10240), 1, 1, gw, NGW, lane);
}
__device__ __forceinline__ void rows_rstd(const float* ssq, int row0, int fq, float (&rstd)[4]) {
    f32x4 p[4];
#pragma unroll
    for (int mm = 0; mm < 4; ++mm) p[mm] = *(const f32x4*)(ssq + (size_t)(row0 + mm * 16) * 16 + fq * 4);
#pragma unroll
    for (int mm = 0; mm < 4; ++mm) { float s = (p[mm][0] + p[mm][1]) + (p[mm][2] + p[mm][3]); s += __shfl_xor(s, 16); s += __shfl_xor(s, 32);
        rstd[mm] = 1.0f / sqrtf(s * (1.f / D) + EPS); }
}
struct EpiIn {
    static constexpr bool PERM = false, AFTER_DRAIN = false;
    int l; bf16_t* PQ; float* out; const float* ssq; const float* bias; const float* rope; const float *qna, *kna, *qnb, *knb;
    __device__ __forceinline__ void operator()(const f32x4 (&acc)[2][2][4][2], const pg8::Unit& u, int wr, int wc, int fr, int fq) const {
        const int pm = u.pm, pn = u.pn; const bool lat = pm >= 32; const int cond = lat ? (pm - 32) >> 2 : 4;
        const int cb = 256 * pn + 64 * wc + 8 * fq;
        const float* gain = nullptr; float gsc = 1.f;
        if (pn < 2) { gain = qna; gsc = C2; } else if (pn < 4) gain = kna; else if (pn < 6) gain = nullptr; else if (pn < 8) { gain = qnb; gsc = C2; } else if (wc < 2) gain = knb;
        float* obase = nullptr; int ocol = 0, opitch = 0;
        if (!lat) {
            if (pn == 2 || pn == 3) { obase = out + O_DK; ocol = cb - 512; opitch = 512; }
            else if (pn == 4 || pn == 5) { obase = out + O_DV; ocol = cb - 1024; opitch = 512; }
            else if (pn == 8) { if (wc < 2) { obase = out + O_GK; ocol = cb - 2048; } else { obase = out + O_GV; ocol = cb - 2176; } opitch = 128; }
        }
        f32x4 bv[2][2], gv[2][2];
#pragma unroll
        for (int bj = 0; bj < 2; ++bj)
#pragma unroll
            for (int n = 0; n < 2; ++n) { bv[bj][n] = *(const f32x4*)(bias + (size_t)cond * INC + cb + 32 * bj + 4 * n);
                gv[bj][n] = gain ? *(const f32x4*)(gain + 32 * bj + 8 * fq + 4 * n) * gsc : (f32x4){1.f, 1.f, 1.f, 1.f}; }
#pragma unroll
        for (int ai = 0; ai < 2; ++ai) {
            float rstd_[4]; rows_rstd(ssq, pm * 256 + ai * 128 + wr * 64 + fr, fq, rstd_);
#pragma unroll
            for (int m = 0; m < 4; ++m) {
                const int row = pm * 256 + ai * 128 + wr * 64 + m * 16 + fr;
                const float rstd = rstd_[m];
                f32x4 v[2][2];
#pragma unroll
                for (int bj = 0; bj < 2; ++bj)
#pragma unroll
                    for (int n = 0; n < 2; ++n) v[bj][n] = acc[ai][bj][m][n] * rstd + bv[bj][n];
                if (obase && pn != 2 && pn != 3 && !(pn == 8 && wc < 2)) {
                    float* op = obase + ((size_t)(pm * 2 + l) * 256 + (row & 255)) * opitch + ocol;
#pragma unroll
                    for (int bj = 0; bj < 2; ++bj) { __builtin_nontemporal_store(v[bj][0], (f32x4*)(op + 32 * bj)); __builtin_nontemporal_store(v[bj][1], (f32x4*)(op + 32 * bj + 4)); }
                }
                if (gain) {
                    float q = 0.f;
#pragma unroll
                    for (int bj = 0; bj < 2; ++bj)
#pragma unroll
                        for (int n = 0; n < 2; ++n) q += (v[bj][n][0] * v[bj][n][0] + v[bj][n][1] * v[bj][n][1]) + (v[bj][n][2] * v[bj][n][2] + v[bj][n][3] * v[bj][n][3]);
                    q += __shfl_xor(q, 16); q += __shfl_xor(q, 32);
                    const float rn = 1.0f / sqrtf(q * (1.f / 64.f) + EPS);
                    if (obase) {
                        float* op = obase + ((size_t)(pm * 2 + l) * 256 + (row & 255)) * opitch + ocol;
#pragma unroll
                        for (int bj = 0; bj < 2; ++bj) { __builtin_nontemporal_store(v[bj][0] * rn * gv[bj][0], (f32x4*)(op + 32 * bj)); __builtin_nontemporal_store(v[bj][1] * rn * gv[bj][1], (f32x4*)(op + 32 * bj + 4)); }
                    }
#pragma unroll
                    for (int bj = 0; bj < 2; ++bj)
#pragma unroll
                        for (int n = 0; n < 2; ++n) v[bj][n] = v[bj][n] * rn * gv[bj][n];
                    if (lat) {
                        const int t = (row - MCTX) & 1023;
#pragma unroll
                        for (int n = 0; n < 2; ++n) { const f32x4 cs = *(const f32x4*)(rope + (size_t)t * 32 + 8 * fq + 4 * n), sn = *(const f32x4*)(rope + 32768 + (size_t)t * 32 + 8 * fq + 4 * n);
                            const f32x4 x1 = v[0][n], x2 = v[1][n]; v[0][n] = x1 * cs - x2 * sn; v[1][n] = x2 * cs + x1 * sn; }
                    }
                }
                bf16_t* pp = PQ + (size_t)row * INC + cb;
#pragma unroll
                for (int bj = 0; bj < 2; ++bj) { u32x4 w; w.x = pg8::cvt_pk_bf16(v[bj][0][0], v[bj][0][1]); w.y = pg8::cvt_pk_bf16(v[bj][0][2], v[bj][0][3]); w.z = pg8::cvt_pk_bf16(v[bj][1][0], v[bj][1][1]); w.w = pg8::cvt_pk_bf16(v[bj][1][2], v[bj][1][3]);
                    *(u32x4*)(pp + 32 * bj) = w; }
            }
        }
    }
};
struct EpiRes {
    static constexpr bool PERM = false, AFTER_DRAIN = false;
    const float* xin_ctx; const float* xin_lat; float* xout; const float* gate; const float* gtab; bf16_t* AP; float* ssq; int nt_in; int nt_out;
    __device__ __forceinline__ void operator()(const f32x4 (&acc)[2][2][4][2], const pg8::Unit& u, int wr, int wc, int fr, int fq) const {
        const int pm = u.pm, pn = u.pn; const bool lat = pm >= 32; const int cond = lat ? (pm - 32) >> 2 : 4;
        const int cb = 256 * pn + 32 * wc + 8 * fq;
        const float* xin = lat ? xin_lat : xin_ctx;
        f32x4 gv[2][2], Gv[2][2];
#pragma unroll
        for (int bj = 0; bj < 2; ++bj)
#pragma unroll
            for (int n = 0; n < 2; ++n) { gv[bj][n] = *(const f32x4*)(gate + (size_t)cond * NMOD + cb + 128 * bj + 4 * n);
                Gv[bj][n] = gtab ? *(const f32x4*)(gtab + (size_t)cond * D + cb + 128 * bj + 4 * n) : (f32x4){0.f, 0.f, 0.f, 0.f}; }
#pragma unroll
        for (int ai = 0; ai < 2; ++ai)
#pragma unroll
            for (int m = 0; m < 4; ++m) {
                const int row = pm * 256 + ai * 128 + wr * 64 + m * 16 + fr;
                const size_t ro = (size_t)row * D + cb;
                float ss = 0.f;
#pragma unroll
                for (int bj = 0; bj < 2; ++bj) { f32x4 xn[2];
#pragma unroll
                    for (int n = 0; n < 2; ++n) { const f32x4 xo = nt_in ? __builtin_nontemporal_load((const f32x4*)(xin + ro + 128 * bj + 4 * n)) : *(const f32x4*)(xin + ro + 128 * bj + 4 * n); xn[n] = xo + gv[bj][n] * acc[ai][bj][m][n];
                        if (nt_out) __builtin_nontemporal_store(xn[n], (f32x4*)(xout + ro + 128 * bj + 4 * n)); else *(f32x4*)(xout + ro + 128 * bj + 4 * n) = xn[n];
                        ss += (xn[n][0] * xn[n][0] + xn[n][1] * xn[n][1]) + (xn[n][2] * xn[n][2] + xn[n][3] * xn[n][3]); }
                    if (gtab) { const f32x4 y0 = xn[0] * Gv[bj][0], y1 = xn[1] * Gv[bj][1];
                        u32x4 w; w.x = pg8::cvt_pk_bf16(y0[0], y0[1]); w.y = pg8::cvt_pk_bf16(y0[2], y0[3]); w.z = pg8::cvt_pk_bf16(y1[0], y1[1]); w.w = pg8::cvt_pk_bf16(y1[2], y1[3]);
                        *(u32x4*)(AP + ro + 128 * bj) = w; } }
                if (gtab) { ss += __shfl_xor(ss, 16); ss += __shfl_xor(ss, 32); if (fq == 0) ssq[(size_t)row * 16 + 4 * pn + wc] = ss; }
            }
    }
};
struct EpiGU {
    static constexpr bool PERM = false, AFTER_DRAIN = false;
    bf16_t* HD; const float* ssq; const float* bias; int dry;
    __device__ __forceinline__ void operator()(const f32x4 (&acc)[2][2][4][2], const pg8::Unit& u, int wr, int wc, int fr, int fq) const {
        if (dry) return;
        const int pm = u.pm, pn = u.pn; const bool lat = pm >= 32; const int cond = lat ? (pm - 32) >> 2 : 4;
        const int cbh = 128 * pn + 32 * wc + 8 * fq;
        f32x4 bg[2], bu[2];
#pragma unroll
        for (int n = 0; n < 2; ++n) { bg[n] = *(const f32x4*)(bias + (size_t)cond * 2 * FH + cbh + 4 * n); bu[n] = *(const f32x4*)(bias + (size_t)cond * 2 * FH + FH + cbh + 4 * n); }
#pragma unroll
        for (int ai = 0; ai < 2; ++ai) {
            float rstd_[4]; rows_rstd(ssq, pm * 256 + ai * 128 + wr * 64 + fr, fq, rstd_);
#pragma unroll
            for (int m = 0; m < 4; ++m) {
                const int row = pm * 256 + ai * 128 + wr * 64 + m * 16 + fr;
                const float rstd = rstd_[m];
                typedef float f32x2 __attribute__((ext_vector_type(2)));
                unsigned wv[4];
#pragma unroll
                for (int n = 0; n < 2; ++n) { const f32x4 g4 = acc[ai][0][m][n] * rstd + bg[n], u4 = acc[ai][1][m][n] * rstd + bu[n];
#pragma unroll
                    for (int pr = 0; pr < 2; ++pr) { const f32x2 g = {g4[2 * pr], g4[2 * pr + 1]}, uu = {u4[2 * pr], u4[2 * pr + 1]};
                        const f32x2 arg = g * (-LOG2E);
                        f32x2 d; d.x = 1.f + __builtin_amdgcn_exp2f(fminf(arg.x, 57.f)); d.y = 1.f + __builtin_amdgcn_exp2f(fminf(arg.y, 57.f));
                        const float r = __builtin_amdgcn_rcpf(d.x * d.y);
                        const f32x2 sg = (f32x2){d.y, d.x} * r;
                        const f32x2 h = (g * sg) * uu;
                        wv[2 * n + pr] = pg8::cvt_pk_bf16(h.x, h.y); } }
                u32x4 w; w.x = wv[0]; w.y = wv[1]; w.z = wv[2]; w.w = wv[3];
                *(u32x4*)(HD + (size_t)row * FH + cbh) = w;
            }
        }
    }
};
namespace at {
constexpr int STAGE = 32768, SLOT_K = 0, SLOT_V = 16384;
struct UnitDesc { int diff; int lat; int b; int head; int qb; };
__device__ __forceinline__ v4i16_t vtr(const LAS unsigned char* p) { return __builtin_amdgcn_ds_read_tr16_b64_v4i16((LAS v4i16_t*)p); }
__device__ __forceinline__ float swap_max(float v) { auto rr = __builtin_amdgcn_permlane32_swap(__float_as_uint(v), __float_as_uint(v), false, false); return fmaxf(__uint_as_float(rr[0]), __uint_as_float(rr[1])); }
__device__ __forceinline__ float swap_sum(float v) { auto rr = __builtin_amdgcn_permlane32_swap(__float_as_uint(v), __float_as_uint(v), false, false); return __uint_as_float(rr[0]) + __uint_as_float(rr[1]); }

struct Strm { const bf16_t* Q; const bf16_t* Kown; const bf16_t* Vown; const bf16_t* Kc; const bf16_t* Vc; int cpitch; int NOWN; int NT; int diff; };
__device__ __forceinline__ Strm mk_strm(const UnitDesc U, int l, const bf16_t* PQ, const unsigned char* ws, int wid) {
    Strm s; const int comp = U.diff ? (wid >> 2) : 0, g = U.head >> 2;
    const int rowbase = U.lat ? MCTX + U.b * 1024 : U.b * 256;
    const int qrow0 = rowbase + (U.diff ? U.qb * 128 + (wid & 3) * 32 : U.qb * 256 + wid * 32);
    const int qcol = U.diff ? U.head * 128 + comp * 64 : 1536 + U.head * 64;
    const int kcol = U.diff ? 512 + U.head * 128 : 2048 + g * 64, vcol = U.diff ? 1024 + U.head * 128 : 2176 + g * 64;
    s.Q = PQ + (size_t)qrow0 * INC + qcol;
    s.Kown = PQ + (size_t)rowbase * INC + kcol; s.Vown = PQ + (size_t)rowbase * INC + vcol;
    s.Kc = U.diff ? (const bf16_t*)(ws + WS_CDK) + (size_t)(U.b * 2 + l) * 512 * 512 + U.head * 128 : (const bf16_t*)(ws + WS_CGK) + (size_t)(U.b * 2 + l) * 512 * 128 + g * 64;
    s.Vc = U.diff ? (const bf16_t*)(ws + WS_CDV) + (size_t)(U.b * 2 + l) * 512 * 512 + U.head * 128 : (const bf16_t*)(ws + WS_CGV) + (size_t)(U.b * 2 + l) * 512 * 128 + g * 64;
    s.cpitch = U.diff ? 512 : 128; s.NOWN = U.lat ? 16 : 4; s.NT = U.lat ? 24 : 4; s.diff = U.diff;
    return s;
}
constexpr int KRING = 0, VRING = 32768, SLOT = 16384, XCH = 65536, QPARK = 98304;
__device__ __forceinline__ void dma_k(LAS unsigned char* lds, const Strm s, int t, int lane, int wid) {
    const bool own = t < s.NOWN; const int tt = own ? t : t - s.NOWN; const int pitch = own ? INC : s.cpitch;
    const bf16_t* kb = (own ? s.Kown : s.Kc) + (size_t)tt * 64 * pitch; LAS unsigned char* st = lds + KRING + (t & 1) * SLOT;
    __builtin_amdgcn_global_load_lds((const unsigned*)(kb + (size_t)lane * pitch + wid * 8), (LAS unsigned*)(st + wid * 1024), 16, 0, 0);
    if (s.diff) __builtin_amdgcn_global_load_lds((const unsigned*)(kb + 64 + (size_t)lane * pitch + wid * 8), (LAS unsigned*)(st + 8192 + wid * 1024), 16, 0, 0);
}
__device__ __forceinline__ void dma_v(LAS unsigned char* lds, const Strm s, int t, int lane, int wid) {
    const bool own = t < s.NOWN; const int tt = own ? t : t - s.NOWN; const int pitch = own ? INC : s.cpitch;
    const bf16_t* vb = (own ? s.Vown : s.Vc) + (size_t)tt * 64 * pitch; LAS unsigned char* st = lds + VRING + (t & 1) * SLOT;
    { const int p = wid; __builtin_amdgcn_global_load_lds((const unsigned*)(vb + (size_t)(16 * (p & 3) + (lane >> 2)) * pitch + (p >> 2) * 32 + (lane & 3) * 8), (LAS unsigned*)(st + p * 1024), 16, 0, 0); }
    if (s.diff) { const int p = wid + 8; __builtin_amdgcn_global_load_lds((const unsigned*)(vb + (size_t)(16 * (p & 3) + (lane >> 2)) * pitch + (p >> 2) * 32 + (lane & 3) * 8), (LAS unsigned*)(st + p * 1024), 16, 0, 0); }
}
__device__ __forceinline__ void prologue_dma(LAS unsigned char* lds, const Strm s, int lane, int wid) {
    dma_k(lds, s, 0, lane, wid); dma_v(lds, s, 0, lane, wid); dma_k(lds, s, 1, lane, wid);
    const bf16_t* qb = s.Q + (size_t)(lane & 31) * INC + (lane >> 5) * 8;
#pragma unroll
    for (int d0 = 0; d0 < 4; ++d0) __builtin_amdgcn_global_load_lds((const unsigned*)(qb + d0 * 16), (LAS unsigned*)(lds + QPARK + wid * 4096 + d0 * 1024), 16, 0, 0);
}
#define AT_WAITBAR() do { asm volatile("s_waitcnt vmcnt(0) lgkmcnt(0)" ::: "memory"); __builtin_amdgcn_s_barrier(); asm volatile("" ::: "memory"); } while (0)
template <bool DIFF, int VAR>
__device__ __forceinline__ void attn_unit(LAS unsigned char* lds, const UnitDesc U, const Strm S, const bool has_nxt, const Strm nxt, int l, const unsigned char* ws, bf16_t* O, const float* subln_l) {
    constexpr int ND0 = DIFF ? 4 : 2;
    int tid_ = threadIdx.x; asm volatile("" : "+v"(tid_));
    const int tid = tid_, lane = tid & 63, r32 = lane & 31, hi = lane >> 5, wid = __builtin_amdgcn_readfirstlane(tid >> 6);
    const int comp = DIFF ? (wid >> 2) : 0;
    const int rowbase = U.lat ? MCTX + U.b * 1024 : U.b * 256;
    const int qrow0 = rowbase + (DIFF ? U.qb * 128 + (wid & 3) * 32 : U.qb * 256 + wid * 32);
    const int NT = (VAR == 5) ? 2 : S.NT;
    const LAS unsigned char* qpark = lds + QPARK + wid * 4096 + lane * 16;
#define AT_QK(P0, P1, t) do { const LAS unsigned char* kp_ = lds + KRING + ((t) & 1) * SLOT + comp * 8192 + hi * 1024 + r32 * 16; P0 = f32x16{}; P1 = f32x16{}; \
        _Pragma("unroll") for (int d0 = 0; d0 < 4; ++d0) { const bf16x8 b0_ = *(const LAS bf16x8*)(kp_ + d0 * 2048), b1_ = *(const LAS bf16x8*)(kp_ + d0 * 2048 + 512); \
            const bf16x8 q_ = *(const LAS bf16x8*)(qpark + d0 * 1024); P0 = __builtin_amdgcn_mfma_f32_32x32x16_bf16(b0_, q_, P0, 0, 0, 0); P1 = __builtin_amdgcn_mfma_f32_32x32x16_bf16(b1_, q_, P1, 0, 0, 0); } } while (0)
    f32x16 o[ND0];
#pragma unroll
    for (int d0 = 0; d0 < ND0; ++d0) o[d0] = f32x16{};
    float mrun = -1e30f, lrun = 0.f;
    f32x16 c0, c1, n0, n1;
    AT_WAITBAR();
    AT_QK(c0, c1, 0);
    for (int t = 0; t < NT; ++t) {
        AT_WAITBAR();
        if (t + 2 < NT) dma_k(lds, S, t + 2, lane, wid);
        if (t + 1 < NT) dma_v(lds, S, t + 1, lane, wid);
        if (t + 1 < NT) AT_QK(n0, n1, t + 1);
        else if (has_nxt) prologue_dma(lds, nxt, lane, wid);
        float rm = fmaxf(c0[0], c1[0]);
#pragma unroll
        for (int r = 1; r < 16; ++r) rm = fmaxf(rm, fmaxf(c0[r], c1[r]));
        rm = swap_max(rm);
        if (__any(rm > mrun + 8.0f)) {
            const float mn = fmaxf(mrun, rm), f = __builtin_amdgcn_exp2f(mrun - mn);
            mrun = mn; lrun *= f;
#pragma unroll
            for (int d0 = 0; d0 < ND0; ++d0)
#pragma unroll
                for (int r = 0; r < 16; ++r) o[d0][r] *= f;
        }
        float ls = 0.f;
#pragma unroll
        for (int r = 0; r < 16; ++r) { c0[r] = __builtin_amdgcn_exp2f(c0[r] - mrun); c1[r] = __builtin_amdgcn_exp2f(c1[r] - mrun); ls += c0[r] + c1[r]; }
        lrun += ls;
        u32x4 pw[4];
#pragma unroll
        for (int q = 0; q < 4; ++q) { pw[0][q] = pg8::cvt_pk_bf16(c0[2 * q], c0[2 * q + 1]); pw[1][q] = pg8::cvt_pk_bf16(c0[8 + 2 * q], c0[8 + 2 * q + 1]);
                                      pw[2][q] = pg8::cvt_pk_bf16(c1[2 * q], c1[2 * q + 1]); pw[3][q] = pg8::cvt_pk_bf16(c1[8 + 2 * q], c1[8 + 2 * q + 1]); }
        const LAS unsigned char* vp = lds + VRING + (t & 1) * SLOT + ((lane >> 4) & 1) * 32 + (lane & 3) * 8 + (4 * hi + ((lane & 15) >> 2)) * 64;
#pragma unroll
        for (int ks = 0; ks < 4; ++ks)
#pragma unroll
            for (int d0 = 0; d0 < ND0; ++d0) {
                const v4i16_t lo = vtr(vp + d0 * 4096 + ks * 1024), hh = vtr(vp + d0 * 4096 + ks * 1024 + 512);
                const bf16x8 vf = (bf16x8){lo[0], lo[1], lo[2], lo[3], hh[0], hh[1], hh[2], hh[3]};
                o[d0] = __builtin_amdgcn_mfma_f32_32x32x16_bf16(vf, __builtin_bit_cast(bf16x8, pw[ks]), o[d0], 0, 0, 0);
            }
        c0 = n0; c1 = n1;
    }
#undef AT_QK
    lrun = swap_sum(lrun);
    const float inv = 1.0f / lrun;
#pragma unroll
    for (int d0 = 0; d0 < ND0; ++d0)
#pragma unroll
        for (int r = 0; r < 16; ++r) o[d0][r] *= inv;
    const int orow = qrow0 + r32;
    if (DIFF) {
        const float lam = ((const float*)(ws + WS_LAM))[l], li = ((const float*)(ws + WS_LAM))[2 + l];
        LAS float* xch = (LAS float*)(lds + XCH + (wid & 3) * 8192);
        float ss = 0.f;
#pragma unroll
        for (int half = 0; half < 2; ++half) {
            if (comp == 1) {
#pragma unroll
                for (int d = 0; d < 2; ++d)
#pragma unroll
                    for (int r = 0; r < 16; ++r) xch[(d * 16 + r) * 64 + lane] = o[2 * half + d][r];
            }
            asm volatile("s_waitcnt lgkmcnt(0)" ::: "memory"); __builtin_amdgcn_s_barrier(); asm volatile("" ::: "memory");
            if (comp == 0) {
#pragma unroll
                for (int d = 0; d < 2; ++d)
#pragma unroll
                    for (int r = 0; r < 16; ++r) { o[2 * half + d][r] -= lam * xch[(d * 16 + r) * 64 + lane]; ss += o[2 * half + d][r] * o[2 * half + d][r]; }
            }
            asm volatile("s_waitcnt lgkmcnt(0)" ::: "memory"); __builtin_amdgcn_s_barrier(); asm volatile("" ::: "memory");
        }
        if (comp == 0) {
            ss = swap_sum(ss);
            const float rs = (1.0f / sqrtf(ss * (1.f / 128.f) + EPS)) * (1.f - li);
            bf16_t* op = O + (size_t)orow * D + U.head * 128;
#pragma unroll
            for (int d0 = 0; d0 < ND0; ++d0)
#pragma unroll
                for (int q = 0; q < 4; ++q) { const int dv0 = 32 * d0 + 8 * q + 4 * hi; const f32x4 sw = *(const f32x4*)(subln_l + dv0);
                    u32x2 w; w.x = pg8::cvt_pk_bf16(o[d0][4 * q] * rs * sw[0], o[d0][4 * q + 1] * rs * sw[1]); w.y = pg8::cvt_pk_bf16(o[d0][4 * q + 2] * rs * sw[2], o[d0][4 * q + 3] * rs * sw[3]);
                    if (VAR != 9 || w.x == 0x12345678u) *(u32x2*)(op + dv0) = w; }
        }
    } else {
        bf16_t* op = O + (size_t)orow * D + 512 + U.head * 64;
#pragma unroll
        for (int d0 = 0; d0 < ND0; ++d0)
#pragma unroll
            for (int q = 0; q < 4; ++q) { const int dv0 = 32 * d0 + 8 * q + 4 * hi;
                u32x2 w; w.x = pg8::cvt_pk_bf16(o[d0][4 * q], o[d0][4 * q + 1]); w.y = pg8::cvt_pk_bf16(o[d0][4 * q + 2], o[d0][4 * q + 3]);
                if (VAR != 9 || w.x == 0x12345678u) *(u32x2*)(op + dv0) = w; }
    }
}
__device__ __forceinline__ UnitDesc mk_ld(int i) { UnitDesc u; u.diff = 1; u.lat = 1; u.b = i >> 5; u.head = (i >> 3) & 3; u.qb = i & 7; return u; }
__device__ __forceinline__ UnitDesc mk_lg(int i) { UnitDesc u; u.diff = 0; u.lat = 1; u.b = i >> 5; u.head = (i >> 2) & 7; u.qb = i & 3; return u; }
__device__ __forceinline__ UnitDesc mk_cd(int i) { UnitDesc u; u.diff = 1; u.lat = 0; u.b = i >> 3; u.head = (i >> 1) & 3; u.qb = i & 1; return u; }
__device__ __forceinline__ UnitDesc mk_cg(int i) { UnitDesc u; u.diff = 0; u.lat = 0; u.b = i >> 3; u.head = i & 7; u.qb = 0; return u; }
__device__ __forceinline__ bool get_unit(int G, int j, int idx, UnitDesc& u) {
    if (G == 256) {
        if (j < 128) { if (idx == 0) { u = mk_ld(j); return true; } if (idx == 1) { u = mk_cg(2 * j); return true; } if (idx == 2) { u = mk_cg(2 * j + 1); return true; } return false; }
        const int k = j - 128;
        if (idx == 0) { u = mk_lg(k); return true; } if (idx == 1) { u = mk_cd(2 * k); return true; } if (idx == 2) { u = mk_cd(2 * k + 1); return true; }
        return false;
    }
    const int i = j + idx * G; if (i >= 768) return false;
    if (i < 128) u = mk_ld(i); else if (i < 256) u = mk_lg(i - 128); else if (i < 512) u = mk_cd(i - 256); else u = mk_cg(i - 512);
    return true;
}
template <int VAR> __device__ __forceinline__ void attn_phase(LAS unsigned char* lds, int l, const bf16_t* PQ, const unsigned char* ws, bf16_t* O, const float* subln_l) {
    const int G = gridDim.x; const int bx = blockIdx.x;
    const int j = (G % 8 == 0) ? (bx % 8) * (G / 8) + bx / 8 : bx;
    int tid_ = threadIdx.x; asm volatile("" : "+v"(tid_));
    const int lane = tid_ & 63, wid = __builtin_amdgcn_readfirstlane(tid_ >> 6);
    UnitDesc U, Un;
    if (VAR == 7 || VAR == 8 || VAR == 9) {
        for (int idx = 0; get_unit(G, j, idx, U); ++idx) { if ((VAR == 7) != (U.lat != 0)) continue; Strm S1 = mk_strm(U, l, PQ, ws, wid); prologue_dma(lds, S1, lane, wid);
            if (U.diff) attn_unit<true, (VAR == 9 ? 9 : 0)>(lds, U, S1, false, S1, l, ws, O, subln_l); else attn_unit<false, (VAR == 9 ? 9 : 0)>(lds, U, S1, false, S1, l, ws, O, subln_l); AT_WAITBAR(); }
        return; }
    if (!get_unit(G, j, 0, U)) return;
    Strm S = mk_strm(U, l, PQ, ws, wid);
    prologue_dma(lds, S, lane, wid);
    for (int idx = 0;; ++idx) {
        const bool hn = get_unit(G, j, idx + 1, Un);
        Strm Sn = S; if (hn) Sn = mk_strm(Un, l, PQ, ws, wid);
        if (U.diff) attn_unit<true, VAR>(lds, U, S, hn, Sn, l, ws, O, subln_l); else attn_unit<false, VAR>(lds, U, S, hn, Sn, l, ws, O, subln_l);
        if (!hn) break;
        U = Un; S = Sn;
    }
    AT_WAITBAR();
}
#undef AT_WAITBAR
}
#define RLX_AGENT __ATOMIC_RELAXED, __HIP_MEMORY_SCOPE_AGENT
#define XB_TMO      128
#define XB_XCNT(j)  (256  + 64 * (j))
#define XB_XSUB(j)  (1280 + 64 * (j))
#define XB_XGEN(j)  (2304 + 64 * (j))
#define XB_TOP      3328
#define XB_TOPGEN   3392
#define XCD_BAR_WORDS 3456
#define XB_SPIN_CAP (1u << 18)

__device__ __forceinline__ unsigned xb_ld(unsigned* p)              { return __hip_atomic_load(p, __ATOMIC_RELAXED, __HIP_MEMORY_SCOPE_AGENT); }
__device__ __forceinline__ unsigned xb_add(unsigned* p, unsigned v) { return __hip_atomic_fetch_add(p, v, __ATOMIC_RELAXED, __HIP_MEMORY_SCOPE_AGENT); }
__device__ __forceinline__ unsigned xb_xcc_id() { return (unsigned)__builtin_amdgcn_s_getreg((3 << 11) | 20) & 0xFu; }
#define XB_SPIN(cond, bar) do { unsigned _sp = 0; while (cond) { __builtin_amdgcn_s_sleep(1); \
    if ((++_sp & 255u) == 0u) { if (xb_ld(&(bar)[XB_TMO])) break; if (_sp > XB_SPIN_CAP) { atomicAdd(&(bar)[XB_TMO], 1u); break; } } } } while (0)

struct XcdBarrier {
    unsigned* bar; unsigned x;
    volatile LAS unsigned* st;
};

__device__ __forceinline__ XcdBarrier xcd_barrier_post(unsigned* bar, volatile LAS unsigned* st) {
    XcdBarrier b; b.bar = bar; b.x = xb_xcc_id(); b.st = st;
    if (threadIdx.x == 0) (void)xb_add(&bar[XB_XCNT(b.x)], 1u);
    return b;
}
__device__ __forceinline__ void xcd_barrier_complete(unsigned* bar, unsigned x, unsigned& nloc, unsigned& nx) {
    const unsigned G = gridDim.x * gridDim.y * gridDim.z;
    unsigned sum, cnt, mine, sp = 0u;
    for (;;) {
        sum = 0u; cnt = 0u; mine = 0u;
#pragma unroll
        for (unsigned j = 0; j < 16; ++j) { const unsigned c = xb_ld(&bar[XB_XCNT(j)]); sum += c; cnt += (c > 0u) ? 1u : 0u; mine = (j == x) ? c : mine; }
        if (sum == G) break;
        __builtin_amdgcn_s_sleep(1);
        if ((++sp & 255u) == 0u) { if (xb_ld(&bar[XB_TMO])) break; if (sp > XB_SPIN_CAP) { atomicAdd(&bar[XB_TMO], 1u); break; } }
    }
    nloc = mine > 0u ? mine : 1u; nx = cnt > 0u ? cnt : 1u;
}

__device__ __forceinline__ void xcd_barrier(const XcdBarrier& b) {
    asm volatile("s_waitcnt vmcnt(0)" ::: "memory");
    __syncthreads();
    if (threadIdx.x == 0) {
        unsigned* bar = b.bar;
        __builtin_amdgcn_s_waitcnt(0);
        unsigned nloc = b.st[0], nx = b.st[1];
        if (nloc == 0u) { xcd_barrier_complete(bar, b.x, nloc, nx); b.st[0] = nloc; b.st[1] = nx; }
        const unsigned old = xb_add(&bar[XB_XSUB(b.x)], 1u);
        const unsigned gen = old / nloc;
        if (old + 1u == (gen + 1u) * nloc) {
            __builtin_amdgcn_fence(__ATOMIC_RELEASE, "agent");
            asm volatile("s_waitcnt vmcnt(0)" ::: "memory");
            const unsigned og = xb_add(&bar[XB_TOP], 1u);
            const unsigned tg = og / nx;
            if (og + 1u == (tg + 1u) * nx) xb_add(&bar[XB_TOPGEN], 1u);
            else XB_SPIN(xb_ld(&bar[XB_TOPGEN]) == tg, bar);
            __builtin_amdgcn_fence(__ATOMIC_ACQUIRE, "agent");
            xb_add(&bar[XB_XGEN(b.x)], 1u);
            asm volatile("s_waitcnt vmcnt(0)" ::: "memory");
        } else {
            XB_SPIN(xb_ld(&bar[XB_XGEN(b.x)]) == gen, bar);
            __builtin_amdgcn_fence(__ATOMIC_ACQUIRE, "agent");
            asm volatile("s_waitcnt vmcnt(0)" ::: "memory");
        }
    }
    __syncthreads();
}

#ifndef PHMASK
#define PHMASK 127
#endif
#ifndef RES_ALIGN
#define RES_ALIGN true
#endif
#ifndef DOWN1_AP
#define DOWN1_AP 0
#endif
#ifndef SJ_MODE
#define SJ_MODE 1
#endif
__global__ void __launch_bounds__(512, 2) fwd(Args a) {
    extern __shared__ __attribute__((aligned(16))) unsigned char lds_raw[];
    LAS unsigned char* lds = (LAS unsigned char*)lds_raw;
    cg::grid_group grid = cg::this_grid();
    unsigned char* ws = a.ws;
    const int G = gridDim.x;
    volatile LAS unsigned* bst = (volatile LAS unsigned*)(lds + 131072 + 1024);
    if (threadIdx.x < 2) bst[threadIdx.x] = 0u;
    __syncthreads();
    XcdBarrier bar = xcd_barrier_post((unsigned*)(ws + WS_CTL), bst);
    if (a.ph_lo < -5) grid.sync();
#ifdef PROBE_PHASE
    unsigned long long pr_dt = 0ull;
#endif
    for (int ph = a.ph_lo; ph < a.ph_hi; ++ph) {
#ifdef PROBE_PHASE
      const unsigned long long pr_t0 = __builtin_amdgcn_s_memrealtime();
#endif
#ifdef REPEAT_KIND
#ifdef DRY_EPI
#define DRY_REP (rep_ > 0 ? 1 : 0)
#else
#define DRY_REP 0
#endif
      for (int rep_ = 0; rep_ < ((ph >= 2 && (ph - 2) % 5 == REPEAT_KIND) || (REPEAT_KIND >= 10 && ph == REPEAT_KIND - 10) || (REPEAT_KIND <= -100 && ph == -REPEAT_KIND - 100) ? 2 : 1); ++rep_) {
#else
#define DRY_REP 0
      {
#endif
        if (ph == 0) { if (PHMASK & 1) phase0(a, lds); }
        else if (ph == 1) { if (PHMASK & 2) phase1(a, lds); }
        else {
            const int l = (ph - 2) / 5, k = (ph - 2) % 5;
            const unsigned char* wt = ws + WS_WT + (size_t)l * WT_LAYER;
            const float* mod_l = (const float*)(ws + WS_MOD) + (size_t)l * 5 * NMOD;
            if (k == 0) { if (PHMASK & 4) {
                pg8::Gemm g{(const bf16_t*)(ws + WS_AP), (const bf16_t*)(wt + WT_IN), MTOT, INC, D}; pg8::StaticOrder S; S.init(MTOT, INC, G, (int)blockIdx.x);
                EpiIn E{l, (bf16_t*)(ws + WS_PQ), a.out, (const float*)(ws + WS_SSQ1), (const float*)(ws + WS_BIN) + (size_t)l * 5 * INC, (const float*)(ws + WS_ROPE),
                        a.in[12] + l * 64, a.in[13] + l * 64, a.in[19] + l * 64, a.in[20] + l * 64};
                pg8::gemm_phase<EpiIn, pg8::StaticOrder, true, true>(lds, g, S, E);
                side_job(a, lds, l == 0 ? 0 : 3); }
            } else if (k == 1) {
                if (PHMASK & 8) at::attn_phase<0>(lds, l, (const bf16_t*)(ws + WS_PQ), ws, (bf16_t*)(ws + WS_O), a.in[18] + l * 128);
#ifdef ATT_EXTRA
                at::attn_phase<ATT_EXTRA>(lds, l, (const bf16_t*)(ws + WS_PQ), ws, (bf16_t*)(ws + WS_AP), a.in[18] + l * 128);
#endif
            } else if (k == 2) { if (PHMASK & 16) {
                pg8::Gemm g{(const bf16_t*)(ws + WS_O), (const bf16_t*)(wt + WT_OUT), MTOT, D, D}; pg8::StaticOrder S; S.init(MTOT, D, G, (int)blockIdx.x);
                EpiRes E{l == 0 ? a.in[0] : a.out, l == 0 ? a.in[1] - (size_t)MCTX * D : a.out, a.out, mod_l + 2048, (const float*)(ws + WS_GTAB) + (size_t)(l * 2 + 1) * 5 * D, (bf16_t*)(ws + WS_AP), (float*)(ws + WS_SSQ2), l == 0 ? 1 : 0, 0};
                pg8::gemm_phase<EpiRes, pg8::StaticOrder, RES_ALIGN, true>(lds, g, S, E);
                if (l == 0) side_job(a, lds, 1); }
            } else if (k == 3) { if (PHMASK & 32) {
                pg8::Gemm g{(const bf16_t*)(ws + WS_AP), (const bf16_t*)(wt + WT_GU), MTOT, 2 * FH, D}; pg8::StaticOrder S; S.init(MTOT, 2 * FH, G, (int)blockIdx.x);
                EpiGU E{(bf16_t*)(ws + WS_HD), (const float*)(ws + WS_SSQ2), (const float*)(ws + WS_BGU) + (size_t)l * 5 * 2 * FH, DRY_REP};
                pg8::gemm_phase<EpiGU, pg8::StaticOrder, true, true>(lds, g, S, E);
                if (l == 0) side_job(a, lds, 2); }
            } else { if (PHMASK & 64) {
                pg8::Gemm g{(const bf16_t*)(ws + WS_HD), (const bf16_t*)(wt + WT_DN), MTOT, D, FH}; pg8::StaticOrder S; S.init(MTOT, D, G, (int)blockIdx.x);
                EpiRes E{a.out, a.out, a.out, mod_l + 5120, (l == 0 || DOWN1_AP) ? (const float*)(ws + WS_GTAB) + (size_t)(1 * 2 + 0) * 5 * D : nullptr, (bf16_t*)(ws + WS_AP), (float*)(ws + WS_SSQ1), 0, l == 1 ? 1 : 0};
                pg8::gemm_phase<EpiRes, pg8::StaticOrder, RES_ALIGN, true>(lds, g, S, E); }
            }
        }
      }
        if (ph + 1 < a.ph_hi) xcd_barrier(bar);
#ifdef EXTRA_SYNC
        if (ph + 1 < a.ph_hi) xcd_barrier(bar);
#endif
#ifdef PROBE_PHASE
        if (ph == PROBE_PHASE) pr_dt = __builtin_amdgcn_s_memrealtime() - pr_t0;
#endif
    }
#ifdef PROBE_PHASE
    if (blockIdx.x == 0) { const unsigned long long te = __builtin_amdgcn_s_memrealtime(); while (__builtin_amdgcn_s_memrealtime() - te < 4ull * pr_dt) __builtin_amdgcn_s_sleep(4); }
#endif
}
constexpr int N_PHASES = 12;
static int g_grid = 0;
static int fast_grid() {
    if (g_grid == 0) {
        int dev = 0, cus = 0, per_cu = 0;
        if (hipGetDevice(&dev) != hipSuccess || hipDeviceGetAttribute(&cus, hipDeviceAttributeMultiprocessorCount, dev) != hipSuccess) { fprintf(stderr, "device query failed\n"); g_grid = -1; return g_grid; }
        if (hipFuncSetAttribute((const void*)fwd, hipFuncAttributeMaxDynamicSharedMemorySize, LDS_BYTES) != hipSuccess) { fprintf(stderr, "hipFuncSetAttribute failed\n"); g_grid = -1; return g_grid; }
        if (hipOccupancyMaxActiveBlocksPerMultiprocessor(&per_cu, (const void*)fwd, 512, LDS_BYTES) != hipSuccess || per_cu < 1) { fprintf(stderr, "occupancy query: %d blocks per CU\n", per_cu); (void)hipGetLastError(); per_cu = 1; }
        g_grid = cus;
    }
    return g_grid;
}
static Args make_args(void* const* d_in, void* d_out, void* d_ws) { Args a{}; for (int i = 0; i < 25; ++i) a.in[i] = (const float*)d_in[i]; a.out = (float*)d_out; a.ws = (unsigned char*)d_ws; return a; }
static void launch_phases(void* const* d_in, void* d_out, void* d_ws, int lo, int hi, hipStream_t stream) {
    const int grid = fast_grid(); if (grid <= 0) return;
    Args a = make_args(d_in, d_out, d_ws); a.ph_lo = lo; a.ph_hi = hi;
    if ((lo == 0) && hipMemsetAsync((unsigned char*)d_ws + WS_CTL, 0, CTL_BYTES, stream) != hipSuccess) { fprintf(stderr, "memset of the barrier words failed\n"); return; }
    void* args[] = {&a};
    hipError_t e = hipLaunchCooperativeKernel((const void*)fwd, dim3(grid), dim3(512), args, LDS_BYTES, stream);
    if (e != hipSuccess) fprintf(stderr, "cooperative launch failed: %s (grid %d)\n", hipGetErrorString(e), grid);
}
#undef LAS
}
extern "C" void kernel_launch(void* const* d_in, const int* in_sizes, int n_in, void* d_out, int out_size, void* d_ws, size_t ws_size, hipStream_t stream) {
    (void)in_sizes; (void)n_in; (void)out_size; (void)ws_size;
    fx::launch_phases(d_in, d_out, d_ws, 0, fx::N_PHASES, stream);
}
```

```cpp
#include <hip/hip_runtime.h>
#include <hip/hip_cooperative_groups.h>
#include <hip/hip_bf16.h>
#include <cstdio>
#include <cstdint>
#include <cmath>
namespace cg = cooperative_groups;

namespace pg8 {
#define PG8_LAS __attribute__((address_space(3)))
typedef unsigned short bf16_t;
typedef short bf16x8 __attribute__((ext_vector_type(8)));
typedef float f32x4 __attribute__((ext_vector_type(4)));
typedef unsigned u32x4 __attribute__((ext_vector_type(4)));
constexpr int BM = 256, BK = 64, HALF = 128, HTB = HALF * BK * 2  , STAGE_BYTES = 8 * HTB, NXCD = 8, WGM = 6;

__host__ __device__ __forceinline__ int lds_byte(int r, int c) { return (r >> 3) * 1024 + (r & 7) * 128 + (((c >> 3) ^ ((r >> 1) & 7)) * 16) + (c & 7) * 2; }
__host__ __device__ __forceinline__ void stage_rc(int b, int& R, int& C) { const int pc = b / 1024, sb = b % 1024; R = pc * 8 + sb / 128; C = (((sb % 128) / 16) ^ ((R >> 1) & 7)) * 8; }
__host__ __device__ __forceinline__ int perm32(int rho) { const int n = rho >> 4, i = rho & 15; return 8 * (i >> 2) + 4 * n + (i & 3); }

struct Unit { int pm, pn; };
struct Gemm { const bf16_t* A; const bf16_t* Bt; int M, N, K; };

struct StaticOrder {
    int nM, nN, nwg, G, c;
    __host__ __device__ void init(int M, int N, int G_, int c_) { nM = M / BM; nN = N / BM; nwg = nM * nN; G = G_; c = c_; }
    __host__ __device__ bool next(int i, Unit& u) const {
        const long L = (long)i * G + c; if (L >= nwg) return false;
        int wgid = (int)L; { const int q = nwg / NXCD, r = nwg % NXCD, xcd = wgid % NXCD, off = wgid / NXCD; wgid = (xcd < r ? xcd * (q + 1) : r * (q + 1) + (xcd - r) * q) + off; }
        const int nig = WGM * nN, gid = wgid / nig, fm = gid * WGM, gsz = (nM - fm) < WGM ? (nM - fm) : WGM;
        u.pm = fm + ((wgid % nig) % gsz); u.pn = (wgid % nig) / gsz; return true;
    }
    __device__ __forceinline__ void a_ready(const Unit&) const {}
    __device__ __forceinline__ void done(const Unit&) const {}
};

typedef float cv_f32x2 __attribute__((ext_vector_type(2))); typedef __bf16 cv_bf16x2 __attribute__((ext_vector_type(2)));
__device__ __forceinline__ unsigned cvt_pk_bf16(float lo, float hi) { const cv_f32x2 v = {lo, hi}; const cv_bf16x2 b = __builtin_convertvector(v, cv_bf16x2); return __builtin_bit_cast(unsigned, b); }
template <class Epi, class Sched, bool ALIGN_EPI = false, bool SP2 = false, bool KDEP = false>
__device__ __forceinline__ void gemm_phase(PG8_LAS unsigned char* lds, const Gemm g, const Sched& S, const Epi& E) {
    int tid_ = threadIdx.x; asm volatile("" : "+v"(tid_));
    const int tid = tid_, wid = __builtin_amdgcn_readfirstlane(tid >> 6), lane = tid & 63, wr = wid >> 2, wc = wid & 3, fr = lane & 15, fq = lane >> 4;
    const int K = g.K, nt = K / BK;
    unsigned voffA[2], voffB[2];
#pragma unroll
    for (int i = 0; i < 2; ++i) { int R, C; stage_rc(tid * 16 + i * 8192, R, C); const int Rb = Epi::PERM ? ((R & ~31) + perm32(R & 31)) : R;
        voffA[i] = (unsigned)(R * K + C) * 2u; voffB[i] = (unsigned)(Rb * K + C) * 2u; }
    const size_t kstep = (size_t)(BK * 2);
    const size_t hstep = (size_t)HALF * K * 2;
    const size_t tstep = 2 * hstep;
    const unsigned ldsw = (unsigned)wid * 1024u;
    const int aoff = lds_byte(wr * 64 + fr, fq * 8), boff = lds_byte(wc * 32 + fr, fq * 8);
    const int aoff1 = lds_byte(wr * 64 + fr, 32 + fq * 8), boff1 = lds_byte(wc * 32 + fr, 32 + fq * 8);
#define PG8_SA(b, h) (((b) * 2 + (h)) * HTB)
#define PG8_SB(b, h) ((4 + (b) * 2 + (h)) * HTB)
#define PG8_STAGE(bufoff, gbase, voff) do { _Pragma("unroll") for (int _i = 0; _i < 2; ++_i) \
        __builtin_amdgcn_global_load_lds((const unsigned*)((const char*)(gbase) + (voff)[_i]), (PG8_LAS unsigned*)(lds + (bufoff) + ldsw + _i * 8192), 16, 0, 0); } while (0)
#define PG8_LDA(dst, b, h) do { _Pragma("unroll") for (int m = 0; m < 4; ++m) _Pragma("unroll") for (int k = 0; k < 2; ++k) dst[m][k] = *(const PG8_LAS bf16x8*)(lds + PG8_SA(b, h) + (k ? aoff1 : aoff) + m * 2048); } while (0)
#define PG8_LDB(dst, b, h) do { _Pragma("unroll") for (int n = 0; n < 2; ++n) _Pragma("unroll") for (int k = 0; k < 2; ++k) dst[n][k] = *(const PG8_LAS bf16x8*)(lds + PG8_SB(b, h) + (k ? boff1 : boff) + n * 2048); } while (0)
#define PG8_MMA(ai, bj, At, Bt) do { __builtin_amdgcn_s_setprio(1); _Pragma("unroll") for (int m = 0; m < 4; ++m) _Pragma("unroll") for (int n = 0; n < 2; ++n) _Pragma("unroll") for (int k = 0; k < 2; ++k) \
        acc[ai][bj][m][n] = __builtin_amdgcn_mfma_f32_16x16x32_bf16(Bt[n][k], At[m][k], acc[ai][bj][m][n], 0, 0, 0); __builtin_amdgcn_s_setprio(0); } while (0)
#define PG8_WAIT_V(n) asm volatile("s_waitcnt vmcnt(" #n ")" ::: "memory")
#define PG8_WAIT_L(n) asm volatile("s_waitcnt lgkmcnt(" #n ")" ::: "memory")
#define PG8_BAR __builtin_amdgcn_s_barrier()
#define PG8_SCHED __builtin_amdgcn_sched_barrier(0)
    Unit cur, nxt; int ui = 0;
    if (!S.next(0, cur)) return;
    f32x4 acc[2][2][4][2];
#pragma unroll
    for (int a = 0; a < 2; ++a)
#pragma unroll
        for (int b = 0; b < 2; ++b)
#pragma unroll
            for (int m = 0; m < 4; ++m)
#pragma unroll
                for (int n = 0; n < 2; ++n) acc[a][b][m][n] = (f32x4){0.f, 0.f, 0.f, 0.f};
    bf16x8 At[4][2], B0[2][2], B1[2][2];
    const char* cA = (const char*)g.A + (size_t)cur.pm * tstep; const char* cB = (const char*)g.Bt + (size_t)cur.pn * tstep;
    S.a_ready(cur);
    if constexpr (SP2) {
        PG8_STAGE(PG8_SB(0, 0), cB, voffB); PG8_STAGE(PG8_SB(0, 1), cB + hstep, voffB); PG8_STAGE(PG8_SA(0, 0), cA, voffA); PG8_STAGE(PG8_SA(0, 1), cA + hstep, voffA);
        if (wr == 1) PG8_BAR;
        PG8_WAIT_V(2); PG8_BAR;
        PG8_STAGE(PG8_SB(1, 0), cB + kstep, voffB); PG8_STAGE(PG8_SA(1, 0), cA + kstep, voffA); PG8_STAGE(PG8_SB(1, 1), cB + hstep + kstep, voffB);
        PG8_WAIT_V(6); PG8_BAR;
    } else {
        PG8_STAGE(PG8_SB(0, 0), cB, voffB); PG8_STAGE(PG8_SA(0, 0), cA, voffA); PG8_STAGE(PG8_SB(0, 1), cB + hstep, voffB); PG8_STAGE(PG8_SA(0, 1), cA + hstep, voffA);
        if (wr == 1) PG8_BAR;
        PG8_WAIT_V(4); PG8_BAR;
        PG8_STAGE(PG8_SB(1, 0), cB + kstep, voffB); PG8_STAGE(PG8_SA(1, 0), cA + kstep, voffA); PG8_STAGE(PG8_SB(1, 1), cB + hstep + kstep, voffB);
        PG8_WAIT_V(6); PG8_BAR;
    }
    for (;;) {
        const bool has_next = S.next(ui + 1, nxt);
        const char* nA = has_next ? (const char*)g.A + (size_t)nxt.pm * tstep : cA; const char* nB = has_next ? (const char*)g.Bt + (size_t)nxt.pn * tstep : cB;
        for (int t = 0; t < nt; t += 2) {
            const bool last = (t == nt - 2);
            const char* a1 = cA + (size_t)(t + 1) * kstep;
            const char* a2 = last ? nA : cA + (size_t)(t + 2) * kstep; const char* b2 = last ? nB : cB + (size_t)(t + 2) * kstep;
            const char* a3 = a2 + kstep; const char* b3 = b2 + kstep;
            if (last && has_next) S.a_ready(nxt);
            if constexpr (KDEP) { if (t == nt - 4) S.k_ready(cur); }
            if constexpr (SP2) {
            PG8_LDB(B0, 0, 0); PG8_LDB(B1, 0, 1); PG8_SCHED; PG8_LDA(At, 0, 0); PG8_STAGE(PG8_SA(1, 1), a1 + hstep, voffA);
            PG8_WAIT_V(8); PG8_WAIT_L(0); PG8_BAR; PG8_MMA(0, 0, At, B0); PG8_MMA(0, 1, At, B1); PG8_BAR; PG8_SCHED;
            PG8_LDA(At, 0, 1); PG8_STAGE(PG8_SB(0, 0), b2, voffB); PG8_STAGE(PG8_SB(0, 1), b2 + hstep, voffB); PG8_STAGE(PG8_SA(0, 0), a2, voffA);
            PG8_WAIT_V(8); PG8_WAIT_L(0); PG8_BAR; PG8_MMA(1, 0, At, B0); PG8_MMA(1, 1, At, B1); PG8_BAR; PG8_SCHED;
            PG8_LDB(B0, 1, 0); PG8_LDB(B1, 1, 1); PG8_SCHED; PG8_LDA(At, 1, 0); PG8_STAGE(PG8_SA(0, 1), a2 + hstep, voffA);
            PG8_WAIT_V(8); PG8_WAIT_L(0); PG8_BAR; PG8_MMA(0, 0, At, B0); PG8_MMA(0, 1, At, B1); PG8_BAR; PG8_SCHED;
            PG8_LDA(At, 1, 1); PG8_STAGE(PG8_SB(1, 0), b3, voffB); PG8_STAGE(PG8_SB(1, 1), b3 + hstep, voffB); PG8_STAGE(PG8_SA(1, 0), a3, voffA);
            PG8_WAIT_V(8); PG8_WAIT_L(0); PG8_BAR; PG8_MMA(1, 0, At, B0); PG8_MMA(1, 1, At, B1); PG8_BAR; PG8_SCHED;
            } else {
            PG8_LDB(B0, 0, 0); PG8_SCHED; PG8_LDA(At, 0, 0); PG8_STAGE(PG8_SA(1, 1), a1 + hstep, voffA);
            PG8_WAIT_L(8); PG8_BAR; PG8_WAIT_L(0); PG8_MMA(0, 0, At, B0); PG8_BAR; PG8_SCHED;
            PG8_LDB(B1, 0, 1); PG8_STAGE(PG8_SB(0, 0), b2, voffB);
            PG8_BAR; PG8_WAIT_L(0); PG8_MMA(0, 1, At, B1); PG8_BAR;
            PG8_LDA(At, 0, 1); PG8_STAGE(PG8_SA(0, 0), a2, voffA);
            PG8_BAR; PG8_WAIT_L(0); PG8_MMA(1, 0, At, B0); PG8_BAR; PG8_SCHED;
            PG8_STAGE(PG8_SB(0, 1), b2 + hstep, voffB);
            PG8_WAIT_V(6); PG8_BAR; PG8_MMA(1, 1, At, B1); PG8_BAR;
            PG8_LDB(B0, 1, 0); PG8_SCHED; PG8_LDA(At, 1, 0); PG8_STAGE(PG8_SA(0, 1), a2 + hstep, voffA);
            PG8_WAIT_L(8); PG8_BAR; PG8_WAIT_L(0); PG8_MMA(0, 0, At, B0); PG8_BAR; PG8_SCHED;
            PG8_LDB(B1, 1, 1); PG8_STAGE(PG8_SB(1, 0), b3, voffB);
            PG8_BAR; PG8_WAIT_L(0); PG8_MMA(0, 1, At, B1); PG8_BAR;
            PG8_LDA(At, 1, 1); PG8_STAGE(PG8_SA(1, 0), a3, voffA);
            PG8_BAR; PG8_WAIT_L(0); PG8_MMA(1, 0, At, B0); PG8_BAR; PG8_SCHED;
            PG8_STAGE(PG8_SB(1, 1), b3 + hstep, voffB);
            PG8_WAIT_V(6); PG8_BAR; PG8_MMA(1, 1, At, B1); PG8_BAR;
            }
        }
        if constexpr (ALIGN_EPI) { if (wr == 0) PG8_BAR; }
        if constexpr (!Epi::AFTER_DRAIN) { E(acc, cur, wr, wc, fr, fq); S.done(cur); }
        if (!has_next) break;
#pragma unroll
        for (int a = 0; a < 2; ++a)
#pragma unroll
            for (int b = 0; b < 2; ++b)
#pragma unroll
                for (int m = 0; m < 4; ++m)
#pragma unroll
                    for (int n = 0; n < 2; ++n) acc[a][b][m][n] = (f32x4){0.f, 0.f, 0.f, 0.f};
        cur = nxt; cA = nA; cB = nB; ++ui;
        if constexpr (ALIGN_EPI) { if (wr == 1) PG8_BAR; }
    }
    PG8_WAIT_V(0);
    if constexpr (!ALIGN_EPI) { if (wr == 0) PG8_BAR; }
    PG8_BAR;
    if constexpr (Epi::AFTER_DRAIN) { E.fused(acc, cur, wr, wc, fr, fq, lds, wid, lane); S.done(cur); }
#undef PG8_SA
#undef PG8_SB
#undef PG8_STAGE
#undef PG8_LDA
#undef PG8_LDB
#undef PG8_MMA
#undef PG8_WAIT_V
#undef PG8_WAIT_L
#undef PG8_BAR
#undef PG8_SCHED
}
}
namespace fx {
using pg8::bf16_t; using pg8::bf16x8; using pg8::f32x4; using pg8::u32x4;
#define LAS __attribute__((address_space(3)))
typedef float f32x16 __attribute__((ext_vector_type(16)));
typedef unsigned u32x2 __attribute__((ext_vector_type(2)));
typedef short v4i16_t __attribute__((ext_vector_type(4)));
constexpr int D = 1024, INC = 2304, FH = 2816, NMOD = 6144, MTOT = 12288, MCTX = 8192;
constexpr float EPS = 1e-6f;
constexpr float LOG2E = 1.4426950408889634f;
constexpr float C2 = 0.125f * LOG2E;
constexpr size_t MiB = 1u << 20;
constexpr size_t WS_MOD = 0;
constexpr size_t WS_LAM = 256 * 1024;
constexpr size_t WS_GTAB = 320 * 1024;
constexpr size_t WS_BIN = 512 * 1024;
constexpr size_t WS_BGU = 768 * 1024;
constexpr size_t WS_ROPE = 1 * MiB;
constexpr size_t WS_SSQ1 = 2 * MiB;
constexpr size_t WS_SSQ2 = 3 * MiB;
constexpr size_t WS_CTL = 3840 * 1024, CTL_BYTES = 32768;
constexpr int CW_RDY = 4096;
constexpr size_t WS_WT = 4 * MiB;
constexpr size_t WT_IN = 0, WT_OUT = 4718592, WT_GU = WT_OUT + 2097152, WT_DN = WT_GU + 11534336, WT_LAYER = WT_DN + 5767168;
static_assert(WT_LAYER == 23 * MiB, "weight copies per layer");
constexpr size_t WS_CACHE = WS_WT + 2 * WT_LAYER;
constexpr size_t WS_CDK = WS_CACHE, WS_CDV = WS_CACHE + 4 * MiB, WS_CGK = WS_CACHE + 8 * MiB, WS_CGV = WS_CACHE + 9 * MiB;
constexpr size_t WS_AP = WS_CACHE + 10 * MiB;
constexpr size_t WS_PQ = WS_AP + 24 * MiB;
constexpr size_t WS_O = WS_PQ + 54 * MiB;
constexpr size_t WS_HD = WS_PQ;
constexpr size_t WS_XB = WS_O + 24 * MiB;
constexpr size_t WS_FAST_END = WS_XB + 24 * MiB;
constexpr size_t O_Y = 0, O_DK = (size_t)12288 * 1024, O_DV = O_DK + (size_t)8192 * 2 * 512, O_GK = O_DV + (size_t)8192 * 2 * 512, O_GV = O_GK + (size_t)8192 * 2 * 128;
constexpr int LDS_BYTES = 147456;

__device__ __forceinline__ unsigned f2bf(float f) { unsigned u = __builtin_bit_cast(unsigned, f); return (u + 0x7fffu + ((u >> 16) & 1u)) >> 16; }
__device__ __forceinline__ unsigned pk2(float lo, float hi) { return f2bf(lo) | (f2bf(hi) << 16); }
__device__ __forceinline__ float wave_sum(float v) {
#pragma unroll
    for (int o = 1; o < 64; o <<= 1) v += __shfl_xor(v, o);
    return v;
}
__host__ __device__ __forceinline__ int col_slot(int kind, int col) {
    int pn, bj, wc, j;
    if (kind == 0) { pn = col >> 8; const int c = col & 255; wc = c >> 6; bj = (c >> 5) & 1; j = c & 31; }
    else if (kind == 1) { pn = col >> 8; const int c = col & 255; bj = c >> 7; wc = (c >> 5) & 3; j = c & 31; }
    else { bj = col >= FH ? 1 : 0; const int cc = col - FH * bj; pn = cc >> 7; wc = (cc >> 5) & 3; j = cc & 31; }
    const int fq = j >> 3, n = (j >> 2) & 1, i = j & 3;
    return 256 * pn + 128 * bj + 32 * wc + 16 * n + 4 * fq + i;
}
__host__ __device__ __forceinline__ int slot_col(int kind, int s) {
    const int pn = s >> 8, t = s & 255, bj = t >> 7, wc = (t >> 5) & 3, n = (t >> 4) & 1, fq = (t >> 2) & 3, i = t & 3;
    if (kind == 0) return 256 * pn + 64 * wc + 32 * bj + 8 * fq + 4 * n + i;
    if (kind == 1) return 256 * pn + 128 * bj + 32 * wc + 8 * fq + 4 * n + i;
    return FH * bj + 128 * pn + 32 * wc + 8 * fq + 4 * n + i;
}

struct Args { const float* in[25]; float* out; unsigned char* ws; int ph_lo, ph_hi; };

__device__ __forceinline__ void p0_transpose_pair(const float* W, int K, int N, bf16_t* WT, int kind, LAS float* scr, int itemA, int itemB, bool hasB, int lane) {
    const int nblk = N / 32;
    const int k0a = 64 * (itemA / nblk), n0a = 32 * (itemA % nblk), k0b = 64 * (itemB / nblk), n0b = 32 * (itemB % nblk);
    float va[32], vb[32];
#pragma unroll
    for (int i = 0; i < 32; ++i) va[i] = __builtin_nontemporal_load(W + (size_t)(k0a + 2 * i + (lane >> 5)) * N + n0a + (lane & 31));
    if (hasB) {
#pragma unroll
        for (int i = 0; i < 32; ++i) vb[i] = __builtin_nontemporal_load(W + (size_t)(k0b + 2 * i + (lane >> 5)) * N + n0b + (lane & 31));
    }
    const int c = lane & 7;
#pragma unroll
    for (int i = 0; i < 32; ++i) scr[(2 * i + (lane >> 5)) * 33 + (lane & 31)] = va[i];
    asm volatile("s_waitcnt lgkmcnt(0)" ::: "memory");
#pragma unroll
    for (int j = 0; j < 4; ++j) { const int n = (lane >> 3) + 8 * j; const LAS float* s = scr + (8 * c) * 33 + n;
        u32x4 o; o.x = pk2(s[0 * 33], s[1 * 33]); o.y = pk2(s[2 * 33], s[3 * 33]); o.z = pk2(s[4 * 33], s[5 * 33]); o.w = pk2(s[6 * 33], s[7 * 33]);
        __builtin_nontemporal_store(o, (u32x4*)(WT + (size_t)col_slot(kind, n0a + n) * K + k0a + 8 * c)); }
    asm volatile("s_waitcnt lgkmcnt(0)" ::: "memory");
    if (hasB) {
#pragma unroll
        for (int i = 0; i < 32; ++i) scr[(2 * i + (lane >> 5)) * 33 + (lane & 31)] = vb[i];
        asm volatile("s_waitcnt lgkmcnt(0)" ::: "memory");
#pragma unroll
        for (int j = 0; j < 4; ++j) { const int n = (lane >> 3) + 8 * j; const LAS float* s = scr + (8 * c) * 33 + n;
            u32x4 o; o.x = pk2(s[0 * 33], s[1 * 33]); o.y = pk2(s[2 * 33], s[3 * 33]); o.z = pk2(s[4 * 33], s[5 * 33]); o.w = pk2(s[6 * 33], s[7 * 33]);
            __builtin_nontemporal_store(o, (u32x4*)(WT + (size_t)col_slot(kind, n0b + n) * K + k0b + 8 * c)); }
        asm volatile("s_waitcnt lgkmcnt(0)" ::: "memory");
    }
}
__device__ __forceinline__ void cache_item(const Args& a, int item, int lane) {
    unsigned char* ws = a.ws; const float* src; bf16_t* dst; int j = item;
    if (j < 512) { src = a.in[2]; dst = (bf16_t*)(ws + WS_CDK); } else if (j < 1024) { j -= 512; src = a.in[3]; dst = (bf16_t*)(ws + WS_CDV); }
    else if (j < 1152) { j -= 1024; src = a.in[4]; dst = (bf16_t*)(ws + WS_CGK); } else { j -= 1152; src = a.in[5]; dst = (bf16_t*)(ws + WS_CGV); }
#pragma unroll
    for (int i = 0; i < 8; ++i) { const size_t e = (size_t)j * 4096 + (size_t)i * 512 + lane * 8;
        const f32x4 v0 = __builtin_nontemporal_load((const f32x4*)(src + e)), v1 = __builtin_nontemporal_load((const f32x4*)(src + e + 4));
        u32x4 o; o.x = pk2(v0[0], v0[1]); o.y = pk2(v0[2], v0[3]); o.z = pk2(v1[0], v1[1]); o.w = pk2(v1[2], v1[3]);
        *(u32x4*)(dst + e) = o; }
}
__device__ __forceinline__ void conv_mat(const Args& a, LAS float* scr, int mat, int l, int gw, int NGW, int lane) {
    unsigned char* wt = a.ws + WS_WT + (size_t)l * WT_LAYER;
    const float* W; int K, N, kind, NI; bf16_t* WT;
    if (mat == 0)      { W = a.in[11] + (size_t)l * D * INC;    K = D;  N = INC;    kind = 0; NI = 16 * 72;  WT = (bf16_t*)(wt + WT_IN); }
    else if (mat == 1) { W = a.in[21] + (size_t)l * D * D;      K = D;  N = D;      kind = 1; NI = 16 * 32;  WT = (bf16_t*)(wt + WT_OUT); }
    else if (mat == 2) { W = a.in[23] + (size_t)l * D * 2 * FH; K = D;  N = 2 * FH; kind = 2; NI = 16 * 176; WT = (bf16_t*)(wt + WT_GU); }
    else               { W = a.in[24] + (size_t)l * FH * D;     K = FH; N = D;      kind = 1; NI = 44 * 32;  WT = (bf16_t*)(wt + WT_DN); }
    for (int it = gw; it < NI; it += 2 * NGW) { const int itB = it + NGW; const bool hasB = itB < NI; p0_transpose_pair(W, K, N, WT, kind, scr, it, hasB ? itB : it, hasB, lane); }
}
__device__ __forceinline__ void phase0(const Args& a, LAS unsigned char* lds) {
    int tid_ = threadIdx.x; asm volatile("" : "+v"(tid_));
    const int tid = tid_, lane = tid & 63, wid = __builtin_amdgcn_readfirstlane(tid >> 6);
    const int G = gridDim.x, bx = blockIdx.x;
    unsigned char* ws = a.ws;
    for (int u = bx; u < 192; u += G) {
        LAS float* s = (LAS float*)lds;
        LAS float* red = (LAS float*)(lds + 20480);
        for (int i = tid; i < 5 * 1024; i += 512) { const int c = i >> 10, k = i & 1023; const float x = c < 4 ? a.in[6][c * 1024 + k] : a.in[7][k]; s[i] = x / (1.f + __expf(-x)); }
        __syncthreads();
        const int l = u / 96, n0 = (u % 96) * 64;
        const float* w = a.in[8] + (size_t)l * 1024 * NMOD + (size_t)(wid * 128) * NMOD + n0 + lane;
        float a0 = 0.f, a1 = 0.f, a2 = 0.f, a3 = 0.f, a4 = 0.f;
#pragma unroll 64
        for (int k = 0; k < 128; ++k) { const float wv = __builtin_nontemporal_load(w + (size_t)k * NMOD); const int kk = wid * 128 + k;
            a0 += s[kk] * wv; a1 += s[1024 + kk] * wv; a2 += s[2048 + kk] * wv; a3 += s[3072 + kk] * wv; a4 += s[4096 + kk] * wv; }
        red[(wid * 5 + 0) * 64 + lane] = a0; red[(wid * 5 + 1) * 64 + lane] = a1; red[(wid * 5 + 2) * 64 + lane] = a2; red[(wid * 5 + 3) * 64 + lane] = a3; red[(wid * 5 + 4) * 64 + lane] = a4;
        __syncthreads();
        if (tid < 320) { const int c = tid >> 6; float sum = 0.f;
#pragma unroll
            for (int ww = 0; ww < 8; ++ww) sum += red[(ww * 5 + c) * 64 + lane];
            ((float*)(ws + WS_MOD))[(size_t)(l * 5 + c) * NMOD + n0 + lane] = sum + a.in[9][l * NMOD + n0 + lane]; }
        __syncthreads();
    }
    if (bx == G - 1 && wid < 2) {
        const int ll = wid;
        const float s1 = wave_sum(a.in[14][ll * 64 + lane] * a.in[15][ll * 64 + lane]), s2 = wave_sum(a.in[16][ll * 64 + lane] * a.in[17][ll * 64 + lane]);
        const float li = 0.8f - 0.6f * expf(-0.3f * (float)ll);
        if (lane == 0) { float* lm = (float*)(ws + WS_LAM); lm[ll] = expf(s1) - expf(s2) + li; lm[2 + ll] = li; }
    }
    {
        LAS float* scr = (LAS float*)(lds + 32768 + wid * 8704);
        const int first = (G == 256) ? 192 : 0;
        if (bx >= first) { const int gw = (bx - first) * 8 + wid, NGW = (G - first) * 8;
        conv_mat(a, scr, 0, 0, gw, NGW, lane); conv_mat(a, scr, 1, 0, gw, NGW, lane);
        for (int it = gw; it < 1280; it += NGW) cache_item(a, it, lane); }
    }
    {
        const size_t gt = (size_t)bx * 512 + tid, GT = (size_t)G * 512;
        float* rope = (float*)(ws + WS_ROPE);
        for (size_t i = gt; i < 32768; i += GT) { const int t = (int)(i >> 5), ii = (int)(i & 31);
            const float pos = (ii < 16) ? (float)(t >> 6) : (float)(t & 63);
            const float freq = powf(10000.0f, -(float)(2 * (ii & 15)) / 32.0f);
            const float ang = pos * freq; rope[i] = cosf(ang); rope[32768 + i] = sinf(ang); }
    }
}
__device__ __forceinline__ void bias_rows(const Args& a, LAS float* red, int l, int isgu, int gw, int NGW, int lane) {
    unsigned char* ws = a.ws; const float* mod = (const float*)(ws + WS_MOD);
    const int nrows = isgu ? 2 * FH : INC, kind = isgu ? 2 : 0;
    const bf16_t* wt = (const bf16_t*)(ws + WS_WT + (size_t)l * WT_LAYER + (isgu ? WT_GU : WT_IN));
    float* bias = (float*)(ws + (isgu ? WS_BGU : WS_BIN)) + (size_t)l * 5 * nrows;
    float sh[5][16];
#pragma unroll
    for (int c = 0; c < 5; ++c) { const float* sp = mod + (size_t)(l * 5 + c) * NMOD + (isgu ? 3072 : 0);
#pragma unroll
        for (int h = 0; h < 2; ++h) { const f32x4 v0 = *(const f32x4*)(sp + h * 512 + lane * 8), v1 = *(const f32x4*)(sp + h * 512 + lane * 8 + 4);
            sh[c][h * 8 + 0] = v0[0]; sh[c][h * 8 + 1] = v0[1]; sh[c][h * 8 + 2] = v0[2]; sh[c][h * 8 + 3] = v0[3]; sh[c][h * 8 + 4] = v1[0]; sh[c][h * 8 + 5] = v1[1]; sh[c][h * 8 + 6] = v1[2]; sh[c][h * 8 + 7] = v1[3]; } }
    for (int s0 = gw * 8; s0 < nrows; s0 += NGW * 8) {
        u32x4 w0[8], w1[8];
#pragma unroll
        for (int j = 0; j < 8; ++j) { w0[j] = *(const u32x4*)(wt + (size_t)(s0 + j) * D + lane * 8); w1[j] = *(const u32x4*)(wt + (size_t)(s0 + j) * D + 512 + lane * 8); }
#pragma unroll
        for (int j = 0; j < 8; ++j) {
            float wv[16];
#pragma unroll
            for (int q = 0; q < 4; ++q) { wv[2 * q] = __uint_as_float(w0[j][q] << 16); wv[2 * q + 1] = __uint_as_float(w0[j][q] & 0xffff0000u); wv[8 + 2 * q] = __uint_as_float(w1[j][q] << 16); wv[8 + 2 * q + 1] = __uint_as_float(w1[j][q] & 0xffff0000u); }
#pragma unroll
            for (int c = 0; c < 5; ++c) { float d = 0.f;
#pragma unroll
                for (int e = 0; e < 16; ++e) d += sh[c][e] * wv[e];
                red[(j * 5 + c) * 64 + lane] = d; }
        }
        asm volatile("s_waitcnt lgkmcnt(0)" ::: "memory");
        if (lane < 40) {
            const LAS f32x4* rp = (const LAS f32x4*)(red + lane * 64); f32x4 acc = rp[0];
#pragma unroll
            for (int q = 1; q < 16; ++q) acc += rp[q];
            const float d = (acc[0] + acc[1]) + (acc[2] + acc[3]);
            const int j = lane / 5, c = lane - 5 * j;
            bias[(size_t)c * nrows + slot_col(kind, s0 + j)] = d;
        }
        asm volatile("s_waitcnt lgkmcnt(0)" ::: "memory");
    }
}
__device__ __forceinline__ void phase1(const Args& a, LAS unsigned char* lds) {
    int tid_ = threadIdx.x; asm volatile("" : "+v"(tid_));
    const int tid = tid_, lane = tid & 63, wid = __builtin_amdgcn_readfirstlane(tid >> 6);
    const int G = gridDim.x, bx = blockIdx.x;
    unsigned char* ws = a.ws;
    const float* mod = (const float*)(ws + WS_MOD);
    const size_t gt = (size_t)bx * 512 + tid, GT = (size_t)G * 512;
    { float* gt_ = (float*)(ws + WS_GTAB);
      for (size_t i = gt; i < 2 * 2 * 5 * 1024; i += GT) { const int k = (int)(i & 1023), c = (int)((i >> 10) % 5), w = (int)((i / 5120) & 1), l = (int)(i / 10240);
          const float nw = w == 0 ? a.in[10][l * D + k] : a.in[22][l * D + k];
          gt_[i] = nw * (1.f + mod[(size_t)(l * 5 + c) * NMOD + (w == 0 ? 1024 : 4096) + k]); } }
    const int gw = bx * 8 + wid, NGW = G * 8;
    bias_rows(a, (LAS float*)(lds + wid * 10240), 0, 0, gw, NGW, lane);
    { bf16_t* AP = (bf16_t*)(ws + WS_AP); float* ssq = (float*)(ws + WS_SSQ1);
      for (int m = gw; m < MTOT; m += NGW) {
          const float* xr = m < MCTX ? a.in[0] + (size_t)m * D : a.in[1] + (size_t)(m - MCTX) * D;
          const int c = m < MCTX ? 4 : (m - MCTX) >> 10;
          const float* sc = mod + (size_t)(0 * 5 + c) * NMOD + 1024; const float* nw = a.in[10];
          float ss = 0.f;
#pragma unroll
          for (int h = 0; h < 2; ++h) { const int k = h * 512 + lane * 8;
              const f32x4 x0 = *(const f32x4*)(xr + k), x1 = *(const f32x4*)(xr + k + 4), s0 = *(const f32x4*)(sc + k), s1 = *(const f32x4*)(sc + k + 4), n0 = *(const f32x4*)(nw + k), n1 = *(const f32x4*)(nw + k + 4);
              ss += (x0[0] * x0[0] + x0[1] * x0[1]) + (x0[2] * x0[2] + x0[3] * x0[3]) + (x1[0] * x1[0] + x1[1] * x1[1]) + (x1[2] * x1[2] + x1[3] * x1[3]);
              const f32x4 y0 = x0 * (n0 * (s0 + 1.f)), y1 = x1 * (n1 * (s1 + 1.f));
              u32x4 o; o.x = pk2(y0[0], y0[1]); o.y = pk2(y0[2], y0[3]); o.z = pk2(y1[0], y1[1]); o.w = pk2(y1[2], y1[3]);
              *(u32x4*)(AP + (size_t)m * D + k) = o; }
          ss = wave_sum(ss);
          if (lane < 16) ssq[(size_t)m * 16 + lane] = lane == 0 ? ss : 0.f;
      } }
}
struct InOrder {
    int G, c; pg8::StaticOrder S0;
    __device__ void init(int M, int N, int G_, int c_) { G = G_; c = c_; S0.init(M, N, G_, c_); }
    __device__ bool next(int i, pg8::Unit& u) const {
        if (G != 256) return S0.next(i, u);
        const int x = c & 7, idx = (c >> 3) + 32 * i;
#ifdef IN_LATENT_FIRST
        if (x < 4) { if (idx >= 48) return false;
            if (idx >= 24) { const int k = idx - 24; u.pm = 8 * x + (k & 7); u.pn = 6 + (k >> 3); } else { const int k = idx; u.pm = 32 + 4 * x + (k & 3); u.pn = k >> 2; } }
        else { const int b = x - 4; if (idx >= 60) return false;
            if (idx >= 12) { const int k = idx - 12; u.pm = 8 * b + (k & 7); u.pn = k >> 3; } else { const int k = idx; u.pm = 32 + 4 * b + (k & 3); u.pn = 6 + (k >> 2); } }
#else
        if (x < 4) { if (idx >= 48) return false;
            if (idx < 24) { u.pm = 8 * x + (idx & 7); u.pn = 6 + (idx >> 3); } else { const int k = idx - 24; u.pm = 32 + 4 * x + (k & 3); u.pn = k >> 2; } }
        else { const int b = x - 4; if (idx >= 60) return false;
            if (idx < 48) { u.pm = 8 * b + (idx & 7); u.pn = idx >> 3; } else { const int k = idx - 48; u.pm = 32 + 4 * b + (k & 3); u.pn = 6 + (k >> 2); } }
#endif
        return true;
    }
    __device__ __forceinline__ void a_ready(const pg8::Unit&) const {}
    __device__ __forceinline__ void done(const pg8::Unit&) const {}
};
__device__ __forceinline__ int slot_panel(int s) { const int x = s / 6, k = s - 6 * x, p = x & 3, hi = x >> 2; return k < 4 ? 8 * p + 4 * hi + k : 32 + 4 * p + 2 * hi + (k - 4); }
struct PairOrder : pg8::StaticOrder {
    __device__ bool next(int i, pg8::Unit& u) const { if (!pg8::StaticOrder::next(i, u)) return false; u.pm = slot_panel(u.pm); return true; }
};
struct LateOrder {
    int pm; unsigned* ready; bool active;
    __device__ bool next(int i, pg8::Unit& u) const { if (!active || i > 0) return false; u.pm = pm; u.pn = 21; return true; }
    __device__ __forceinline__ void a_ready(const pg8::Unit&) const {}
    __device__ __forceinline__ void done(const pg8::Unit&) const {}
    __device__ __forceinline__ void publish() const {
        if (active && threadIdx.x == 0) {
            __builtin_amdgcn_fence(__ATOMIC_RELEASE, "agent");
            asm volatile("s_waitcnt vmcnt(0)" ::: "memory");
            __hip_atomic_fetch_add(ready + 16 * pm, 8u, __ATOMIC_RELAXED, __HIP_MEMORY_SCOPE_AGENT);
        }
    }
};
struct DownOrder : PairOrder {
    unsigned* ready; bool dep;
    __device__ __forceinline__ void k_ready(const pg8::Unit& u) const {
        if (!dep) return;
        if (threadIdx.x < 64) {
            unsigned spins = 0;
            while ((unsigned)__builtin_amdgcn_readfirstlane(__hip_atomic_load(ready + 16 * u.pm, __ATOMIC_RELAXED, __HIP_MEMORY_SCOPE_AGENT)) < 8u) { __builtin_amdgcn_s_sleep(2); if (++spins > (1u << 20)) break; }
            __builtin_amdgcn_fence(__ATOMIC_ACQUIRE, "agent");
            asm volatile("s_waitcnt vmcnt(0)" ::: "memory");
        }
        asm volatile("" ::: "memory"); __builtin_amdgcn_s_barrier(); asm volatile("" ::: "memory");
    }
};
__device__ __forceinline__ int in_idle_rank(int bx) { const int x = bx & 7, li = bx >> 3; if (x < 4) return li >= 16 ? x * 16 + (li - 16) : -1; return li >= 28 ? 64 + (x - 4) * 4 + (li - 28) : -1; }
__device__ __forceinline__ void side_job(const Args& a, LAS unsigned char* lds, int job) {
    int tid_ = threadIdx.x; asm volatile("" : "+v"(tid_));
    const int lane = tid_ & 63, wid = __builtin_amdgcn_readfirstlane(tid_ >> 6);
    const int G = gridDim.x, bx = blockIdx.x; const bool split = (G == 256);
    int first = (job == 0 || job == 3) ? 176 : 192;
    if (!split) first = 0;
    int rank = bx - first, nidle = G - first;
    if (split && (job == 0 || job == 3)) { rank = in_idle_rank(bx); nidle = 80; }
    if (rank < 0) return;
    const int gw = rank * 8 + wid, NGW = nidle * 8;
    LAS float* scr = (LAS float*)(lds + wid * 10240);
    LAS float* red = (LAS float*)(lds + wid * 10240);
    if (job == 0) conv_mat(a, scr, 2, 0, gw, NGW, lane);
    else if (job == 1) { conv_mat(a, scr, 3, 0, gw, NGW, lane); conv_mat(a, scr, 0, 1, gw, NGW, lane); bias_rows(a, red, 0, 1, gw, NGW, lane); }
    else if (job == 2) { bias_rows(a, red, 1, 0, gw, NGW, lane); conv_mat(a, scr, 1, 1, gw, NGW, lane); conv_mat(a, scr, 2, 1, gw, NGW, lane); conv_mat(a, scr, 3, 1, gw, NGW, lane); }
    else if (job == 3) { if (split) { conv_mat(a, scr, 1, 1, gw, NGW, lane); conv_mat(a, scr, 2, 1, gw, NGW, lane); } else bias_rows(a, red, 1, 1, gw, NGW, lane); }
    else if (job == 5) { conv_mat(a, scr, 3, 1, gw, NGW, lane); bias_rows(a, red, 1, 1, gw, NGW, lane); }
    else { if (bx >= 240) bias_rows(a, red, 1, 0, (bx - 240) * 8 + wid, 16 * 8, lane); }
}
__device__ __forceinline__ void rows_rstd(const float* ssq, int row0, int fq, float (&rstd)[4]) {
    f32x4 p[4];
#pragma unroll
    for (int mm = 0; mm < 4; ++mm) p[mm] = *(const f32x4*)(ssq + (size_t)(row0 + mm * 16) * 16 + fq * 4);
#pragma unroll
    for (int mm = 0; mm < 4; ++mm) { float s = (p[mm][0] + p[mm][1]) + (p[mm][2] + p[mm][3]); s += __shfl_xor(s, 16); s += __shfl_xor(s, 32);
        rstd[mm] = __builtin_amdgcn_rsqf(s * (1.f / D) + EPS); }
}
struct EpiIn {
    static constexpr bool PERM = false, AFTER_DRAIN = false;
    int l; bf16_t* PQ; float* out; const float* ssq; const float* bias; const float* rope; const float *qna, *kna, *qnb, *knb;
    __device__ __forceinline__ void operator()(const f32x4 (&acc)[2][2][4][2], const pg8::Unit& u, int wr, int wc, int fr, int fq) const {
        const int pm = u.pm, pn = u.pn; const bool lat = pm >= 32; const int cond = lat ? (pm - 32) >> 2 : 4;
        const int cb = 256 * pn + 64 * wc + 8 * fq;
        const float* gain = nullptr; float gsc = 1.f;
        if (pn < 2) { gain = qna; gsc = C2; } else if (pn < 4) gain = kna; else if (pn < 6) gain = nullptr; else if (pn < 8) { gain = qnb; gsc = C2; } else if (wc < 2) gain = knb;
        float* obase = nullptr; int ocol = 0, opitch = 0;
        if (!lat) {
            if (pn == 2 || pn == 3) { obase = out + O_DK; ocol = cb - 512; opitch = 512; }
            else if (pn == 4 || pn == 5) { obase = out + O_DV; ocol = cb - 1024; opitch = 512; }
            else if (pn == 8) { if (wc < 2) { obase = out + O_GK; ocol = cb - 2048; } else { obase = out + O_GV; ocol = cb - 2176; } opitch = 128; }
        }
        f32x4 bv[2][2], gv[2][2];
#pragma unroll
        for (int bj = 0; bj < 2; ++bj)
#pragma unroll
            for (int n = 0; n < 2; ++n) { bv[bj][n] = *(const f32x4*)(bias + (size_t)cond * INC + cb + 32 * bj + 4 * n);
                gv[bj][n] = gain ? *(const f32x4*)(gain + 32 * bj + 8 * fq + 4 * n) * gsc : (f32x4){1.f, 1.f, 1.f, 1.f}; }
#pragma unroll
        for (int ai = 0; ai < 2; ++ai) {
            float rstd_[4]; rows_rstd(ssq, pm * 256 + ai * 128 + wr * 64 + fr, fq, rstd_);
#pragma unroll
            for (int m = 0; m < 4; ++m) {
                const int row = pm * 256 + ai * 128 + wr * 64 + m * 16 + fr;
                const float rstd = rstd_[m];
                f32x4 v[2][2];
#pragma unroll
                for (int bj = 0; bj < 2; ++bj)
#pragma unroll
                    for (int n = 0; n < 2; ++n) v[bj][n] = acc[ai][bj][m][n] * rstd + bv[bj][n];
                if (obase && pn != 2 && pn != 3 && !(pn == 8 && wc < 2)) {
                    float* op = obase + ((size_t)(pm * 2 + l) * 256 + (row & 255)) * opitch + ocol;
#pragma unroll
                    for (int bj = 0; bj < 2; ++bj) { __builtin_nontemporal_store(v[bj][0], (f32x4*)(op + 32 * bj)); __builtin_nontemporal_store(v[bj][1], (f32x4*)(op + 32 * bj + 4)); }
                }
                if (gain) {
                    float q = 0.f;
#pragma unroll
                    for (int bj = 0; bj < 2; ++bj)
#pragma unroll
                        for (int n = 0; n < 2; ++n) q += (v[bj][n][0] * v[bj][n][0] + v[bj][n][1] * v[bj][n][1]) + (v[bj][n][2] * v[bj][n][2] + v[bj][n][3] * v[bj][n][3]);
                    q += __shfl_xor(q, 16); q += __shfl_xor(q, 32);
                    const float rn = __builtin_amdgcn_rsqf(q * (1.f / 64.f) + EPS);
                    if (obase) {
                        float* op = obase + ((size_t)(pm * 2 + l) * 256 + (row & 255)) * opitch + ocol;
#pragma unroll
                        for (int bj = 0; bj < 2; ++bj) { __builtin_nontemporal_store(v[bj][0] * rn * gv[bj][0], (f32x4*)(op + 32 * bj)); __builtin_nontemporal_store(v[bj][1] * rn * gv[bj][1], (f32x4*)(op + 32 * bj + 4)); }
                    }
#pragma unroll
                    for (int bj = 0; bj < 2; ++bj)
#pragma unroll
                        for (int n = 0; n < 2; ++n) v[bj][n] = v[bj][n] * rn * gv[bj][n];
                    if (lat) {
                        const int t = (row - MCTX) & 1023;
#pragma unroll
                        for (int n = 0; n < 2; ++n) { const f32x4 cs = *(const f32x4*)(rope + (size_t)t * 32 + 8 * fq + 4 * n), sn = *(const f32x4*)(rope + 32768 + (size_t)t * 32 + 8 * fq + 4 * n);
                            const f32x4 x1 = v[0][n], x2 = v[1][n]; v[0][n] = x1 * cs - x2 * sn; v[1][n] = x2 * cs + x1 * sn; }
                    }
                }
                bf16_t* pp = PQ + (size_t)row * INC + cb;
#pragma unroll
                for (int bj = 0; bj < 2; ++bj) { u32x4 w; w.x = pg8::cvt_pk_bf16(v[bj][0][0], v[bj][0][1]); w.y = pg8::cvt_pk_bf16(v[bj][0][2], v[bj][0][3]); w.z = pg8::cvt_pk_bf16(v[bj][1][0], v[bj][1][1]); w.w = pg8::cvt_pk_bf16(v[bj][1][2], v[bj][1][3]);
                    *(u32x4*)(pp + 32 * bj) = w; }
            }
        }
    }
};
struct EpiRes {
    static constexpr bool PERM = false, AFTER_DRAIN = false;
    const float* xin_ctx; const float* xin_lat; float* xout; const float* gate; const float* gtab; bf16_t* AP; float* ssq; int nt_in; int nt_out; bf16_t* XB; int in_bf16; int out_bf16;
    __device__ __forceinline__ void operator()(const f32x4 (&acc)[2][2][4][2], const pg8::Unit& u, int wr, int wc, int fr, int fq) const {
        const int pm = u.pm, pn = u.pn; const bool lat = pm >= 32; const int cond = lat ? (pm - 32) >> 2 : 4;
        const int cb = 256 * pn + 32 * wc + 8 * fq;
        const float* xin = lat ? xin_lat : xin_ctx;
        f32x4 gv[2][2], Gv[2][2];
#pragma unroll
        for (int bj = 0; bj < 2; ++bj)
#pragma unroll
            for (int n = 0; n < 2; ++n) { gv[bj][n] = *(const f32x4*)(gate + (size_t)cond * NMOD + cb + 128 * bj + 4 * n);
                Gv[bj][n] = gtab ? *(const f32x4*)(gtab + (size_t)cond * D + cb + 128 * bj + 4 * n) : (f32x4){0.f, 0.f, 0.f, 0.f}; }
#pragma unroll
        for (int ai = 0; ai < 2; ++ai)
#pragma unroll
            for (int m = 0; m < 4; ++m) {
                const int row = pm * 256 + ai * 128 + wr * 64 + m * 16 + fr;
                const size_t ro = (size_t)row * D + cb;
                float ss = 0.f;
#pragma unroll
                for (int bj = 0; bj < 2; ++bj) { f32x4 xn[2], xo[2];
                    if (in_bf16) { const u32x4 w = *(const u32x4*)(XB + ro + 128 * bj);
                        xo[0][0] = __uint_as_float(w[0] << 16); xo[0][1] = __uint_as_float(w[0] & 0xffff0000u); xo[0][2] = __uint_as_float(w[1] << 16); xo[0][3] = __uint_as_float(w[1] & 0xffff0000u);
                        xo[1][0] = __uint_as_float(w[2] << 16); xo[1][1] = __uint_as_float(w[2] & 0xffff0000u); xo[1][2] = __uint_as_float(w[3] << 16); xo[1][3] = __uint_as_float(w[3] & 0xffff0000u); }
                    else {
#pragma unroll
                        for (int n = 0; n < 2; ++n) xo[n] = nt_in ? __builtin_nontemporal_load((const f32x4*)(xin + ro + 128 * bj + 4 * n)) : *(const f32x4*)(xin + ro + 128 * bj + 4 * n); }
#pragma unroll
                    for (int n = 0; n < 2; ++n) { xn[n] = xo[n] + gv[bj][n] * acc[ai][bj][m][n];
                        ss += (xn[n][0] * xn[n][0] + xn[n][1] * xn[n][1]) + (xn[n][2] * xn[n][2] + xn[n][3] * xn[n][3]); }
                    if (out_bf16) { u32x4 w; w.x = pg8::cvt_pk_bf16(xn[0][0], xn[0][1]); w.y = pg8::cvt_pk_bf16(xn[0][2], xn[0][3]); w.z = pg8::cvt_pk_bf16(xn[1][0], xn[1][1]); w.w = pg8::cvt_pk_bf16(xn[1][2], xn[1][3]);
                        *(u32x4*)(XB + ro + 128 * bj) = w; }
                    else {
#pragma unroll
                        for (int n = 0; n < 2; ++n) { if (nt_out) __builtin_nontemporal_store(xn[n], (f32x4*)(xout + ro + 128 * bj + 4 * n)); else *(f32x4*)(xout + ro + 128 * bj + 4 * n) = xn[n]; } }
                    if (gtab) { const f32x4 y0 = xn[0] * Gv[bj][0], y1 = xn[1] * Gv[bj][1];
                        u32x4 w; w.x = pg8::cvt_pk_bf16(y0[0], y0[1]); w.y = pg8::cvt_pk_bf16(y0[2], y0[3]); w.z = pg8::cvt_pk_bf16(y1[0], y1[1]); w.w = pg8::cvt_pk_bf16(y1[2], y1[3]);
                        *(u32x4*)(AP + ro + 128 * bj) = w; } }
                if (gtab) { ss += __shfl_xor(ss, 16); ss += __shfl_xor(ss, 32); if (fq == 0) ssq[(size_t)row * 16 + 4 * pn + wc] = ss; }
            }
    }
};
struct EpiGU {
    static constexpr bool PERM = false, AFTER_DRAIN = false;
    bf16_t* HD; const float* ssq; const float* bias; int dry;
    __device__ __forceinline__ void operator()(const f32x4 (&acc)[2][2][4][2], const pg8::Unit& u, int wr, int wc, int fr, int fq) const {
        if (dry) return;
        const int pm = u.pm, pn = u.pn; const bool lat = pm >= 32; const int cond = lat ? (pm - 32) >> 2 : 4;
        const int cbh = 128 * pn + 32 * wc + 8 * fq;
        f32x4 bg[2], bu[2];
#pragma unroll
        for (int n = 0; n < 2; ++n) { bg[n] = *(const f32x4*)(bias + (size_t)cond * 2 * FH + cbh + 4 * n); bu[n] = *(const f32x4*)(bias + (size_t)cond * 2 * FH + FH + cbh + 4 * n); }
#pragma unroll
        for (int ai = 0; ai < 2; ++ai) {
            float rstd_[4]; rows_rstd(ssq, pm * 256 + ai * 128 + wr * 64 + fr, fq, rstd_);
#pragma unroll
            for (int m = 0; m < 4; ++m) {
                const int row = pm * 256 + ai * 128 + wr * 64 + m * 16 + fr;
                const float rstd = rstd_[m];
                typedef float f32x2 __attribute__((ext_vector_type(2)));
                unsigned wv[4];
#pragma unroll
                for (int n = 0; n < 2; ++n) { const f32x4 g4 = acc[ai][0][m][n] * rstd + bg[n], u4 = acc[ai][1][m][n] * rstd + bu[n];
#pragma unroll
                    for (int pr = 0; pr < 2; ++pr) { const f32x2 g = {g4[2 * pr], g4[2 * pr + 1]}, uu = {u4[2 * pr], u4[2 * pr + 1]};
                        const f32x2 arg = g * (-LOG2E);
                        f32x2 d; d.x = 1.f + __builtin_amdgcn_exp2f(fminf(arg.x, 57.f)); d.y = 1.f + __builtin_amdgcn_exp2f(fminf(arg.y, 57.f));
                        const float r = __builtin_amdgcn_rcpf(d.x * d.y);
                        const f32x2 sg = (f32x2){d.y, d.x} * r;
                        const f32x2 h = (g * sg) * uu;
                        wv[2 * n + pr] = pg8::cvt_pk_bf16(h.x, h.y); } }
                u32x4 w; w.x = wv[0]; w.y = wv[1]; w.z = wv[2]; w.w = wv[3];
                *(u32x4*)(HD + (size_t)row * FH + cbh) = w;
            }
        }
    }
};
namespace at {
constexpr int STAGE = 32768, SLOT_K = 0, SLOT_V = 16384;
struct UnitDesc { int diff; int lat; int b; int head; int qb; };
__device__ __forceinline__ v4i16_t vtr(const LAS unsigned char* p) { return __builtin_amdgcn_ds_read_tr16_b64_v4i16((LAS v4i16_t*)p); }
__device__ __forceinline__ u32x4 st_pair(u32x2 a, u32x2 b) {
    const auto x = __builtin_amdgcn_permlane32_swap(a.x, b.x, false, false); const auto y = __builtin_amdgcn_permlane32_swap(a.y, b.y, false, false);
    u32x4 r; r.x = x[0]; r.y = y[0]; r.z = x[1]; r.w = y[1]; return r;
}
__device__ __forceinline__ float swap_max(float v) { auto rr = __builtin_amdgcn_permlane32_swap(__float_as_uint(v), __float_as_uint(v), false, false); return fmaxf(__uint_as_float(rr[0]), __uint_as_float(rr[1])); }
__device__ __forceinline__ float swap_sum(float v) { auto rr = __builtin_amdgcn_permlane32_swap(__float_as_uint(v), __float_as_uint(v), false, false); return __uint_as_float(rr[0]) + __uint_as_float(rr[1]); }

struct Strm { const bf16_t* Q; const bf16_t* Kown; const bf16_t* Vown; const bf16_t* Kc; const bf16_t* Vc; int cpitch; int NOWN; int NT; int diff; };
__device__ __forceinline__ Strm mk_strm(const UnitDesc U, int l, const bf16_t* PQ, const unsigned char* ws, int wid) {
    Strm s; const int comp = U.diff ? (wid >> 2) : 0, g = U.head >> 2;
    const int rowbase = U.lat ? MCTX + U.b * 1024 : U.b * 256;
    const int qrow0 = rowbase + (U.diff ? U.qb * 128 + (wid & 3) * 32 : U.qb * 256 + wid * 32);
    const int qcol = U.diff ? U.head * 128 + comp * 64 : 1536 + U.head * 64;
    const int kcol = U.diff ? 512 + U.head * 128 : 2048 + g * 64, vcol = U.diff ? 1024 + U.head * 128 : 2176 + g * 64;
    s.Q = PQ + (size_t)qrow0 * INC + qcol;
    s.Kown = PQ + (size_t)rowbase * INC + kcol; s.Vown = PQ + (size_t)rowbase * INC + vcol;
    s.Kc = U.diff ? (const bf16_t*)(ws + WS_CDK) + (size_t)(U.b * 2 + l) * 512 * 512 + U.head * 128 : (const bf16_t*)(ws + WS_CGK) + (size_t)(U.b * 2 + l) * 512 * 128 + g * 64;
    s.Vc = U.diff ? (const bf16_t*)(ws + WS_CDV) + (size_t)(U.b * 2 + l) * 512 * 512 + U.head * 128 : (const bf16_t*)(ws + WS_CGV) + (size_t)(U.b * 2 + l) * 512 * 128 + g * 64;
    s.cpitch = U.diff ? 512 : 128; s.NOWN = U.lat ? 16 : 4; s.NT = U.lat ? 24 : 4; s.diff = U.diff;
    return s;
}
constexpr int KRING = 0, VRING = 32768, SLOT = 16384, XCH = 65536, QPARK = 98304;
__device__ __forceinline__ void glds16(const void* gsrc, LAS unsigned char* lds_dst) { unsigned keep; const unsigned d = (unsigned)__builtin_amdgcn_readfirstlane((int)(unsigned)(uintptr_t)lds_dst);
    asm volatile("s_mov_b32 %0, m0\n\ts_mov_b32 m0, %2\n\ts_nop 0\n\tglobal_load_lds_dwordx4 %1, off\n\ts_mov_b32 m0, %0" : "=&s"(keep) : "v"(gsrc), "s"(d) : "memory"); }
__device__ __forceinline__ void dma_k(LAS unsigned char* lds, const Strm s, int t, int lane, int wid) {
    const bool own = t < s.NOWN; const int tt = own ? t : t - s.NOWN; const int pitch = own ? INC : s.cpitch;
    const bf16_t* kb = (own ? s.Kown : s.Kc) + (size_t)tt * 64 * pitch; LAS unsigned char* st = lds + KRING + (t & 1) * SLOT;
    const int kl = lane >> 3, key = wid * 8 + kl, g = (lane & 7) ^ ((key >> 1) & 7);
    glds16(kb + (size_t)key * pitch + g * 8, st + wid * 1024);
    if (s.diff) glds16(kb + 64 + (size_t)key * pitch + g * 8, st + 8192 + wid * 1024);
}
__device__ __forceinline__ void dma_v(LAS unsigned char* lds, const Strm s, int t, int lane, int wid) {
    const bool own = t < s.NOWN; const int tt = own ? t : t - s.NOWN; const int pitch = own ? INC : s.cpitch;
    const bf16_t* vb = (own ? s.Vown : s.Vc) + (size_t)tt * 64 * pitch; LAS unsigned char* st = lds + VRING + (t & 1) * SLOT;
    const int kl = lane >> 3, ch = (lane & 7) ^ (((kl >> 1) & 1) << 2);
    { const int q = wid; glds16(vb + (size_t)((q & 7) * 8 + kl) * pitch + (q >> 3) * 64 + ch * 8, st + q * 1024); }
    if (s.diff) { const int q = wid + 8; glds16(vb + (size_t)((q & 7) * 8 + kl) * pitch + (q >> 3) * 64 + ch * 8, st + q * 1024); }
}
__device__ __forceinline__ void prologue_dma(LAS unsigned char* lds, const Strm s, int lane, int wid) {
    dma_k(lds, s, 0, lane, wid); dma_v(lds, s, 0, lane, wid); dma_k(lds, s, 1, lane, wid);
    const bf16_t* qb = s.Q + (size_t)(lane & 31) * INC + (lane >> 5) * 8;
#pragma unroll
    for (int d0 = 0; d0 < 4; ++d0) glds16(qb + d0 * 16, lds + QPARK + wid * 4096 + d0 * 1024);
}
#define AT_WAITBAR() do { asm volatile("s_waitcnt vmcnt(0) lgkmcnt(0)" ::: "memory"); __builtin_amdgcn_s_barrier(); asm volatile("" ::: "memory"); } while (0)
template <bool DIFF, int VAR>
__device__ __forceinline__ void attn_unit(LAS unsigned char* lds, const UnitDesc U, const Strm S, const bool has_nxt, const Strm nxt, int l, const unsigned char* ws, bf16_t* O, const float* subln_l, const bool first) {
    constexpr int ND0 = DIFF ? 4 : 2;
    int tid_ = threadIdx.x; asm volatile("" : "+v"(tid_));
    const int tid = tid_, lane = tid & 63, r32 = lane & 31, hi = lane >> 5, wid = __builtin_amdgcn_readfirstlane(tid >> 6);
    const int comp = DIFF ? (wid >> 2) : 0;
    const int rowbase = U.lat ? MCTX + U.b * 1024 : U.b * 256;
    const int qrow0 = rowbase + (DIFF ? U.qb * 128 + (wid & 3) * 32 : U.qb * 256 + wid * 32);
    const int NT = (VAR == 5) ? 2 : S.NT;
    const LAS unsigned char* qpark = lds + QPARK + wid * 4096 + lane * 16;
    bf16x8 qreg[4];
    auto getq = [&](const int d0) __attribute__((always_inline)) { if constexpr (false) return *(const LAS bf16x8*)(qpark + d0 * 1024); else return qreg[d0]; };
#define AT_QK(P0, P1, t) do { const LAS unsigned char* kp_ = lds + KRING + ((t) & 1) * SLOT + comp * 8192 + r32 * 128; const int kx_ = (hi ^ ((r32 >> 1) & 7)) * 16; P0 = f32x16{}; P1 = f32x16{}; \
        _Pragma("unroll") for (int d0 = 0; d0 < 4; ++d0) { const bf16x8 b0_ = *(const LAS bf16x8*)(kp_ + ((d0 * 32) ^ kx_)), b1_ = *(const LAS bf16x8*)(kp_ + ((d0 * 32) ^ kx_) + 4096); \
            const bf16x8 q_ = getq(d0); P0 = __builtin_amdgcn_mfma_f32_32x32x16_bf16(b0_, q_, P0, 0, 0, 0); P1 = __builtin_amdgcn_mfma_f32_32x32x16_bf16(b1_, q_, P1, 0, 0, 0); } } while (0)
    f32x16 o[ND0];
#pragma unroll
    for (int d0 = 0; d0 < ND0; ++d0) o[d0] = f32x16{};
    float mrun = 0.f, lrun = 0.f;
    f32x16 c0, c1, n0, n1;
#define AT_BAR_L() do { asm volatile("s_waitcnt lgkmcnt(0)" ::: "memory"); __builtin_amdgcn_s_barrier(); asm volatile("" ::: "memory"); } while (0)
    if (first) AT_WAITBAR(); else AT_BAR_L();
    if constexpr (true) {
#pragma unroll
        for (int d0 = 0; d0 < 4; ++d0) qreg[d0] = *(const LAS bf16x8*)(qpark + d0 * 1024); }
    AT_QK(c0, c1, 0);
    for (int t = 0; t < NT; ++t) {
        if (t == 0) AT_BAR_L(); else AT_WAITBAR();
        if (t + 2 < NT) dma_k(lds, S, t + 2, lane, wid);
        if (t + 1 < NT) dma_v(lds, S, t + 1, lane, wid);
        if (t + 1 < NT) AT_QK(n0, n1, t + 1);
        else if (has_nxt) prologue_dma(lds, nxt, lane, wid);
        c0 = c0 - mrun; c1 = c1 - mrun;
        float rm = fmaxf(c0[0], c1[0]);
#pragma unroll
        for (int r = 1; r < 16; ++r) rm = fmaxf(rm, fmaxf(c0[r], c1[r]));
        rm = swap_max(rm);
        if (t == 0 || __any(rm > 8.0f)) {
            const float dl = (t == 0) ? rm : fmaxf(rm, 0.f), f = __builtin_amdgcn_exp2f(-dl);
            mrun += dl; lrun *= f; c0 = c0 - dl; c1 = c1 - dl;
#pragma unroll
            for (int d0 = 0; d0 < ND0; ++d0)
#pragma unroll
                for (int r = 0; r < 16; ++r) o[d0][r] *= f;
        }
#pragma unroll
        for (int r = 0; r < 16; ++r) { c0[r] = __builtin_amdgcn_exp2f(c0[r]); c1[r] = __builtin_amdgcn_exp2f(c1[r]); }
        { const f32x16 s16 = c0 + c1; typedef float f32x8 __attribute__((ext_vector_type(8)));
          const f32x8 s8 = __builtin_shufflevector(s16, s16, 0, 1, 2, 3, 4, 5, 6, 7) + __builtin_shufflevector(s16, s16, 8, 9, 10, 11, 12, 13, 14, 15);
          const f32x4 s4 = __builtin_shufflevector(s8, s8, 0, 1, 2, 3) + __builtin_shufflevector(s8, s8, 4, 5, 6, 7);
          lrun += (s4[0] + s4[1]) + (s4[2] + s4[3]); }
        u32x4 pw[4];
#pragma unroll
        for (int q = 0; q < 4; ++q) { pw[0][q] = pg8::cvt_pk_bf16(c0[2 * q], c0[2 * q + 1]); pw[1][q] = pg8::cvt_pk_bf16(c0[8 + 2 * q], c0[8 + 2 * q + 1]);
                                      pw[2][q] = pg8::cvt_pk_bf16(c1[2 * q], c1[2 * q + 1]); pw[3][q] = pg8::cvt_pk_bf16(c1[8 + 2 * q], c1[8 + 2 * q + 1]); }
        const int kr_ = 4 * hi + ((lane & 15) >> 2), sw_ = ((kr_ >> 1) & 1) * 64;
        const LAS unsigned char* vp0 = lds + VRING + (t & 1) * SLOT + kr_ * 128 + ((lane >> 4) & 1) * 32 + ((lane & 3) >> 1) * 16 + (lane & 1) * 8;
        const LAS unsigned char* vpa = vp0 + sw_; const LAS unsigned char* vpb = vp0 + (64 - sw_);
#pragma unroll
        for (int ks = 0; ks < 4; ++ks)
#pragma unroll
            for (int d0 = 0; d0 < ND0; ++d0) {
                const LAS unsigned char* vq = ((d0 & 1) ? vpb : vpa) + (d0 >> 1) * 8192 + ks * 2048; const v4i16_t lo = vtr(vq), hh = vtr(vq + 1024);
                const bf16x8 vf = (bf16x8){lo[0], lo[1], lo[2], lo[3], hh[0], hh[1], hh[2], hh[3]};
                o[d0] = __builtin_amdgcn_mfma_f32_32x32x16_bf16(vf, __builtin_bit_cast(bf16x8, pw[ks]), o[d0], 0, 0, 0);
            }
        c0 = n0; c1 = n1;
    }
#undef AT_QK
#undef AT_BAR_L
    asm volatile("s_waitcnt vmcnt(0)" ::: "memory");
    lrun = swap_sum(lrun);
    const float inv = 1.0f / lrun;
#pragma unroll
    for (int d0 = 0; d0 < ND0; ++d0)
#pragma unroll
        for (int r = 0; r < 16; ++r) o[d0][r] *= inv;
    const int orow = qrow0 + r32;
    if (DIFF) {
        const float lam = ((const float*)(ws + WS_LAM))[l], li = ((const float*)(ws + WS_LAM))[2 + l];
        LAS float* xch = (LAS float*)(lds + XCH + (wid & 3) * 8192);
        float ss = 0.f;
#pragma unroll
        for (int half = 0; half < 2; ++half) {
            if (comp == 1) {
#pragma unroll
                for (int d = 0; d < 2; ++d)
#pragma unroll
                    for (int r = 0; r < 16; ++r) xch[(d * 16 + r) * 64 + lane] = o[2 * half + d][r];
            }
            asm volatile("s_waitcnt lgkmcnt(0)" ::: "memory"); __builtin_amdgcn_s_barrier(); asm volatile("" ::: "memory");
            if (comp == 0) {
#pragma unroll
                for (int d = 0; d < 2; ++d)
#pragma unroll
                    for (int r = 0; r < 16; ++r) { o[2 * half + d][r] -= lam * xch[(d * 16 + r) * 64 + lane]; ss += o[2 * half + d][r] * o[2 * half + d][r]; }
            }
            asm volatile("s_waitcnt lgkmcnt(0)" ::: "memory"); __builtin_amdgcn_s_barrier(); asm volatile("" ::: "memory");
        }
        if (comp == 0) {
            ss = swap_sum(ss);
            const float rs = __builtin_amdgcn_rsqf(ss * (1.f / 128.f) + EPS) * (1.f - li);
            bf16_t* op = O + (size_t)orow * D + U.head * 128;
#pragma unroll
            for (int d0 = 0; d0 < ND0; ++d0)
#pragma unroll
                for (int q = 0; q < 4; q += 2) { u32x2 w[2];
#pragma unroll
                    for (int e = 0; e < 2; ++e) { const int dv0 = 32 * d0 + 8 * (q + e) + 4 * hi; const f32x4 sw = *(const f32x4*)(subln_l + dv0);
                        w[e].x = pg8::cvt_pk_bf16(o[d0][4 * (q + e)] * rs * sw[0], o[d0][4 * (q + e) + 1] * rs * sw[1]); w[e].y = pg8::cvt_pk_bf16(o[d0][4 * (q + e) + 2] * rs * sw[2], o[d0][4 * (q + e) + 3] * rs * sw[3]); }
                    const u32x4 w4 = st_pair(w[0], w[1]);
                    if (VAR != 9 || w4.x == 0x12345678u) *(u32x4*)(op + 32 * d0 + 8 * (q + hi)) = w4; }
        }
    } else {
        bf16_t* op = O + (size_t)orow * D + 512 + U.head * 64;
#pragma unroll
        for (int d0 = 0; d0 < ND0; ++d0)
#pragma unroll
            for (int q = 0; q < 4; q += 2) { u32x2 w[2];
#pragma unroll
                for (int e = 0; e < 2; ++e) { w[e].x = pg8::cvt_pk_bf16(o[d0][4 * (q + e)], o[d0][4 * (q + e) + 1]); w[e].y = pg8::cvt_pk_bf16(o[d0][4 * (q + e) + 2], o[d0][4 * (q + e) + 3]); }
                const u32x4 w4 = st_pair(w[0], w[1]);
                if (VAR != 9 || w4.x == 0x12345678u) *(u32x4*)(op + 32 * d0 + 8 * (q + hi)) = w4; }
    }
}
__device__ __forceinline__ UnitDesc mk_ld(int i) { UnitDesc u; u.diff = 1; u.lat = 1; u.b = i >> 5; u.head = (i >> 3) & 3; u.qb = i & 7; return u; }
__device__ __forceinline__ UnitDesc mk_lg(int i) { UnitDesc u; u.diff = 0; u.lat = 1; u.b = i >> 5; u.head = (i >> 2) & 7; u.qb = i & 3; return u; }
__device__ __forceinline__ UnitDesc mk_cd(int i) { UnitDesc u; u.diff = 1; u.lat = 0; u.b = i >> 3; u.head = (i >> 1) & 3; u.qb = i & 1; return u; }
__device__ __forceinline__ UnitDesc mk_cg(int i) { UnitDesc u; u.diff = 0; u.lat = 0; u.b = i >> 3; u.head = i & 7; u.qb = 0; return u; }
__device__ __forceinline__ bool get_unit(int G, int j, int idx, UnitDesc& u) {
    if (G == 256) {
        if (j < 128) { if (idx == 0) { u = mk_ld(j); return true; } if (idx == 1) { u = mk_cg(2 * j); return true; } if (idx == 2) { u = mk_cg(2 * j + 1); return true; } return false; }
        const int k = j - 128;
        if (idx == 0) { u = mk_lg(k); return true; } if (idx == 1) { u = mk_cd(2 * k); return true; } if (idx == 2) { u = mk_cd(2 * k + 1); return true; }
        return false;
    }
    const int i = j + idx * G; if (i >= 768) return false;
    if (i < 128) u = mk_ld(i); else if (i < 256) u = mk_lg(i - 128); else if (i < 512) u = mk_cd(i - 256); else u = mk_cg(i - 512);
    return true;
}
template <int VAR> __device__ __forceinline__ void attn_phase(LAS unsigned char* lds, int l, const bf16_t* PQ, const unsigned char* ws, bf16_t* O, const float* subln_l) {
    const int G = gridDim.x; const int bx = blockIdx.x;
    const int j = (G % 8 == 0) ? (bx % 8) * (G / 8) + bx / 8 : bx;
    int tid_ = threadIdx.x; asm volatile("" : "+v"(tid_));
    const int lane = tid_ & 63, wid = __builtin_amdgcn_readfirstlane(tid_ >> 6);
    UnitDesc U, Un;
    if (VAR == 7 || VAR == 8 || VAR == 9) {
        for (int idx = 0; get_unit(G, j, idx, U); ++idx) { if ((VAR == 7) != (U.lat != 0)) continue; Strm S1 = mk_strm(U, l, PQ, ws, wid); prologue_dma(lds, S1, lane, wid);
            if (U.diff) attn_unit<true, (VAR == 9 ? 9 : 0)>(lds, U, S1, false, S1, l, ws, O, subln_l, true); else attn_unit<false, (VAR == 9 ? 9 : 0)>(lds, U, S1, false, S1, l, ws, O, subln_l, true); AT_WAITBAR(); }
        return; }
    if (!get_unit(G, j, 0, U)) return;
    Strm S = mk_strm(U, l, PQ, ws, wid);
    prologue_dma(lds, S, lane, wid);
    if (wid >= 4) __builtin_amdgcn_s_setprio(1);
    for (int idx = 0;; ++idx) {
        const bool hn = get_unit(G, j, idx + 1, Un);
        Strm Sn = S; if (hn) Sn = mk_strm(Un, l, PQ, ws, wid);
        if (U.diff) attn_unit<true, VAR>(lds, U, S, hn, Sn, l, ws, O, subln_l, idx == 0); else attn_unit<false, VAR>(lds, U, S, hn, Sn, l, ws, O, subln_l, idx == 0);
        if (!hn) break;
        U = Un; S = Sn;
    }
    __builtin_amdgcn_s_setprio(0);
    AT_WAITBAR();
}
#undef AT_WAITBAR
}
#define RLX_AGENT __ATOMIC_RELAXED, __HIP_MEMORY_SCOPE_AGENT
#define XB_TMO      128
#define XB_XCNT(j)  (256  + 64 * (j))
#define XB_XSUB(j)  (1280 + 64 * (j))
#define XB_XGEN(j)  (2304 + 64 * (j))
#define XB_TOP      3328
#define XB_TOPGEN   3392
#define XCD_BAR_WORDS 3456
#define XB_SPIN_CAP (1u << 18)

__device__ __forceinline__ unsigned xb_ld(unsigned* p)              { return __hip_atomic_load(p, __ATOMIC_RELAXED, __HIP_MEMORY_SCOPE_AGENT); }
__device__ __forceinline__ unsigned xb_add(unsigned* p, unsigned v) { return __hip_atomic_fetch_add(p, v, __ATOMIC_RELAXED, __HIP_MEMORY_SCOPE_AGENT); }
__device__ __forceinline__ unsigned xb_xcc_id() { return (unsigned)__builtin_amdgcn_s_getreg((3 << 11) | 20) & 0xFu; }
#define XB_SPIN(cond, bar) do { unsigned _sp = 0; while (cond) { __builtin_amdgcn_s_sleep(1); \
    if ((++_sp & 255u) == 0u) { if (xb_ld(&(bar)[XB_TMO])) break; if (_sp > XB_SPIN_CAP) { atomicAdd(&(bar)[XB_TMO], 1u); break; } } } } while (0)

struct XcdBarrier {
    unsigned* bar; unsigned x;
    volatile LAS unsigned* st;
};

__device__ __forceinline__ XcdBarrier xcd_barrier_post(unsigned* bar, volatile LAS unsigned* st) {
    XcdBarrier b; b.bar = bar; b.x = xb_xcc_id(); b.st = st;
    if (threadIdx.x == 0) (void)xb_add(&bar[XB_XCNT(b.x)], 1u);
    return b;
}
__device__ __forceinline__ void xcd_barrier_complete(unsigned* bar, unsigned x, unsigned& nloc, unsigned& nx) {
    const unsigned G = gridDim.x * gridDim.y * gridDim.z;
    unsigned sum, cnt, mine, sp = 0u;
    for (;;) {
        sum = 0u; cnt = 0u; mine = 0u;
#pragma unroll
        for (unsigned j = 0; j < 16; ++j) { const unsigned c = xb_ld(&bar[XB_XCNT(j)]); sum += c; cnt += (c > 0u) ? 1u : 0u; mine = (j == x) ? c : mine; }
        if (sum == G) break;
        __builtin_amdgcn_s_sleep(1);
        if ((++sp & 255u) == 0u) { if (xb_ld(&bar[XB_TMO])) break; if (sp > XB_SPIN_CAP) { atomicAdd(&bar[XB_TMO], 1u); break; } }
    }
    nloc = mine > 0u ? mine : 1u; nx = cnt > 0u ? cnt : 1u;
}

__device__ __forceinline__ void xcd_barrier(const XcdBarrier& b) {
    asm volatile("s_waitcnt vmcnt(0)" ::: "memory");
    __syncthreads();
    if (threadIdx.x == 0) {
        unsigned* bar = b.bar;
        __builtin_amdgcn_s_waitcnt(0);
        unsigned nloc = b.st[0], nx = b.st[1];
        if (nloc == 0u) { xcd_barrier_complete(bar, b.x, nloc, nx); b.st[0] = nloc; b.st[1] = nx; }
        const unsigned old = xb_add(&bar[XB_XSUB(b.x)], 1u);
        const unsigned gen = old / nloc;
        if (old + 1u == (gen + 1u) * nloc) {
            __builtin_amdgcn_fence(__ATOMIC_RELEASE, "agent");
            asm volatile("s_waitcnt vmcnt(0)" ::: "memory");
            const unsigned og = xb_add(&bar[XB_TOP], 1u);
            const unsigned tg = og / nx;
            if (og + 1u == (tg + 1u) * nx) xb_add(&bar[XB_TOPGEN], 1u);
            else XB_SPIN(xb_ld(&bar[XB_TOPGEN]) == tg, bar);
            __builtin_amdgcn_fence(__ATOMIC_ACQUIRE, "agent");
            xb_add(&bar[XB_XGEN(b.x)], 1u);
            asm volatile("s_waitcnt vmcnt(0)" ::: "memory");
        } else {
            XB_SPIN(xb_ld(&bar[XB_XGEN(b.x)]) == gen, bar);
            __builtin_amdgcn_fence(__ATOMIC_ACQUIRE, "agent");
            asm volatile("s_waitcnt vmcnt(0)" ::: "memory");
        }
    }
    __syncthreads();
}

#ifndef PHMASK
#define PHMASK 127
#endif
#ifndef RES_ALIGN
#define RES_ALIGN true
#endif
#ifndef DOWN1_AP
#define DOWN1_AP 0
#endif
#ifndef SJ_MODE
#define SJ_MODE 1
#endif
__global__ void __launch_bounds__(512, 2) fwd(Args a) {
    extern __shared__ __attribute__((aligned(16))) unsigned char lds_raw[];
    LAS unsigned char* lds = (LAS unsigned char*)lds_raw;
    cg::grid_group grid = cg::this_grid();
    unsigned char* ws = a.ws;
    const int G = gridDim.x;
    volatile LAS unsigned* bst = (volatile LAS unsigned*)(lds + 131072 + 1024);
    if (threadIdx.x < 2) bst[threadIdx.x] = 0u;
    __syncthreads();
    XcdBarrier bar = xcd_barrier_post((unsigned*)(ws + WS_CTL), bst);
    if (a.ph_lo < -5) grid.sync();
#ifdef PROBE_PHASE
    unsigned long long pr_dt = 0ull;
#endif
    for (int ph = a.ph_lo; ph < a.ph_hi; ++ph) {
#ifdef PROBE_PHASE
      const unsigned long long pr_t0 = __builtin_amdgcn_s_memrealtime();
#endif
#ifdef REPEAT_KIND
#ifdef DRY_EPI
#define DRY_REP (rep_ > 0 ? 1 : 0)
#else
#define DRY_REP 0
#endif
      for (int rep_ = 0; rep_ < ((ph >= 2 && (ph - 2) % 5 == REPEAT_KIND) || (REPEAT_KIND >= 10 && ph == REPEAT_KIND - 10) || (REPEAT_KIND <= -100 && ph == -REPEAT_KIND - 100) ? 2 : 1); ++rep_) {
#else
#define DRY_REP 0
      {
#endif
        if (ph == 0) { if (PHMASK & 1) phase0(a, lds); }
        else if (ph == 1) { if (PHMASK & 2) phase1(a, lds); }
        else {
            const int l = (ph - 2) / 5, k = (ph - 2) % 5;
            const unsigned char* wt = ws + WS_WT + (size_t)l * WT_LAYER;
            const float* mod_l = (const float*)(ws + WS_MOD) + (size_t)l * 5 * NMOD;
            if (k == 0) { if (PHMASK & 4) {
                pg8::Gemm g{(const bf16_t*)(ws + WS_AP), (const bf16_t*)(wt + WT_IN), MTOT, INC, D}; InOrder S; S.init(MTOT, INC, G, (int)blockIdx.x);
                EpiIn E{l, (bf16_t*)(ws + WS_PQ), a.out, (const float*)(ws + WS_SSQ1), (const float*)(ws + WS_BIN) + (size_t)l * 5 * INC, (const float*)(ws + WS_ROPE),
                        a.in[12] + l * 64, a.in[13] + l * 64, a.in[19] + l * 64, a.in[20] + l * 64};
                pg8::gemm_phase<EpiIn, InOrder, true, true>(lds, g, S, E);
                side_job(a, lds, l == 0 ? 0 : 3); }
            } else if (k == 1) {
                if (PHMASK & 8) at::attn_phase<0>(lds, l, (const bf16_t*)(ws + WS_PQ), ws, (bf16_t*)(ws + WS_O), a.in[18] + l * 128);
#ifdef ATT_EXTRA
                at::attn_phase<ATT_EXTRA>(lds, l, (const bf16_t*)(ws + WS_PQ), ws, (bf16_t*)(ws + WS_AP), a.in[18] + l * 128);
#endif
            } else if (k == 2) { if (PHMASK & 16) {
                pg8::Gemm g{(const bf16_t*)(ws + WS_O), (const bf16_t*)(wt + WT_OUT), MTOT, D, D}; PairOrder S; S.init(MTOT, D, G, (int)blockIdx.x);
                EpiRes E{l == 0 ? a.in[0] : a.out, l == 0 ? a.in[1] - (size_t)MCTX * D : a.out, a.out, mod_l + 2048, (const float*)(ws + WS_GTAB) + (size_t)(l * 2 + 1) * 5 * D, (bf16_t*)(ws + WS_AP), (float*)(ws + WS_SSQ2), l == 0 ? 1 : 0, 0, (bf16_t*)(ws + WS_XB), l == 0 ? 0 : 1, 1};
                pg8::gemm_phase<EpiRes, PairOrder, RES_ALIGN, true>(lds, g, S, E);
                if (l == 0) side_job(a, lds, 1); else if (G == 256) side_job(a, lds, 5); }
            } else if (k == 3) { if (PHMASK & 32) {
                const int ngu = (G == 256) ? 21 * 256 : 2 * FH;
                pg8::Gemm g{(const bf16_t*)(ws + WS_AP), (const bf16_t*)(wt + WT_GU), MTOT, ngu, D}; PairOrder S; S.init(MTOT, ngu, G, (int)blockIdx.x);
                EpiGU E{(bf16_t*)(ws + WS_HD), (const float*)(ws + WS_SSQ2), (const float*)(ws + WS_BGU) + (size_t)l * 5 * 2 * FH, DRY_REP};
                pg8::gemm_phase<EpiGU, PairOrder, true, true>(lds, g, S, E);
                if (l == 0 && G != 256) side_job(a, lds, 2); }
            } else { if (PHMASK & 64) {
                const bool split = (G == 256); const int bx = (int)blockIdx.x;
                unsigned* ready = (unsigned*)(ws + WS_CTL) + CW_RDY + l * 768;
                if (split && bx >= 192 && bx < 240) {
                    pg8::Gemm gg{(const bf16_t*)(ws + WS_AP), (const bf16_t*)(wt + WT_GU), MTOT, 2 * FH, D};
                    LateOrder LS{slot_panel(6 * (bx & 7) + ((bx - 192) >> 3)), ready, true};
                    EpiGU EG{(bf16_t*)(ws + WS_HD), (const float*)(ws + WS_SSQ2), (const float*)(ws + WS_BGU) + (size_t)l * 5 * 2 * FH, 0};
                    pg8::gemm_phase<EpiGU, LateOrder, true, true>(lds, gg, LS, EG);
                    LS.publish();
                } else {
                    pg8::Gemm g{(const bf16_t*)(ws + WS_HD), (const bf16_t*)(wt + WT_DN), MTOT, D, FH}; DownOrder S; S.init(MTOT, D, G, bx); S.ready = ready; S.dep = split;
                    EpiRes E{a.out, a.out, a.out, mod_l + 5120, (l == 0 || DOWN1_AP) ? (const float*)(ws + WS_GTAB) + (size_t)(1 * 2 + 0) * 5 * D : nullptr, (bf16_t*)(ws + WS_AP), (float*)(ws + WS_SSQ1), 0, l == 1 ? 1 : 0, (bf16_t*)(ws + WS_XB), 1, l == 1 ? 0 : 1};
                    pg8::gemm_phase<EpiRes, DownOrder, RES_ALIGN, true, true>(lds, g, S, E);
                }
                if (l == 0 && split) side_job(a, lds, 6); }
            }
        }
      }
#if defined(PROBE_PHASE) && defined(PROBE_NOBAR)
        if (ph == PROBE_PHASE) pr_dt = __builtin_amdgcn_s_memrealtime() - pr_t0;
#endif
        if (ph + 1 < a.ph_hi) xcd_barrier(bar);
#ifdef EXTRA_SYNC
        if (ph + 1 < a.ph_hi) xcd_barrier(bar);
#endif
#if defined(PROBE_PHASE) && !defined(PROBE_NOBAR)
        if (ph == PROBE_PHASE) pr_dt = __builtin_amdgcn_s_memrealtime() - pr_t0;
#endif
    }
#ifdef PROBE_PHASE
#ifndef PROBE_BX
#define PROBE_BX 0
#endif
    if (blockIdx.x == PROBE_BX) { const unsigned long long te = __builtin_amdgcn_s_memrealtime(); while (__builtin_amdgcn_s_memrealtime() - te < 4ull * pr_dt) __builtin_amdgcn_s_sleep(4); }
#endif
}
constexpr int N_PHASES = 12;
static int g_grid = 0;
static int fast_grid() {
    if (g_grid == 0) {
        int dev = 0, cus = 0, per_cu = 0;
        if (hipGetDevice(&dev) != hipSuccess || hipDeviceGetAttribute(&cus, hipDeviceAttributeMultiprocessorCount, dev) != hipSuccess) { fprintf(stderr, "device query failed\n"); g_grid = -1; return g_grid; }
        if (hipFuncSetAttribute((const void*)fwd, hipFuncAttributeMaxDynamicSharedMemorySize, LDS_BYTES) != hipSuccess) { fprintf(stderr, "hipFuncSetAttribute failed\n"); g_grid = -1; return g_grid; }
        if (hipOccupancyMaxActiveBlocksPerMultiprocessor(&per_cu, (const void*)fwd, 512, LDS_BYTES) != hipSuccess || per_cu < 1) { fprintf(stderr, "occupancy query: %d blocks per CU\n", per_cu); (void)hipGetLastError(); per_cu = 1; }
        g_grid = cus;
    }
    return g_grid;
}
static Args make_args(void* const* d_in, void* d_out, void* d_ws) { Args a{}; for (int i = 0; i < 25; ++i) a.in[i] = (const float*)d_in[i]; a.out = (float*)d_out; a.ws = (unsigned char*)d_ws; return a; }
static void launch_phases(void* const* d_in, void* d_out, void* d_ws, int lo, int hi, hipStream_t stream) {
    const int grid = fast_grid(); if (grid <= 0) return;
    Args a = make_args(d_in, d_out, d_ws); a.ph_lo = lo; a.ph_hi = hi;
    if ((lo == 0) && hipMemsetAsync((unsigned char*)d_ws + WS_CTL, 0, CTL_BYTES, stream) != hipSuccess) { fprintf(stderr, "memset of the barrier words failed\n"); return; }
    void* args[] = {&a};
    hipError_t e = hipLaunchCooperativeKernel((const void*)fwd, dim3(grid), dim3(512), args, LDS_BYTES, stream);
    if (e != hipSuccess) fprintf(stderr, "cooperative launch failed: %s (grid %d)\n", hipGetErrorString(e), grid);
}
#undef LAS
}
extern "C" void kernel_launch(void* const* d_in, const int* in_sizes, int n_in, void* d_out, int out_size, void* d_ws, size_t ws_size, hipStream_t stream) {
    (void)in_sizes; (void)n_in; (void)out_size; (void)ws_size;
    fx::launch_phases(d_in, d_out, d_ws, 0, fx::N_PHASES, stream);
}
```
